# Optimizing an MI355X kernel written in HIP

```python
import math
import jax, jax.numpy as jnp
from jax import lax
import numpy as np

D_MODEL = 1024
BATCH = 16
SEQ = 256
DEPTH = 2
DEC_BATCH = 8
DEC_SEQ = 4096
PAST_LEN = 512

GRID_W = 64
ROPE_BASE = 10000.0
NORM_EPS = 1e-6
Q_BLOCK = 128

N_AB = (DEPTH + 1) // 2
N_C = DEPTH // 2

MLA_HEADS = 8
MLA_NOPE = 64
MLA_ROPE = 32
MLA_V = 64
MLA_Q_LORA = 384
MLA_KV_LORA = 256
GLA_HEADS = 4
GLA_DK = 128
GLA_DV = 128
GLA_GATE_RANK = 16
GLA_GATE_NORM = 16.0
GLA_CHUNK = 64
DIFF_HEADS = 8
DIFF_HEAD_DIM = 64
FFN_HIDDEN = -(-8 * D_MODEL // (3 * 256)) * 256

AB_SIZES = (MLA_Q_LORA, MLA_KV_LORA, MLA_ROPE, GLA_HEADS * GLA_DK, GLA_HEADS * GLA_DK,
            GLA_HEADS * GLA_DV, 2 * GLA_GATE_RANK, GLA_HEADS * GLA_DV)
AB_IN = sum(AB_SIZES)
AB_SPLIT_IDX = tuple(int(i) for i in np.cumsum(AB_SIZES)[:-1])
AB_MIX = MLA_HEADS * MLA_V + GLA_HEADS * GLA_DV
C_MIX = DIFF_HEADS * 2 * DIFF_HEAD_DIM

kernel_name = 'hybrid_mla_gla_diffattn_prefix_context_dit_step'


def rms_norm(x, g):
    xf = x.astype(jnp.float32)
    y = xf * lax.rsqrt(jnp.mean(xf * xf, axis=-1, keepdims=True) + NORM_EPS)
    return (y * g.astype(jnp.float32)).astype(x.dtype)


def axial_rope(n_tokens, rot_dim):
    rows = n_tokens // GRID_W
    row = jnp.repeat(jnp.arange(rows, dtype=jnp.float32), GRID_W)
    col = jnp.tile(jnp.arange(GRID_W, dtype=jnp.float32), rows)
    n_freq = rot_dim // 4
    inv = ROPE_BASE ** (-jnp.arange(n_freq, dtype=jnp.float32) / n_freq)
    ang = jnp.concatenate([row[:, None] * inv, col[:, None] * inv], axis=-1)
    return jnp.cos(ang), jnp.sin(ang)


def apply_rope(x, rope):
    cos, sin = rope
    n_tok, half = x.shape[1], x.shape[-1] // 2
    shape = (1, n_tok) + (1,) * (x.ndim - 3) + (half,)
    c, s = cos.reshape(shape), sin.reshape(shape)
    xf = x.astype(jnp.float32).reshape(x.shape[:-1] + (half, 2))
    xe, xo = xf[..., 0], xf[..., 1]
    out = jnp.stack([xe * c - xo * s, xe * s + xo * c], axis=-1).reshape(x.shape)
    return out.astype(x.dtype)


def sweep_query_blocks(fn, q):
    b, lq = q.shape[:2]
    nb = lq // Q_BLOCK
    qb = jnp.moveaxis(q.reshape((b, nb, Q_BLOCK) + q.shape[2:]), 1, 0)
    out = jnp.moveaxis(lax.map(fn, qb), 0, 1)
    return out.reshape((b, lq) + out.shape[3:])


def gla_chunked(q, k, v, g, s0):
    b, n_tok, h, _ = q.shape
    dv = v.shape[-1]
    n = n_tok // GLA_CHUNK

    def chunks(a):
        return a.astype(jnp.float32).reshape(b, n, GLA_CHUNK, h, a.shape[-1]).transpose(0, 3, 1, 2, 4)

    q, k, v, g = chunks(q), chunks(k), chunks(v), chunks(g)
    cum = jnp.cumsum(g, axis=3)
    cum_last = cum[:, :, :, -1:, :]
    q_in = q * jnp.exp(cum)
    k_in = k * jnp.exp(-cum)
    mask = jnp.tril(jnp.ones((GLA_CHUNK, GLA_CHUNK), dtype=bool))
    a = jnp.where(mask, jnp.einsum('bhncd,bhnsd->bhncs', q_in, k_in), 0.0)
    o_intra = jnp.einsum('bhncs,bhnsv->bhncv', a, v)
    u = jnp.einsum('bhncd,bhncv->bhndv', k * jnp.exp(cum_last - cum), v)
    decay = jnp.exp(cum_last[:, :, :, 0, :])

    def step(s, xs):
        dec, u_n = xs
        return dec[..., None] * s + u_n, s

    s_final, s_prev = lax.scan(step, s0.astype(jnp.float32),
                               (jnp.moveaxis(decay, 2, 0), jnp.moveaxis(u, 2, 0)))
    s_prev = jnp.moveaxis(s_prev, 0, 2)
    o = o_intra + jnp.einsum('bhncd,bhndv->bhncv', q_in, s_prev)
    return o.transpose(0, 2, 3, 1, 4).reshape(b, n_tok, h, dv), s_final


def mla_mix(q_lat, kv_lat, k_rope, ai, P, rope, ctx):
    b, n_tok, _ = q_lat.shape
    q = (rms_norm(q_lat, P['mla_g_q'][ai]) @ P['mla_w_uq'][ai]).reshape(b, n_tok, MLA_HEADS, MLA_NOPE + MLA_ROPE)
    q_nope, q_rope = q[..., :MLA_NOPE], q[..., MLA_NOPE:]
    ckv = rms_norm(kv_lat, P['mla_g_kv'][ai])
    if rope is not None:
        q_rope = apply_rope(q_rope, rope)
        k_rope = apply_rope(k_rope, rope)
    ckv_all, krope_all = ckv, k_rope
    if ctx is not None:
        ckv_all = jnp.concatenate([ctx[0].astype(ckv.dtype), ckv], axis=1)
        krope_all = jnp.concatenate([ctx[1].astype(k_rope.dtype), k_rope], axis=1)
    n_keys = ckv_all.shape[1]
    kv = (ckv_all @ P['mla_w_ukv'][ai]).reshape(b, n_keys, MLA_HEADS, MLA_NOPE + MLA_V)
    k_nope, v = kv[..., :MLA_NOPE], kv[..., MLA_NOPE:]
    scale = (MLA_NOPE + MLA_ROPE) ** -0.5

    def attend(qb):
        s = (jnp.einsum('bqhd,bkhd->bhqk', qb[..., :MLA_NOPE], k_nope)
             + jnp.einsum('bqhr,bkr->bhqk', qb[..., MLA_NOPE:], krope_all))
        p = jax.nn.softmax(s.astype(jnp.float32) * scale, axis=-1)
        return jnp.einsum('bhqk,bkhd->bqhd', p.astype(v.dtype), v)

    o = sweep_query_blocks(attend, jnp.concatenate([q_nope, q_rope], axis=-1))
    return o.reshape(b, n_tok, MLA_HEADS * MLA_V), (ckv, k_rope)


def gla_mix(gq, gk, gv, ggate, gout, ai, P, ctx):
    b, n_tok, _ = gq.shape
    q = gq.reshape(b, n_tok, GLA_HEADS, GLA_DK) * (GLA_DK ** -0.5)
    k = gk.reshape(b, n_tok, GLA_HEADS, GLA_DK)
    v = gv.reshape(b, n_tok, GLA_HEADS, GLA_DV)
    lr = ggate.reshape(b, n_tok, 2, GLA_GATE_RANK)
    pre = jnp.einsum('bldr,drk->bldk', lr, P['gla_w_gate_up'][ai]) + P['gla_b_gate'][ai]
    g = (jax.nn.log_sigmoid(pre.astype(jnp.float32)) / GLA_GATE_NORM).reshape(b, n_tok, 2, GLA_HEADS, GLA_DK)
    if ctx is None:
        s0f = jnp.zeros((b, GLA_HEADS, GLA_DK, GLA_DV), jnp.float32)
        s0b = s0f
    else:
        s0f, s0b = ctx
    o_f, s_f = gla_chunked(q, k, v, g[:, :, 0], s0f)
    o_b, s_b = gla_chunked(jnp.flip(q, 1), jnp.flip(k, 1), jnp.flip(v, 1), jnp.flip(g[:, :, 1], 1), s0b)
    o = (o_f + jnp.flip(o_b, 1)).astype(gq.dtype)
    o = rms_norm(o, P['gla_g_out'][ai]) * jax.nn.silu(gout.reshape(b, n_tok, GLA_HEADS, GLA_DV))
    return o.reshape(b, n_tok, GLA_HEADS * GLA_DV), (s_f, s_b)


def ab_mix(h, ai, P, rope, ctx):
    parts = jnp.split(h @ P['ab_w_in'][ai], AB_SPLIT_IDX, axis=-1)
    q_lat, kv_lat, k_rope, gq, gk, gv, ggate, gout = parts
    mla_out, (ckv, krope) = mla_mix(q_lat, kv_lat, k_rope, ai, P, rope,
                                    None if ctx is None else ctx[:2])
    gla_out, (s_f, s_b) = gla_mix(gq, gk, gv, ggate, gout, ai, P,
                                  None if ctx is None else ctx[2:])
    out = jnp.concatenate([mla_out, gla_out.astype(mla_out.dtype)], axis=-1) @ P['ab_w_out'][ai]
    return out, (ckv, krope, s_f, s_b)


def diff_lambda_init(layer):
    return 0.8 - 0.6 * math.exp(-0.3 * layer)


def diff_mix(h, li, ci, P, rope, ctx):
    b, n_tok, _ = h.shape
    q, k, v = jnp.split(h @ P['c_w_qkv'][ci], 3, axis=-1)
    q = q.reshape(b, n_tok, DIFF_HEADS, 2, DIFF_HEAD_DIM)
    k = k.reshape(b, n_tok, DIFF_HEADS, 2, DIFF_HEAD_DIM)
    v = v.reshape(b, n_tok, DIFF_HEADS, 2 * DIFF_HEAD_DIM)
    if rope is not None:
        q = apply_rope(q, rope)
        k = apply_rope(k, rope)
    k_all, v_all = k, v
    if ctx is not None:
        k_all = jnp.concatenate([ctx[0].astype(k.dtype), k], axis=1)
        v_all = jnp.concatenate([ctx[1].astype(v.dtype), v], axis=1)
    lp = P['diff_lambda'][ci].astype(jnp.float32)
    lam_init = diff_lambda_init(li)
    lam = jnp.exp(jnp.sum(lp[0] * lp[1])) - jnp.exp(jnp.sum(lp[2] * lp[3])) + lam_init
    scale = DIFF_HEAD_DIM ** -0.5

    def attend(qb):
        s = jnp.einsum('bqhjd,bkhjd->bhjqk', qb, k_all).astype(jnp.float32) * scale
        p = jax.nn.softmax(s, axis=-1)
        a = p[:, :, 0] - lam * p[:, :, 1]
        return jnp.einsum('bhqk,bkhe->bqhe', a.astype(v_all.dtype), v_all)

    o = sweep_query_blocks(attend, q)
    o = rms_norm(o, P['diff_g_out'][ci]) * (1.0 - lam_init)
    return o.reshape(b, n_tok, C_MIX) @ P['c_w_out'][ci], (k, v)


def trunk_layer(x, li, cond, P, rope, ctx):
    mod = (jax.nn.silu(cond) @ P['w_mod'][li] + P['b_mod'][li])[:, None, :]
    shift1, scale1, gate1, shift2, scale2, gate2 = jnp.split(mod, 6, axis=-1)
    g = P['g_norm'][li]
    h = rms_norm(x, g[0]) * (1.0 + scale1) + shift1
    if li % 2 == 0:
        out, new = ab_mix(h, li // 2, P, rope, ctx)
    else:
        out, new = diff_mix(h, li, li // 2, P, rope, ctx)
    x = x + gate1 * rms_norm(out, g[1])
    h = rms_norm(x, g[2]) * (1.0 + scale2) + shift2
    gate, up = jnp.split(h @ P['w_ffn_in'][li], 2, axis=-1)
    f = (jax.nn.silu(gate) * up) @ P['w_ffn_out'][li]
    x = x + gate2 * rms_norm(f, g[3])
    return x, new


def _normal(k, shape, scale):
    return jax.random.normal(k, shape, jnp.float32) * scale


def setup_inputs(seed: int = 0) -> dict:
    key = jax.random.key(seed)
    ks = jax.random.split(key, 32)
    d = D_MODEL
    return {
        'x_prompt': _normal(ks[0], (BATCH, SEQ, d), 1.0),
        'x_sample': _normal(ks[1], (DEC_BATCH, DEC_SEQ, d), 1.0),
        'cache_mla_ckv': _normal(ks[2], (DEC_BATCH, N_AB, PAST_LEN, MLA_KV_LORA), 1.0),
        'cache_mla_krope': _normal(ks[3], (DEC_BATCH, N_AB, PAST_LEN, MLA_ROPE), 1.0),
        'state_gla_fwd': _normal(ks[4], (DEC_BATCH, N_AB, GLA_HEADS, GLA_DK, GLA_DV), 1.0),
        'state_gla_bwd': _normal(ks[5], (DEC_BATCH, N_AB, GLA_HEADS, GLA_DK, GLA_DV), 1.0),
        'cache_diff_k': _normal(ks[6], (DEC_BATCH, N_C, PAST_LEN, DIFF_HEADS, 2, DIFF_HEAD_DIM), 1.0),
        'cache_diff_v': _normal(ks[7], (DEC_BATCH, N_C, PAST_LEN, DIFF_HEADS, 2 * DIFF_HEAD_DIM), 1.0),
        'c': _normal(ks[8], (DEC_BATCH, d), 1.0),
        'c_ctx': _normal(ks[9], (d,), 1.0),
        'w_mod': _normal(ks[10], (DEPTH, d, 6 * d), d ** -0.5),
        'b_mod': _normal(ks[11], (DEPTH, 6 * d), 0.02),
        'g_norm': 1.0 + _normal(ks[12], (DEPTH, 4, d), 0.02),
        'ab_w_in': _normal(ks[13], (N_AB, d, AB_IN), d ** -0.5),
        'mla_g_q': 1.0 + _normal(ks[14], (N_AB, MLA_Q_LORA), 0.02),
        'mla_g_kv': 1.0 + _normal(ks[15], (N_AB, MLA_KV_LORA), 0.02),
        'mla_w_uq': _normal(ks[16], (N_AB, MLA_Q_LORA, MLA_HEADS * (MLA_NOPE + MLA_ROPE)), MLA_Q_LORA ** -0.5),
        'mla_w_ukv': _normal(ks[17], (N_AB, MLA_KV_LORA, MLA_HEADS * (MLA_NOPE + MLA_V)), MLA_KV_LORA ** -0.5),
        'gla_w_gate_up': _normal(ks[18], (N_AB, 2, GLA_GATE_RANK, GLA_HEADS * GLA_DK), GLA_GATE_RANK ** -0.5),
        'gla_b_gate': _normal(ks[19], (N_AB, 2, GLA_HEADS * GLA_DK), 0.1),
        'gla_g_out': 1.0 + _normal(ks[20], (N_AB, GLA_DV), 0.02),
        'ab_w_out': _normal(ks[21], (N_AB, AB_MIX, d), AB_MIX ** -0.5),
        'c_w_qkv': _normal(ks[22], (N_C, d, 3 * C_MIX), d ** -0.5),
        'diff_lambda': _normal(ks[23], (N_C, 4, DIFF_HEAD_DIM), 0.1),
        'diff_g_out': 1.0 + _normal(ks[24], (N_C, 2 * DIFF_HEAD_DIM), 0.02),
        'c_w_out': _normal(ks[25], (N_C, C_MIX, d), C_MIX ** -0.5),
        'w_ffn_in': _normal(ks[26], (DEPTH, d, 2 * FFN_HIDDEN), d ** -0.5),
        'w_ffn_out': _normal(ks[27], (DEPTH, FFN_HIDDEN, d), FFN_HIDDEN ** -0.5),
    }


def reference(x_prompt, x_sample, cache_mla_ckv, cache_mla_krope, state_gla_fwd, state_gla_bwd,
              cache_diff_k, cache_diff_v, c, c_ctx, w_mod, b_mod, g_norm, ab_w_in, mla_g_q, mla_g_kv,
              mla_w_uq, mla_w_ukv, gla_w_gate_up, gla_b_gate, gla_g_out, ab_w_out, c_w_qkv, diff_lambda,
              diff_g_out, c_w_out, w_ffn_in, w_ffn_out):
    P = dict(w_mod=w_mod, b_mod=b_mod, g_norm=g_norm, ab_w_in=ab_w_in, mla_g_q=mla_g_q, mla_g_kv=mla_g_kv,
             mla_w_uq=mla_w_uq, mla_w_ukv=mla_w_ukv, gla_w_gate_up=gla_w_gate_up, gla_b_gate=gla_b_gate,
             gla_g_out=gla_g_out, ab_w_out=ab_w_out, c_w_qkv=c_w_qkv, diff_lambda=diff_lambda,
             diff_g_out=diff_g_out, c_w_out=c_w_out, w_ffn_in=w_ffn_in, w_ffn_out=w_ffn_out)

    y = x_prompt
    ab_states, c_states = [], []
    for li in range(DEPTH):
        y, new = trunk_layer(y, li, c_ctx[None, :], P, None, None)
        if li % 2 == 0:
            ab_states.append(new)
        else:
            c_states.append(new)
    y_prompt = y

    n_lat = x_sample.shape[1]
    rope_mla = axial_rope(n_lat, MLA_ROPE)
    rope_diff = axial_rope(n_lat, DIFF_HEAD_DIM)
    z = x_sample
    for li in range(DEPTH):
        i = li // 2
        if li % 2 == 0:
            ctx = (cache_mla_ckv[:, i], cache_mla_krope[:, i], state_gla_fwd[:, i], state_gla_bwd[:, i])
            z, _ = trunk_layer(z, li, c, P, rope_mla, ctx)
        else:
            ctx = (cache_diff_k[:, i], cache_diff_v[:, i])
            z, _ = trunk_layer(z, li, c, P, rope_diff, ctx)
    y_sample = z

    new_mla_ckv = jnp.stack([s[0] for s in ab_states], axis=1)
    new_mla_krope = jnp.stack([s[1] for s in ab_states], axis=1)
    new_gla_fwd = jnp.stack([s[2] for s in ab_states], axis=1)
    new_gla_bwd = jnp.stack([s[3] for s in ab_states], axis=1)
    new_diff_k = jnp.stack([s[0] for s in c_states], axis=1)
    new_diff_v = jnp.stack([s[1] for s in c_states], axis=1)
    return (y_prompt, y_sample, new_mla_ckv, new_mla_krope, new_gla_fwd, new_gla_bwd, new_diff_k, new_diff_v)
```

```cpp
#include <hip/hip_runtime.h>
#include <hip/hip_cooperative_groups.h>
#include <cstdio>
#include <cstdint>
namespace cg = cooperative_groups;
__device__ __forceinline__ int tid_opaque() { int t = threadIdx.x; asm volatile("" : "+v"(t)); return t; }
namespace pg8 {
#define PG8_LAS __attribute__((address_space(3)))
typedef unsigned short bf16_t;
typedef short bf16x8 __attribute__((ext_vector_type(8)));
typedef float f32x4 __attribute__((ext_vector_type(4)));
typedef unsigned u32x4 __attribute__((ext_vector_type(4)));
constexpr int BM = 256, BK = 64, HALF = 128, HTB = HALF * BK * 2  , STAGE_BYTES = 8 * HTB, NXCD = 8, WGM = 8;

__host__ __device__ __forceinline__ int lds_byte(int r, int c) { const int st = (r >> 4) * 2 + (c >> 5), rr = r & 15, cc = c & 31, ob = rr * 64 + cc * 2; return st * 1024 + (ob ^ (((ob >> 9) & 1) << 5)); }
__host__ __device__ __forceinline__ void stage_rc(int b, int& R, int& C) { const int st = b / 1024, sb = b % 1024, swz = sb ^ (((sb >> 9) & 1) << 5); R = (st >> 1) * 16 + swz / 64; C = (st & 1) * 32 + (swz % 64) / 2; }
__host__ __device__ __forceinline__ int perm32(int rho) { const int n = rho >> 4, i = rho & 15; return 8 * (i >> 2) + 4 * n + (i & 3); }

struct Unit { int pm, pn; };
struct Gemm { const bf16_t* A; const bf16_t* Bt; int M, N, K; };

struct StaticOrder {
    int nM, nN, nwg, G, c;
    __host__ __device__ void init(int M, int N, int G_, int c_) { nM = M / BM; nN = N / BM; nwg = nM * nN; G = G_; c = c_; }
    __host__ __device__ bool next(int i, Unit& u) const {
        const long L = (long)i * G + c; if (L >= nwg) return false;
        int wgid = (int)L; { const int q = nwg / NXCD, r = nwg % NXCD, xcd = wgid % NXCD, off = wgid / NXCD; wgid = (xcd < r ? xcd * (q + 1) : r * (q + 1) + (xcd - r) * q) + off; }
        const int nig = WGM * nN, gid = wgid / nig, fm = gid * WGM, gsz = (nM - fm) < WGM ? (nM - fm) : WGM;
        u.pm = fm + ((wgid % nig) % gsz); u.pn = (wgid % nig) / gsz; return true;
    }
    __device__ __forceinline__ void a_ready(const Unit&) const {}
    __device__ __forceinline__ void done(const Unit&) const {}
};

__device__ __forceinline__ unsigned cvt_pk_bf16(float lo, float hi) { unsigned r; asm volatile("v_cvt_pk_bf16_f32 %0, %1, %2" : "=v"(r) : "v"(lo), "v"(hi)); return r; }
typedef float f32x2 __attribute__((ext_vector_type(2)));
template <class Epi, class Sched, bool ALIGN_EPI = false, bool SP2 = false>
__device__ __forceinline__ void gemm_phase(PG8_LAS unsigned char* lds, const Gemm g, const Sched& S, const Epi& E) {
    const int tid = tid_opaque(), wid = __builtin_amdgcn_readfirstlane(tid >> 6), lane = tid & 63, wr = wid >> 2, wc = wid & 3, fr = lane & 15, fq = lane >> 4;
    const int K = g.K, nt = K / BK;
    unsigned voffA[2], voffB[2];
#pragma unroll
    for (int i = 0; i < 2; ++i) { int R, C; stage_rc(tid * 16 + i * 8192, R, C); const int Rb = Epi::PERM ? ((R & ~31) + perm32(R & 31)) : R;
        voffA[i] = (unsigned)(R * K + C) * 2u; voffB[i] = (unsigned)(Rb * K + C) * 2u; }
    const size_t kstep = (size_t)(BK * 2);
    const size_t hstep = (size_t)HALF * K * 2;
    const size_t tstep = 2 * hstep;
    const unsigned ldsw = (unsigned)wid * 1024u;
    const int aoff = lds_byte(wr * 64 + fr, fq * 8), boff = lds_byte(wc * 32 + fr, fq * 8);
#define PG8_SA(b, h) (((b) * 2 + (h)) * HTB)
#define PG8_SB(b, h) ((4 + (b) * 2 + (h)) * HTB)
#define PG8_STAGE(bufoff, gbase, voff) do { _Pragma("unroll") for (int _i = 0; _i < 2; ++_i) \
        __builtin_amdgcn_global_load_lds((const unsigned*)((const char*)(gbase) + (voff)[_i]), (PG8_LAS unsigned*)(lds + (bufoff) + ldsw + _i * 8192), 16, 0, 0); } while (0)
#define PG8_LDA(dst, b, h) do { _Pragma("unroll") for (int m = 0; m < 4; ++m) _Pragma("unroll") for (int k = 0; k < 2; ++k) dst[m][k] = *(const PG8_LAS bf16x8*)(lds + PG8_SA(b, h) + aoff + m * 2048 + k * 1024); } while (0)
#define PG8_LDB(dst, b, h) do { _Pragma("unroll") for (int n = 0; n < 2; ++n) _Pragma("unroll") for (int k = 0; k < 2; ++k) dst[n][k] = *(const PG8_LAS bf16x8*)(lds + PG8_SB(b, h) + boff + n * 2048 + k * 1024); } while (0)
#define PG8_MMA(ai, bj, At, Bt) do { __builtin_amdgcn_s_setprio(1); _Pragma("unroll") for (int m = 0; m < 4; ++m) _Pragma("unroll") for (int n = 0; n < 2; ++n) _Pragma("unroll") for (int k = 0; k < 2; ++k) \
        acc[ai][bj][m][n] = __builtin_amdgcn_mfma_f32_16x16x32_bf16(Bt[n][k], At[m][k], acc[ai][bj][m][n], 0, 0, 0); __builtin_amdgcn_s_setprio(0); } while (0)
#define PG8_WAIT_V(n) asm volatile("s_waitcnt vmcnt(" #n ")" ::: "memory")
#define PG8_WAIT_L(n) asm volatile("s_waitcnt lgkmcnt(" #n ")" ::: "memory")
#define PG8_BAR __builtin_amdgcn_s_barrier()
#define PG8_SCHED __builtin_amdgcn_sched_barrier(0)
    Unit cur, nxt; int ui = 0;
    if (!S.next(0, cur)) return;
    f32x4 acc[2][2][4][2];
#pragma unroll
    for (int a = 0; a < 2; ++a)
#pragma unroll
        for (int b = 0; b < 2; ++b)
#pragma unroll
            for (int m = 0; m < 4; ++m)
#pragma unroll
                for (int n = 0; n < 2; ++n) acc[a][b][m][n] = (f32x4){0.f, 0.f, 0.f, 0.f};
    bf16x8 At[4][2], B0[2][2], B1[2][2];
    const char* cA = (const char*)g.A + (size_t)cur.pm * tstep; const char* cB = (const char*)g.Bt + (size_t)cur.pn * tstep;
    S.a_ready(cur);
    if constexpr (SP2) {
        PG8_STAGE(PG8_SB(0, 0), cB, voffB); PG8_STAGE(PG8_SB(0, 1), cB + hstep, voffB); PG8_STAGE(PG8_SA(0, 0), cA, voffA); PG8_STAGE(PG8_SA(0, 1), cA + hstep, voffA);
        if (wr == 1) PG8_BAR;
        PG8_WAIT_V(2); PG8_BAR;
        PG8_STAGE(PG8_SB(1, 0), cB + kstep, voffB); PG8_STAGE(PG8_SA(1, 0), cA + kstep, voffA); PG8_STAGE(PG8_SB(1, 1), cB + hstep + kstep, voffB);
        PG8_WAIT_V(6); PG8_BAR;
    } else {
        PG8_STAGE(PG8_SB(0, 0), cB, voffB); PG8_STAGE(PG8_SA(0, 0), cA, voffA); PG8_STAGE(PG8_SB(0, 1), cB + hstep, voffB); PG8_STAGE(PG8_SA(0, 1), cA + hstep, voffA);
        if (wr == 1) PG8_BAR;
        PG8_WAIT_V(4); PG8_BAR;
        PG8_STAGE(PG8_SB(1, 0), cB + kstep, voffB); PG8_STAGE(PG8_SA(1, 0), cA + kstep, voffA); PG8_STAGE(PG8_SB(1, 1), cB + hstep + kstep, voffB);
        PG8_WAIT_V(6); PG8_BAR;
    }
    for (;;) {
        const bool has_next = S.next(ui + 1, nxt);
        const char* nA = has_next ? (const char*)g.A + (size_t)nxt.pm * tstep : cA; const char* nB = has_next ? (const char*)g.Bt + (size_t)nxt.pn * tstep : cB;
        for (int t = 0; t < nt; t += 2) {
            const bool last = (t == nt - 2);
            const char* a1 = cA + (size_t)(t + 1) * kstep;
            const char* a2 = last ? nA : cA + (size_t)(t + 2) * kstep; const char* b2 = last ? nB : cB + (size_t)(t + 2) * kstep;
            const char* a3 = a2 + kstep; const char* b3 = b2 + kstep;
            if (last && has_next) S.a_ready(nxt);
            if constexpr (SP2) {
            PG8_LDB(B0, 0, 0); PG8_LDB(B1, 0, 1); PG8_SCHED; PG8_LDA(At, 0, 0); PG8_STAGE(PG8_SA(1, 1), a1 + hstep, voffA);
            PG8_WAIT_V(8); PG8_WAIT_L(0); PG8_BAR; PG8_MMA(0, 0, At, B0); PG8_MMA(0, 1, At, B1); PG8_BAR; PG8_SCHED;
            PG8_LDA(At, 0, 1); PG8_STAGE(PG8_SB(0, 0), b2, voffB); PG8_STAGE(PG8_SB(0, 1), b2 + hstep, voffB); PG8_STAGE(PG8_SA(0, 0), a2, voffA);
            PG8_WAIT_V(8); PG8_WAIT_L(0); PG8_BAR; PG8_MMA(1, 0, At, B0); PG8_MMA(1, 1, At, B1); PG8_BAR; PG8_SCHED;
            PG8_LDB(B0, 1, 0); PG8_LDB(B1, 1, 1); PG8_SCHED; PG8_LDA(At, 1, 0); PG8_STAGE(PG8_SA(0, 1), a2 + hstep, voffA);
            PG8_WAIT_V(8); PG8_WAIT_L(0); PG8_BAR; PG8_MMA(0, 0, At, B0); PG8_MMA(0, 1, At, B1); PG8_BAR; PG8_SCHED;
            PG8_LDA(At, 1, 1); PG8_STAGE(PG8_SB(1, 0), b3, voffB); PG8_STAGE(PG8_SB(1, 1), b3 + hstep, voffB); PG8_STAGE(PG8_SA(1, 0), a3, voffA);
            PG8_WAIT_V(8); PG8_WAIT_L(0); PG8_BAR; PG8_MMA(1, 0, At, B0); PG8_MMA(1, 1, At, B1); PG8_BAR; PG8_SCHED;
            } else {
            PG8_LDB(B0, 0, 0); PG8_SCHED; PG8_LDA(At, 0, 0); PG8_STAGE(PG8_SA(1, 1), a1 + hstep, voffA);
            PG8_WAIT_L(8); PG8_BAR; PG8_WAIT_L(0); PG8_MMA(0, 0, At, B0); PG8_BAR; PG8_SCHED;
            PG8_LDB(B1, 0, 1); PG8_STAGE(PG8_SB(0, 0), b2, voffB);
            PG8_BAR; PG8_WAIT_L(0); PG8_MMA(0, 1, At, B1); PG8_BAR;
            PG8_LDA(At, 0, 1); PG8_STAGE(PG8_SA(0, 0), a2, voffA);
            PG8_BAR; PG8_WAIT_L(0); PG8_MMA(1, 0, At, B0); PG8_BAR; PG8_SCHED;
            PG8_STAGE(PG8_SB(0, 1), b2 + hstep, voffB);
            PG8_WAIT_V(6); PG8_BAR; PG8_MMA(1, 1, At, B1); PG8_BAR;
            PG8_LDB(B0, 1, 0); PG8_SCHED; PG8_LDA(At, 1, 0); PG8_STAGE(PG8_SA(0, 1), a2 + hstep, voffA);
            PG8_WAIT_L(8); PG8_BAR; PG8_WAIT_L(0); PG8_MMA(0, 0, At, B0); PG8_BAR; PG8_SCHED;
            PG8_LDB(B1, 1, 1); PG8_STAGE(PG8_SB(1, 0), b3, voffB);
            PG8_BAR; PG8_WAIT_L(0); PG8_MMA(0, 1, At, B1); PG8_BAR;
            PG8_LDA(At, 1, 1); PG8_STAGE(PG8_SA(1, 0), a3, voffA);
            PG8_BAR; PG8_WAIT_L(0); PG8_MMA(1, 0, At, B0); PG8_BAR; PG8_SCHED;
            PG8_STAGE(PG8_SB(1, 1), b3 + hstep, voffB);
            PG8_WAIT_V(6); PG8_BAR; PG8_MMA(1, 1, At, B1); PG8_BAR;
            }
        }
        if constexpr (ALIGN_EPI) { if (wr == 0) PG8_BAR; }
        if constexpr (!Epi::AFTER_DRAIN) { E(acc, cur, wr, wc, fr, fq); S.done(cur); }
        if (!has_next) break;
#pragma unroll
        for (int a = 0; a < 2; ++a)
#pragma unroll
            for (int b = 0; b < 2; ++b)
#pragma unroll
                for (int m = 0; m < 4; ++m)
#pragma unroll
                    for (int n = 0; n < 2; ++n) acc[a][b][m][n] = (f32x4){0.f, 0.f, 0.f, 0.f};
        cur = nxt; cA = nA; cB = nB; ++ui;
        if constexpr (ALIGN_EPI) { if (wr == 1) PG8_BAR; }
    }
    PG8_WAIT_V(0);
    if constexpr (!ALIGN_EPI) { if (wr == 0) PG8_BAR; }
    PG8_BAR;
    if constexpr (Epi::AFTER_DRAIN) { E.fused(acc, cur, wr, wc, fr, fq, lds, wid, lane); S.done(cur); }
#undef PG8_SA
#undef PG8_SB
#undef PG8_STAGE
#undef PG8_LDA
#undef PG8_LDB
#undef PG8_MMA
#undef PG8_WAIT_V
#undef PG8_WAIT_L
#undef PG8_BAR
#undef PG8_SCHED
}
}

#define LAS __attribute__((address_space(3)))
typedef LAS unsigned char* ldsp;
typedef unsigned short bf16;
typedef float f32x4 __attribute__((ext_vector_type(4)));
typedef float f32x2 __attribute__((ext_vector_type(2)));
typedef float f32x16 __attribute__((ext_vector_type(16)));
typedef short bf16x8 __attribute__((ext_vector_type(8)));
typedef short s16x4 __attribute__((ext_vector_type(4)));
typedef unsigned u32x4 __attribute__((ext_vector_type(4)));
typedef unsigned u32x2 __attribute__((ext_vector_type(2)));

constexpr int DM = 1024, MP = 4096, MS = 32768, MT = MP + MS, KR = 4096 + 8 * 4608;
constexpr int FFH = 2816, PJ = 2816;
constexpr float EPS = 1e-6f;
constexpr float LAM_INIT = 0.35550907f;
constexpr int C_QLAT = 0, C_KVLAT = 384, C_KROPE = 640, C_GQ = 672, C_GK = 1184, C_GV = 1696, C_GGATE = 2208, C_GOUT = 2240;

constexpr size_t MiB = 1u << 20;
constexpr size_t WS_CTL = 0, WS_MOD = 1 * MiB, WS_ROPE = 2 * MiB, WS_W = 4 * MiB;
constexpr size_t WS_RM_COS = WS_ROPE, WS_RM_SIN = WS_ROPE + 256 * 1024, WS_RD_COS = WS_ROPE + 512 * 1024, WS_RD_SIN = WS_ROPE + 1024 * 1024, WS_LAM = WS_ROPE + 1536 * 1024;
constexpr size_t W_IN = WS_W, W_UQ = W_IN + (size_t)2816 * 1024 * 2, W_UKV = W_UQ + (size_t)768 * 384 * 2, W_ABO = W_UKV + (size_t)1024 * 256 * 2,
                 W_QKV = W_ABO + 2 * MiB, W_CO = W_QKV + 6 * MiB, W_F1 = W_CO + 2 * MiB, W_F2 = W_F1 + 22 * MiB, W_END = W_F2 + 11 * MiB;
constexpr size_t WS_A = 54 * MiB, WS_B = 126 * MiB, WS_C = 324 * MiB, WS_END = 476 * MiB;
static_assert(W_END <= WS_A, "weights fit");
constexpr size_t A_H = WS_A, A_MIX = WS_A, A_QLN = WS_A, A_CKV = WS_A + 28 * MiB;
constexpr size_t B_PROJ = WS_B, B_FFNH = WS_B, B_QD = WS_B, B_KD = WS_B + 72 * MiB;
constexpr size_t R_OUT = WS_C, R_Q = WS_C, R_KN = WS_C + 54 * MiB, R_KROPE = WS_C + 94 * MiB, R_VTM = WS_C + 97 * MiB, R_VTD = WS_C + 72 * MiB;

struct ParamsK {
    const float* in[28];
    float* out;
    unsigned char* ws;
};
struct Params {
    const __attribute__((address_space(4))) char* kp;
    __device__ __forceinline__ const float* inp(int i) const {
#if defined(__HIP_DEVICE_COMPILE__)
        return *(const float* const __attribute__((address_space(4)))*)(kp + 8 * i);
#else
        return nullptr;
#endif
    }
    __device__ __forceinline__ float* outp() const {
#if defined(__HIP_DEVICE_COMPILE__)
        return *(float* const __attribute__((address_space(4)))*)(kp + 8 * 28);
#else
        return nullptr;
#endif
    }
    __device__ __forceinline__ unsigned char* wsp() const {
#if defined(__HIP_DEVICE_COMPILE__)
        return *(unsigned char* const __attribute__((address_space(4)))*)(kp + 8 * 29);
#else
        return nullptr;
#endif
    }
};
enum { I_XP = 0, I_XS, I_CKV, I_CKROPE, I_SF, I_SB, I_CDK, I_CDV, I_C, I_CCTX, I_WMOD, I_BMOD, I_GNORM, I_ABWIN, I_GQ, I_GKV, I_WUQ, I_WUKV, I_WGATE, I_BGATE, I_GGOUT, I_ABWOUT,
       I_CWQKV, I_DLAM, I_DGOUT, I_CWOUT, I_WF1, I_WF2 };
constexpr size_t O_Y = 0, O_CKV = (size_t)MT * 1024, O_KROPE = O_CKV + (size_t)4096 * 256, O_GF = O_KROPE + (size_t)4096 * 32, O_GB = O_GF + (size_t)16 * 4 * 128 * 128,
                 O_DK = O_GB + (size_t)16 * 4 * 128 * 128, O_DV = O_DK + (size_t)4096 * 1024;

typedef float f32x2_cv __attribute__((ext_vector_type(2))); typedef __bf16 bf16x2_cv __attribute__((ext_vector_type(2)));
__device__ __forceinline__ unsigned pkbf(float lo, float hi) { f32x2_cv v = {lo, hi}; bf16x2_cv b = __builtin_convertvector(v, bf16x2_cv); return __builtin_bit_cast(unsigned, b); }
__device__ __forceinline__ float bf_lo(unsigned w) { return __uint_as_float(w << 16); }
__device__ __forceinline__ float bf_hi(unsigned w) { return __uint_as_float(w & 0xffff0000u); }
__device__ __forceinline__ float bf1(bf16 v) { return __uint_as_float((unsigned)v << 16); }
__device__ __forceinline__ bf16 tobf(float f) { return (bf16)(pkbf(f, 0.f) & 0xffffu); }
__device__ __forceinline__ float wave_sum(float v) {
#pragma unroll
    for (int o = 1; o < 64; o <<= 1) v += __shfl_xor(v, o);
    return v;
}
__device__ __forceinline__ float fast_exp2(float x) { return __builtin_amdgcn_exp2f(x); }
__device__ __forceinline__ float fast_rcp(float x) { return __builtin_amdgcn_rcpf(x); }
__device__ __forceinline__ float silu_f(float g) { return g * fast_rcp(1.f + fast_exp2(-1.4426950408889634f * g)); }
__device__ __forceinline__ int key_row(int row) { if (row < MP) return row; const int r = row - MP; return MP + (r >> 12) * 4608 + 512 + (r & 4095); }
__device__ __forceinline__ void vt_pos(int krow, int HD, size_t& base, int& pos, int& Lk) {
    if (krow < MP) { const int kb = krow >> 8; pos = krow & 255; Lk = 256; base = (size_t)kb * HD * 256; }
    else { const int r = krow - MP, b = r / 4608; pos = r - b * 4608; Lk = 4608; base = (size_t)16 * HD * 256 + (size_t)b * HD * 4608; }
}
__device__ __forceinline__ const float* xrow_in(const Params& P, int row) { return row < MP ? P.inp(I_XP) + (size_t)row * DM : P.inp(I_XS) + (size_t)(row - MP) * DM; }
__device__ __forceinline__ int cond_of(int row) { return row < MP ? 0 : 1 + ((row - MP) >> 12); }

namespace pg8 {
template <class F> struct Epi8 {
    static constexpr bool PERM = true, AFTER_DRAIN = false; F f;
    __device__ __forceinline__ void operator()(const f32x4 (&acc)[2][2][4][2], const Unit& u, int wr, int wc, int fr, int fq) const {
        const int row0 = u.pm * BM + wr * 64 + fr, col0 = u.pn * BM + wc * 32 + 8 * fq;
#pragma unroll
        for (int ai = 0; ai < 2; ++ai)
#pragma unroll
            for (int m = 0; m < 4; ++m)
#pragma unroll
                for (int bj = 0; bj < 2; ++bj) { f(row0 + ai * HALF + m * 16, col0 + bj * HALF, acc[ai][bj][m][0], acc[ai][bj][m][1]); asm volatile("" ::: "memory"); }
    }
};
__device__ __forceinline__ ::u32x4 pack8(::f32x4 v0, ::f32x4 v1) { ::u32x4 w; w.x = pkbf(v0[0], v0[1]); w.y = pkbf(v0[2], v0[3]); w.z = pkbf(v1[0], v1[1]); w.w = pkbf(v1[2], v1[3]); return w; }
__device__ __forceinline__ void rot8(::f32x4& v0, ::f32x4& v1, const float* cs, const float* sn) {
    const ::f32x4 c = *(const ::f32x4*)cs, s = *(const ::f32x4*)sn;
    ::f32x4 a, b;
    a[0] = v0[0] * c[0] - v0[1] * s[0]; a[1] = v0[0] * s[0] + v0[1] * c[0];
    a[2] = v0[2] * c[1] - v0[3] * s[1]; a[3] = v0[2] * s[1] + v0[3] * c[1];
    b[0] = v1[0] * c[2] - v1[1] * s[2]; b[1] = v1[0] * s[2] + v1[1] * c[2];
    b[2] = v1[2] * c[3] - v1[3] * s[3]; b[3] = v1[2] * s[3] + v1[3] * c[3];
    v0 = a; v1 = b;
}
struct EmPlain { bf16_t* O; int ldc;
    __device__ __forceinline__ void operator()(int row, int col, ::f32x4 v0, ::f32x4 v1) const { *(::u32x4*)(O + (size_t)row * ldc + col) = pack8(v0, v1); } };
struct EmQ { bf16_t* Q; const float* rc; const float* rs;
    __device__ __forceinline__ void operator()(int row, int col, ::f32x4 v0, ::f32x4 v1) const {
        const int o = col % 96;
        if (o >= 64 && row >= MP) { const int t = (row - MP) & 4095, p0 = (o - 64) >> 1; rot8(v0, v1, rc + t * 16 + p0, rs + t * 16 + p0); }
        *(::u32x4*)(Q + (size_t)row * 768 + col) = pack8(v0, v1); } };
struct EmKV { bf16_t* KN; bf16_t* VT;
    __device__ __forceinline__ void operator()(int row, int col, ::f32x4 v0, ::f32x4 v1) const {
        const int h = col >> 7, o = col & 127;
        if (o < 64) { *(::u32x4*)(KN + (size_t)row * 512 + h * 64 + o) = pack8(v0, v1); }
        else { size_t base; int pos, Lk; vt_pos(row, 512, base, pos, Lk); bf16_t* p = VT + base + (size_t)(h * 64 + o - 64) * Lk + pos;
            const ::u32x4 w = pack8(v0, v1);
            p[0] = (bf16_t)(w.x & 0xffff); p[(size_t)Lk] = (bf16_t)(w.x >> 16); p[(size_t)2 * Lk] = (bf16_t)(w.y & 0xffff); p[(size_t)3 * Lk] = (bf16_t)(w.y >> 16);
            p[(size_t)4 * Lk] = (bf16_t)(w.z & 0xffff); p[(size_t)5 * Lk] = (bf16_t)(w.z >> 16); p[(size_t)6 * Lk] = (bf16_t)(w.w & 0xffff); p[(size_t)7 * Lk] = (bf16_t)(w.w >> 16); } } };
struct EmFFN { bf16_t* O;
    __device__ __forceinline__ void operator()(int row, int col, ::f32x4 v0, ::f32x4 v1) const {
        ::u32x2 w; w.x = pkbf(silu_f(v0[0]) * v1[0], silu_f(v0[1]) * v1[1]); w.y = pkbf(silu_f(v0[2]) * v1[2], silu_f(v0[3]) * v1[3]);
        *(::u32x2*)(O + (size_t)row * FFH + (col >> 1)) = w; } };
struct EmQKV { bf16_t* QD; bf16_t* KD; bf16_t* VT; float* odk; float* odv; const float* rc; const float* rs;
    __device__ __forceinline__ void operator()(int row, int col, ::f32x4 v0, ::f32x4 v1) const {
        if (col < 2048) {
            const int cc = col & 1023;
            if (col >= 1024 && row < MP) { float* o = odk + (size_t)row * 1024 + cc; *(::f32x4*)o = v0; *(::f32x4*)(o + 4) = v1; }
            if (row >= MP) { const int t = (row - MP) & 4095, p0 = (cc & 63) >> 1; rot8(v0, v1, rc + t * 32 + p0, rs + t * 32 + p0); }
            if (col < 1024) *(::u32x4*)(QD + (size_t)row * 1024 + cc) = pack8(v0, v1);
            else *(::u32x4*)(KD + (size_t)key_row(row) * 1024 + cc) = pack8(v0, v1);
        } else {
            const int cc = col - 2048;
            if (row < MP) { float* o = odv + (size_t)row * 1024 + cc; *(::f32x4*)o = v0; *(::f32x4*)(o + 4) = v1; }
            size_t base; int pos, Lk; vt_pos(key_row(row), 1024, base, pos, Lk); bf16_t* p = VT + base + (size_t)cc * Lk + pos;
            const ::u32x4 w = pack8(v0, v1);
            p[0] = (bf16_t)(w.x & 0xffff); p[(size_t)Lk] = (bf16_t)(w.x >> 16); p[(size_t)2 * Lk] = (bf16_t)(w.y & 0xffff); p[(size_t)3 * Lk] = (bf16_t)(w.y >> 16);
            p[(size_t)4 * Lk] = (bf16_t)(w.z & 0xffff); p[(size_t)5 * Lk] = (bf16_t)(w.z >> 16); p[(size_t)6 * Lk] = (bf16_t)(w.w & 0xffff); p[(size_t)7 * Lk] = (bf16_t)(w.w >> 16);
        } } };
template <class F> __device__ __forceinline__ void run_gemm(PG8_LAS unsigned char* lds, const bf16_t* A, const bf16_t* Bt, int M, int N, int K, const F& f) {
    asm volatile("" : "+s"(M), "+s"(N), "+s"(K));
    Gemm g{A, Bt, M, N, K}; StaticOrder S; S.init(M, N, (int)gridDim.x, (int)blockIdx.x);
    Epi8<F> E{f};
    gemm_phase<Epi8<F>, StaticOrder, true, true>(lds, g, S, E);
}
}

template <int MAPMODE> __device__ __forceinline__ int wrow_map(int n) {
    if (MAPMODE == 1) { return n < FFH ? 8 * (n >> 2) + (n & 3) : 8 * ((n - FFH) >> 2) + 4 + ((n - FFH) & 3); }
    return n;
}
template <int MAPMODE> __device__ __forceinline__ void transpose_item(const float* W, int K, int N, bf16* WT, LAS float* scr, int item, int lane) {
    const int nblk = N / 32, kb = item / nblk, nb = item % nblk, k0 = 64 * kb, n0 = 32 * nb;
#pragma unroll 8
    for (int i = 0; i < 32; ++i) { const int kk = 2 * i + (lane >> 5); scr[kk * 33 + (lane & 31)] = W[(size_t)(k0 + kk) * N + n0 + (lane & 31)]; }
    asm volatile("s_waitcnt lgkmcnt(0)" ::: "memory");
    const int c = lane & 7;
#pragma unroll
    for (int j = 0; j < 4; ++j) { const int n = (lane >> 3) + 8 * j; const LAS float* s = scr + (8 * c) * 33 + n;
        u32x4 o; o.x = pkbf(s[0 * 33], s[1 * 33]); o.y = pkbf(s[2 * 33], s[3 * 33]); o.z = pkbf(s[4 * 33], s[5 * 33]); o.w = pkbf(s[6 * 33], s[7 * 33]);
        *(u32x4*)(WT + (size_t)wrow_map<MAPMODE>(n0 + n) * K + k0 + 8 * c) = o; }
    asm volatile("s_waitcnt lgkmcnt(0)" ::: "memory");
}

__device__ __forceinline__ void phase0(const Params& P, ldsp lds) {
    const int tid = tid_opaque(), lane = tid & 63, wave = tid >> 6, G = gridDim.x, bid = blockIdx.x;
    unsigned char* ws = P.wsp();
    {
        LAS float* sc = (LAS float*)lds;
        LAS float* red = (LAS float*)(lds + 9 * 1024 * 4);
        for (int e = tid; e < 9 * 1024; e += 512) { const int ci = e >> 10, k = e & 1023; const float v = ci == 0 ? P.inp(I_CCTX)[k] : P.inp(I_C)[(ci - 1) * 1024 + k]; sc[e] = silu_f(v); }
        __syncthreads();
        float* MOD = (float*)(ws + WS_MOD);
        for (int item = bid; item < 192; item += G) {
            const int li = item / 96, j0 = (item % 96) * 64;
            const float* wm = P.inp(I_WMOD) + (size_t)li * 1024 * 6144 + j0 + lane;
            float acc[9];
#pragma unroll
            for (int c = 0; c < 9; ++c) acc[c] = 0.f;
            const int kbeg = wave * 128;
#pragma unroll 4
            for (int k = kbeg; k < kbeg + 128; ++k) { const float wv = wm[(size_t)k * 6144];
#pragma unroll
                for (int c = 0; c < 9; ++c) acc[c] += sc[c * 1024 + k] * wv; }
#pragma unroll
            for (int c = 0; c < 9; ++c) red[(wave * 9 + c) * 64 + lane] = acc[c];
            __syncthreads();
            for (int e = tid; e < 576; e += 512) { const int c = e >> 6, l = e & 63; float s = 0.f;
#pragma unroll
                for (int w = 0; w < 8; ++w) s += red[(w * 9 + c) * 64 + l];
                MOD[((size_t)li * 9 + c) * 6144 + j0 + l] = s + P.inp(I_BMOD)[li * 6144 + j0 + l]; }
            __syncthreads();
        }
    }
    __syncthreads();
    {
        LAS float* scr = (LAS float*)(lds + wave * 16384);
        const int gw = bid * 8 + wave, NGW = G * 8;
        constexpr int I1 = 16 * 86, I2 = 6 * 24, I3 = 4 * 32, I4 = 16 * 32, I5 = 16 * 96, I6 = 16 * 32, I7 = 16 * 176, I8 = 44 * 32;
        constexpr int NIT = I1 + I2 + I3 + I4 + I5 + I6 + 2 * I7 + 2 * I8;
        for (int it = gw; it < NIT; it += NGW) {
            int r = it;
            if (r < I1) { transpose_item<0>(P.inp(I_ABWIN), 1024, 2752, (bf16*)(ws + W_IN), scr, r, lane); continue; } r -= I1;
            if (r < I2) { transpose_item<0>(P.inp(I_WUQ), 384, 768, (bf16*)(ws + W_UQ), scr, r, lane); continue; } r -= I2;
            if (r < I3) { transpose_item<0>(P.inp(I_WUKV), 256, 1024, (bf16*)(ws + W_UKV), scr, r, lane); continue; } r -= I3;
            if (r < I4) { transpose_item<0>(P.inp(I_ABWOUT), 1024, 1024, (bf16*)(ws + W_ABO), scr, r, lane); continue; } r -= I4;
            if (r < I5) { transpose_item<0>(P.inp(I_CWQKV), 1024, 3072, (bf16*)(ws + W_QKV), scr, r, lane); continue; } r -= I5;
            if (r < I6) { transpose_item<0>(P.inp(I_CWOUT), 1024, 1024, (bf16*)(ws + W_CO), scr, r, lane); continue; } r -= I6;
            if (r < 2 * I7) { const int li = r / I7; transpose_item<1>(P.inp(I_WF1) + (size_t)li * 1024 * 5632, 1024, 5632, (bf16*)(ws + W_F1 + (size_t)li * 11 * MiB), scr, r % I7, lane); continue; } r -= 2 * I7;
            { const int li = r / I8; transpose_item<0>(P.inp(I_WF2) + (size_t)li * 2816 * 1024, 2816, 1024, (bf16*)(ws + W_F2 + (size_t)li * 2816 * 1024 * 2), scr, r % I8, lane); }
        }
    }
    const int gt = bid * 512 + tid, NT = G * 512;
    { u32x4* z = (u32x4*)(ws + W_IN + (size_t)2752 * 1024 * 2); for (int e = gt; e < 64 * 1024 * 2 / 16; e += NT) z[e] = (u32x4){0u, 0u, 0u, 0u}; }
    {
        float* rmc = (float*)(ws + WS_RM_COS); float* rms = (float*)(ws + WS_RM_SIN); float* rdc = (float*)(ws + WS_RD_COS); float* rds = (float*)(ws + WS_RD_SIN);
        for (int e = gt; e < 4096 * 16 + 4096 * 32; e += NT) {
            const bool isd = e >= 4096 * 16; const int ee = isd ? e - 4096 * 16 : e; const int np = isd ? 32 : 16, nf = np >> 1;
            const int t = ee / np, p = ee % np; const int fi = p % nf; const float posv = (float)(p < nf ? (t >> 6) : (t & 63));
            const float inv = exp2f(-(float)fi / (float)nf * 13.287712379549449f);
            const float ang = posv * inv; float rev = ang * 0.15915494309189535f; rev -= rintf(rev);
            const float sn = __builtin_amdgcn_sinf(rev), cs = __builtin_amdgcn_cosf(rev);
            if (isd) { rdc[ee] = cs; rds[ee] = sn; } else { rmc[ee] = cs; rms[ee] = sn; }
        }
    }
    if (bid == 0 && wave == 0) {
        const float* lp = P.inp(I_DLAM);
        const float a = wave_sum(lp[lane] * lp[64 + lane]), b = wave_sum(lp[128 + lane] * lp[192 + lane]);
        if (lane == 0) *(float*)(ws + WS_LAM) = __expf(a) - __expf(b) + LAM_INIT;
    }
}

__device__ __forceinline__ void norm_mod_store(const f32x4 (&v)[4], float ss, const float* g, const float* scale, const float* shift, bf16* hrow, int lane) {
    const float r = 1.f / sqrtf(ss * (1.f / 1024.f) + EPS);
#pragma unroll
    for (int j = 0; j < 4; ++j) { const int c = 4 * lane + 256 * j;
        const f32x4 gg = *(const f32x4*)(g + c), sc = *(const f32x4*)(scale + c), sh = *(const f32x4*)(shift + c);
        const f32x4 h = v[j] * r * gg * (sc + 1.f) + sh;
        u32x2 w; w.x = pkbf(h[0], h[1]); w.y = pkbf(h[2], h[3]); *(u32x2*)(hrow + c) = w; }
}
__device__ __forceinline__ void phase_norm0(const Params& P) {
    const int tid = tid_opaque(), lane = tid & 63, gw = blockIdx.x * 8 + (tid >> 6), NGW = gridDim.x * 8;
    const float* MOD = (const float*)(P.wsp() + WS_MOD); bf16* H = (bf16*)(P.wsp() + A_H);
    for (int row = gw; row < MT; row += NGW) {
        const float* x = xrow_in(P, row); const float* md = MOD + (size_t)(0 * 9 + cond_of(row)) * 6144;
        f32x4 v[4]; float ss = 0.f;
#pragma unroll
        for (int j = 0; j < 4; ++j) { v[j] = *(const f32x4*)(x + 4 * lane + 256 * j); ss += v[j][0] * v[j][0] + v[j][1] * v[j][1] + v[j][2] * v[j][2] + v[j][3] * v[j][3]; }
        ss = wave_sum(ss);
        norm_mod_store(v, ss, P.inp(I_GNORM) + 0, md + 1024, md + 0, H + (size_t)row * DM, lane);
    }
}
__device__ __forceinline__ void phase_resnorm(const Params& P, bool first, int liA, int gA, int gateIdx, bool doH, int liB, int gB, int scaleIdx, int shiftIdx) {
    const int tid = tid_opaque(), lane = tid & 63, gw = blockIdx.x * 8 + (tid >> 6), NGW = gridDim.x * 8;
    const float* MOD = (const float*)(P.wsp() + WS_MOD); bf16* H = (bf16*)(P.wsp() + A_H); const bf16* OUT = (const bf16*)(P.wsp() + R_OUT);
    float* X = P.outp() + O_Y;
    const float* ga = P.inp(I_GNORM) + (liA * 4 + gA) * 1024;
    constexpr int NR = 3;
    for (int row0 = gw; row0 < MT; row0 += NR * NGW) {
        int rows[NR];
#pragma unroll
        for (int u = 0; u < NR; ++u) rows[u] = row0 + u * NGW;
        f32x4 o[NR][4], v[NR][4]; float so[NR];
#pragma unroll
        for (int u = 0; u < NR; ++u) so[u] = 0.f;
#pragma unroll
        for (int u = 0; u < NR; ++u) { if (rows[u] >= MT) break; const int row = rows[u];
            const float* xo = first ? xrow_in(P, row) : X + (size_t)row * DM;
#pragma unroll
            for (int j = 0; j < 4; ++j) { const u32x2 w = *(const u32x2*)(OUT + (size_t)row * DM + 4 * lane + 256 * j);
                o[u][j] = (f32x4){bf_lo(w.x), bf_hi(w.x), bf_lo(w.y), bf_hi(w.y)}; v[u][j] = *(const f32x4*)(xo + 4 * lane + 256 * j); } }
#pragma unroll
        for (int u = 0; u < NR; ++u) { if (rows[u] >= MT) break;
#pragma unroll
            for (int j = 0; j < 4; ++j) so[u] += o[u][j][0] * o[u][j][0] + o[u][j][1] * o[u][j][1] + o[u][j][2] * o[u][j][2] + o[u][j][3] * o[u][j][3]; }
#pragma unroll
        for (int off = 1; off < 64; off <<= 1) {
#pragma unroll
            for (int u = 0; u < NR; ++u) so[u] += __shfl_xor(so[u], off); }
        float ss[NR];
#pragma unroll
        for (int u = 0; u < NR; ++u) ss[u] = 0.f;
#pragma unroll
        for (int u = 0; u < NR; ++u) { if (rows[u] >= MT) break; const int row = rows[u];
            const float* gate = MOD + (size_t)(liA * 9 + cond_of(row)) * 6144 + gateIdx * 1024; const float ro = 1.f / sqrtf(so[u] * (1.f / 1024.f) + EPS);
#pragma unroll
            for (int j = 0; j < 4; ++j) { const int c = 4 * lane + 256 * j; const f32x4 gg = *(const f32x4*)(ga + c), gt = *(const f32x4*)(gate + c);
                v[u][j] = v[u][j] + gt * (o[u][j] * ro * gg); ss[u] += v[u][j][0] * v[u][j][0] + v[u][j][1] * v[u][j][1] + v[u][j][2] * v[u][j][2] + v[u][j][3] * v[u][j][3];
                *(f32x4*)(X + (size_t)row * DM + c) = v[u][j]; } }
        if (doH) {
#pragma unroll
            for (int off = 1; off < 64; off <<= 1) {
#pragma unroll
                for (int u = 0; u < NR; ++u) ss[u] += __shfl_xor(ss[u], off); }
#pragma unroll
            for (int u = 0; u < NR; ++u) { if (rows[u] >= MT) break; const int row = rows[u]; const float* mdB = MOD + (size_t)(liB * 9 + cond_of(row)) * 6144;
                norm_mod_store(v[u], ss[u], P.inp(I_GNORM) + (liB * 4 + gB) * 1024, mdB + scaleIdx * 1024, mdB + shiftIdx * 1024, H + (size_t)row * DM, lane); }
        }
    }
}
__device__ __forceinline__ void phase_mla_prep(const Params& P) {
    const int tid = tid_opaque(), lane = tid & 63, gw = blockIdx.x * 8 + (tid >> 6), NGW = gridDim.x * 8;
    unsigned char* ws = P.wsp(); const bf16* PROJ = (const bf16*)(ws + B_PROJ); bf16* QLN = (bf16*)(ws + A_QLN); bf16* CKV = (bf16*)(ws + A_CKV); bf16* KROPE = (bf16*)(ws + R_KROPE);
    const float* rmc = (const float*)(ws + WS_RM_COS); const float* rms = (const float*)(ws + WS_RM_SIN);
    for (int row = gw; row < MT; row += NGW) {
        const bf16* pr = PROJ + (size_t)row * PJ; const int kr = key_row(row);
        float q[6]; float ss = 0.f;
#pragma unroll
        for (int j = 0; j < 3; ++j) { const unsigned w = *(const unsigned*)(pr + C_QLAT + 2 * lane + 128 * j); q[2 * j] = bf_lo(w); q[2 * j + 1] = bf_hi(w); ss += q[2 * j] * q[2 * j] + q[2 * j + 1] * q[2 * j + 1]; }
        ss = wave_sum(ss); const float rq = 1.f / sqrtf(ss * (1.f / 384.f) + EPS);
#pragma unroll
        for (int j = 0; j < 3; ++j) { const int c = 2 * lane + 128 * j; *(unsigned*)(QLN + (size_t)row * 384 + c) = pkbf(q[2 * j] * rq * P.inp(I_GQ)[c], q[2 * j + 1] * rq * P.inp(I_GQ)[c + 1]); }
        const u32x2 w = *(const u32x2*)(pr + C_KVLAT + 4 * lane); f32x4 kv = (f32x4){bf_lo(w.x), bf_hi(w.x), bf_lo(w.y), bf_hi(w.y)};
        float s2 = wave_sum(kv[0] * kv[0] + kv[1] * kv[1] + kv[2] * kv[2] + kv[3] * kv[3]); const float rk = 1.f / sqrtf(s2 * (1.f / 256.f) + EPS);
        kv = kv * rk * *(const f32x4*)(P.inp(I_GKV) + 4 * lane);
        { u32x2 o; o.x = pkbf(kv[0], kv[1]); o.y = pkbf(kv[2], kv[3]); *(u32x2*)(CKV + (size_t)kr * 256 + 4 * lane) = o; }
        if (row < MP) *(f32x4*)(P.outp() + O_CKV + (size_t)row * 256 + 4 * lane) = kv;
        if (lane < 16) { const unsigned wr = *(const unsigned*)(pr + C_KROPE + 2 * lane); float e = bf_lo(wr), od = bf_hi(wr);
            if (row < MP) { *(f32x2*)(P.outp() + O_KROPE + (size_t)row * 32 + 2 * lane) = (f32x2){e, od}; }
            else { const int t = (row - MP) & 4095; const float c = rmc[t * 16 + lane], s = rms[t * 16 + lane]; const float ne = e * c - od * s, no = e * s + od * c; e = ne; od = no; }
            *(unsigned*)(KROPE + (size_t)kr * 32 + 2 * lane) = pkbf(e, od); }
    }
    const int gt = blockIdx.x * 512 + tid, NT = gridDim.x * 512;
    for (int i = gt; i < 4096 * 256 / 4; i += NT) { const int e = i * 4, sr = e >> 8, col = e & 255; const int dr = MP + (sr >> 9) * 4608 + (sr & 511);
        const f32x4 v = *(const f32x4*)(P.inp(I_CKV) + e); u32x2 o; o.x = pkbf(v[0], v[1]); o.y = pkbf(v[2], v[3]); *(u32x2*)(CKV + (size_t)dr * 256 + col) = o; }
    for (int i = gt; i < 4096 * 32 / 4; i += NT) { const int e = i * 4, sr = e >> 5, col = e & 31; const int dr = MP + (sr >> 9) * 4608 + (sr & 511);
        const f32x4 v = *(const f32x4*)(P.inp(I_CKROPE) + e); u32x2 o; o.x = pkbf(v[0], v[1]); o.y = pkbf(v[2], v[3]); *(u32x2*)(KROPE + (size_t)dr * 32 + col) = o; }
}
__device__ __forceinline__ void phase_diff_ctx(const Params& P) {
    const int gt = blockIdx.x * 512 + tid_opaque(), NT = gridDim.x * 512;
    bf16* KD = (bf16*)(P.wsp() + B_KD); bf16* VT = (bf16*)(P.wsp() + R_VTD);
    for (int i = gt; i < 4096 * 1024 / 4; i += NT) { const int e = i * 4, sr = e >> 10, col = e & 1023; const int dr = MP + (sr >> 9) * 4608 + (sr & 511);
        const f32x4 v = *(const f32x4*)(P.inp(I_CDK) + e); u32x2 o; o.x = pkbf(v[0], v[1]); o.y = pkbf(v[2], v[3]); *(u32x2*)(KD + (size_t)dr * 1024 + col) = o; }
    for (int i = gt; i < 8 * 64 * 1024; i += NT) { const int hd = i & 1023, jg = (i >> 10) & 63, b = i >> 16;
        const float* src = P.inp(I_CDV) + ((size_t)(b * 512 + jg * 8)) * 1024 + hd; float f[8];
#pragma unroll
        for (int k = 0; k < 8; ++k) f[k] = src[(size_t)k * 1024];
        u32x4 o; o.x = pkbf(f[0], f[1]); o.y = pkbf(f[2], f[3]); o.z = pkbf(f[4], f[5]); o.w = pkbf(f[6], f[7]);
        *(u32x4*)(VT + (size_t)16 * 1024 * 256 + (size_t)b * 1024 * 4608 + (size_t)hd * 4608 + jg * 8) = o; }
}

__device__ __forceinline__ f32x16 mfma32(bf16x8 a, bf16x8 b, f32x16 c) { return __builtin_amdgcn_mfma_f32_32x32x16_bf16(a, b, c, 0, 0, 0); }
__device__ __forceinline__ f32x4 mfma16(bf16x8 a, bf16x8 b, f32x4 c) { return __builtin_amdgcn_mfma_f32_16x16x32_bf16(a, b, c, 0, 0, 0); }
__device__ __forceinline__ bf16x8 pack_bf8(float a0, float a1, float a2, float a3, float a4, float a5, float a6, float a7) {
    u32x4 w; w.x = pkbf(a0, a1); w.y = pkbf(a2, a3); w.z = pkbf(a4, a5); w.w = pkbf(a6, a7); return __builtin_bit_cast(bf16x8, w);
}
constexpr int VSTR = 144;
template <int MODE> struct AttnArgs {
    const bf16* Q; const bf16* K; const bf16* K2; const bf16* VTh; bf16* MIX; int row0, krow0, Lk, h; float lam; const float* gout;
};
__device__ __forceinline__ float max3f(float a, float b, float c) { float r; asm("v_max3_f32 %0, %1, %2, %3" : "=v"(r) : "v"(a), "v"(b), "v"(c)); return r; }
template <int MODE> __device__ __forceinline__ void attn_unit(ldsp lds, const AttnArgs<MODE>& A) {
    constexpr int ND = MODE == 0 ? 6 : 4, NMB = MODE == 0 ? 2 : 4, KSTR = MODE == 0 ? 208 : 272, DV = MODE == 0 ? 64 : 128;
    constexpr int KBUF = 64 * KSTR, VBUF = DV * VSTR;
    constexpr float CS = (MODE == 0 ? 0.10206207261596577f : 0.125f) * 1.4426950408889634f;
    const int tid = tid_opaque(), lane = tid & 63, r32 = lane & 31, hi = lane >> 5, wid = tid >> 6;
    const int map = MODE == 1 ? (wid >> 2) : 0;
    const int qrow = A.row0 + (MODE == 0 ? wid * 32 : (wid & 3) * 32) + r32;
    constexpr bool QLDS = MODE == 1;
    constexpr int QST_OFF = 2 * KBUF + 2 * VBUF;
    bf16x8 qf[ND];
#pragma unroll
    for (int d0 = 0; d0 < ND; ++d0) {
        const u32x4 w = MODE == 0 ? *(const u32x4*)(A.Q + (size_t)qrow * 768 + A.h * 96 + 16 * d0 + 8 * hi) : *(const u32x4*)(A.Q + (size_t)qrow * 1024 + A.h * 128 + map * 64 + 16 * d0 + 8 * hi);
        u32x4 s; s.x = pkbf(bf_lo(w.x) * CS, bf_hi(w.x) * CS); s.y = pkbf(bf_lo(w.y) * CS, bf_hi(w.y) * CS); s.z = pkbf(bf_lo(w.z) * CS, bf_hi(w.z) * CS); s.w = pkbf(bf_lo(w.w) * CS, bf_hi(w.w) * CS);
        if (QLDS) *(LAS u32x4*)(lds + QST_OFF + wid * 4608 + r32 * 144 + hi * 16 + d0 * 32) = s; else qf[d0] = __builtin_bit_cast(bf16x8, s);
    }
    const int koff = r32 * KSTR + (MODE == 1 ? map * 128 : 0) + hi * 16;
    const int voff = r32 * VSTR + hi * 16;
    f32x16 o[NMB];
#pragma unroll
    for (int mb = 0; mb < NMB; ++mb) o[mb] = (f32x16){0.f, 0.f, 0.f, 0.f, 0.f, 0.f, 0.f, 0.f, 0.f, 0.f, 0.f, 0.f, 0.f, 0.f, 0.f, 0.f};
    float m_run = 0.f, l_run = 0.f;
    f32x16 negm = (f32x16){0.f, 0.f, 0.f, 0.f, 0.f, 0.f, 0.f, 0.f, 0.f, 0.f, 0.f, 0.f, 0.f, 0.f, 0.f, 0.f};
    const int NT = A.Lk >> 6;
    u32x4 rk0[2], rk1[2], rv0[2], rv1[2];
    const bf16* kg0; const bf16* kg1; const bf16* vg0; const bf16* vg1;
    if (MODE == 0) { kg0 = A.K + (size_t)(A.krow0 + (tid >> 3)) * 512 + A.h * 64 + (tid & 7) * 8; kg1 = A.K2 + (size_t)(A.krow0 + ((tid & 255) >> 2)) * 32 + (tid & 3) * 8;
                     vg0 = A.VTh + (size_t)(tid >> 3) * A.Lk + (tid & 7) * 8; vg1 = vg0; }
    else { kg0 = A.K + (size_t)(A.krow0 + (tid >> 4)) * 1024 + A.h * 128 + (tid & 15) * 8; kg1 = kg0;
           vg0 = A.VTh + (size_t)(tid >> 3) * A.Lk + (tid & 7) * 8; vg1 = vg0; }
    auto gloadK = [&](int t, const int s) {
        if (MODE == 0) { rk0[s] = *(const u32x4*)(kg0 + (size_t)t * 64 * 512); if (tid < 256) rk1[s] = *(const u32x4*)(kg1 + (size_t)t * 64 * 32); }
        else { const bf16* kp = kg0 + (size_t)t * 64 * 1024; rk0[s] = *(const u32x4*)kp; rk1[s] = *(const u32x4*)(kp + (size_t)32 * 1024); }
    };
    auto gloadV = [&](int t, const int s) { const bf16* vp = vg0 + 64 * t; rv0[s] = *(const u32x4*)vp; if (MODE == 1) rv1[s] = *(const u32x4*)(vp + (size_t)64 * A.Lk); };
    auto stK = [&](int buf, const int s) {
        ldsp kb = lds + buf * KBUF;
        if (MODE == 0) { *(LAS u32x4*)(kb + (tid >> 3) * KSTR + (tid & 7) * 16) = rk0[s]; if (tid < 256) *(LAS u32x4*)(kb + (tid >> 2) * KSTR + 128 + (tid & 3) * 16) = rk1[s]; }
        else { *(LAS u32x4*)(kb + (tid >> 4) * KSTR + (tid & 15) * 16) = rk0[s]; *(LAS u32x4*)(kb + (32 + (tid >> 4)) * KSTR + (tid & 15) * 16) = rk1[s]; }
    };
    auto stV = [&](int buf, const int s) {
        ldsp vb = lds + 2 * KBUF + buf * VBUF;
        const int cc = tid & 7, vpo = ((cc >> 1) * 16 + (cc & 1) * 4) * 2;
        LAS u32x2* vp = (LAS u32x2*)(vb + (tid >> 3) * VSTR + vpo); vp[0] = (u32x2){rv0[s].x, rv0[s].y}; vp[2] = (u32x2){rv0[s].z, rv0[s].w};
        if (MODE == 1) { LAS u32x2* vq = (LAS u32x2*)(vb + (64 + (tid >> 3)) * VSTR + vpo); vq[0] = (u32x2){rv1[s].x, rv1[s].y}; vq[2] = (u32x2){rv1[s].z, rv1[s].w}; }
    };
    auto qk = [&](int buf, f32x16& s0, f32x16& s1) {
        ldsp kb = lds + buf * KBUF;
        s0 = negm; s1 = negm;
#pragma unroll
        for (int d0 = 0; d0 < ND; ++d0) {
            const bf16x8 a0 = *(const LAS bf16x8*)(kb + koff + d0 * 32), a1 = *(const LAS bf16x8*)(kb + koff + 32 * KSTR + d0 * 32);
            const bf16x8 qq = QLDS ? *(const LAS bf16x8*)(lds + QST_OFF + wid * 4608 + r32 * 144 + hi * 16 + d0 * 32) : qf[d0];
            s0 = mfma32(a0, qq, s0); s1 = mfma32(a1, qq, s1);
        }
    };
    bf16x8 pf[4];
    f32x16 sc0, sc1;
    float mxa, mxb;
    auto mxstep = [&](int k) {
        if (k == 0) mxa = max3f(sc0[0], sc0[1], sc1[0]);
        else if (k == 1) mxb = max3f(sc0[2], sc0[3], sc1[1]);
        else if (k == 2) mxa = max3f(mxa, sc1[2], sc1[3]);
        else if (k < 15) { const int q = k - 3, r = 4 + 4 * (q >> 2), w = q & 3;
            if (w == 0) mxa = max3f(mxa, sc0[r], sc0[r + 1]); else if (w == 1) mxb = max3f(mxb, sc0[r + 2], sc0[r + 3]);
            else if (w == 2) mxa = max3f(mxa, sc1[r], sc1[r + 1]); else mxb = max3f(mxb, sc1[r + 2], sc1[r + 3]); }
        else mxa = max3f(mxa, mxb, mxb);
    };
    constexpr int NS = 2 * NMB, NH = NS / 2;
    auto ldv = [&](ldsp vb, int s, bf16x8 (&dst)[2]) __attribute__((always_inline)) {
        const int j = s / (NMB / 2), mp = s % (NMB / 2);
#pragma unroll
        for (int e = 0; e < 2; ++e) { const int mb = 2 * mp + e; dst[e] = *(const LAS bf16x8*)(vb + mb * 32 * VSTR + voff + j * 32); }
    };
    auto pvstep = [&](int s, const bf16x8 (&vfr)[2]) __attribute__((always_inline)) {
        const int j = s / (NMB / 2), mp = s % (NMB / 2);
#pragma unroll
        for (int e = 0; e < 2; ++e) { const int mb = 2 * mp + e; o[mb] = mfma32(vfr[e], pf[j], o[mb]); }
    };
    auto secA = [&](int buf, const bool dopv) __attribute__((always_inline)) {
        if (!dopv) {
#pragma unroll
            for (int k = 0; k < 16; ++k) mxstep(k);
            return;
        }
        ldsp vb = lds + 2 * KBUF + buf * VBUF;
        bf16x8 vf[2][2];
        ldv(vb, 0, vf[0]);
        __builtin_amdgcn_sched_barrier(0);
#pragma unroll
        for (int s = 0; s < NH; ++s) {
            if (s + 1 < NH) { ldv(vb, s + 1, vf[(s + 1) & 1]); __builtin_amdgcn_sched_barrier(0); }
            pvstep(s, vf[s & 1]);
#pragma unroll
            for (int q = 0; q < 16 / NH; ++q) mxstep(s * (16 / NH) + q);
            __builtin_amdgcn_sched_barrier(0);
        }
    };
    auto pv_full = [&](int buf) __attribute__((always_inline)) {
        ldsp vb = lds + 2 * KBUF + buf * VBUF;
        bf16x8 vf[2][2];
        ldv(vb, 0, vf[0]);
        __builtin_amdgcn_sched_barrier(0);
#pragma unroll
        for (int s = 0; s < NS; ++s) {
            if (s + 1 < NS) { ldv(vb, s + 1, vf[(s + 1) & 1]); __builtin_amdgcn_sched_barrier(0); }
            pvstep(s, vf[s & 1]);
            __builtin_amdgcn_sched_barrier(0);
        }
    };
    auto secB = [&](int vbuf, int kbuf, const bool dopv, const bool doqk, f32x16& sn0, f32x16& sn1) __attribute__((always_inline)) {
        ldsp vb = lds + 2 * KBUF + vbuf * VBUF; ldsp kb = lds + kbuf * KBUF;
        float rs = 0.f;
        auto exps4 = [&](int g) __attribute__((always_inline)) {
#pragma unroll
            for (int i = 0; i < 4; ++i) { const int idx = 4 * g + i;
                if (idx < 16) { sc0[idx] = fast_exp2(sc0[idx]); rs += sc0[idx]; } else { sc1[idx - 16] = fast_exp2(sc1[idx - 16]); rs += sc1[idx - 16]; } }
        };
        bf16x8 vf[2][2], ka[2][2], qq[2];
        auto ldk = [&](int d0, bf16x8 (&kd)[2], bf16x8& qd) __attribute__((always_inline)) {
            kd[0] = *(const LAS bf16x8*)(kb + koff + d0 * 32); kd[1] = *(const LAS bf16x8*)(kb + koff + 32 * KSTR + d0 * 32);
            qd = QLDS ? *(const LAS bf16x8*)(lds + QST_OFF + wid * 4608 + r32 * 144 + hi * 16 + d0 * 32) : qf[d0];
        };
        const int gq = dopv ? NH : 0;
        if (dopv) {
            ldv(vb, NH, vf[NH & 1]);

#pragma unroll
            for (int s = NH; s < NS; ++s) {
                if (s + 1 < NS) ldv(vb, s + 1, vf[(s + 1) & 1]); else if (doqk) ldk(0, ka[0], qq[0]);

                pvstep(s, vf[s & 1]);
                exps4(s - NH);

            }
        } else if (doqk) { ldk(0, ka[0], qq[0]);  }
        if (doqk) {
            sn0 = negm; sn1 = negm;
#pragma unroll
            for (int d0 = 0; d0 < ND; ++d0) {
                if (d0 + 1 < ND) { ldk(d0 + 1, ka[(d0 + 1) & 1], qq[(d0 + 1) & 1]);  }
                sn0 = mfma32(ka[d0 & 1][0], qq[d0 & 1], sn0); sn1 = mfma32(ka[d0 & 1][1], qq[d0 & 1], sn1);
                if (gq + d0 < 8) exps4(gq + d0);

            }
        }
#pragma unroll
        for (int g = gq + (doqk ? ND : 0); g < 8; ++g) exps4(g);
        l_run += rs;
        pf[0] = pack_bf8(sc0[0], sc0[1], sc0[2], sc0[3], sc0[4], sc0[5], sc0[6], sc0[7]); pf[1] = pack_bf8(sc0[8], sc0[9], sc0[10], sc0[11], sc0[12], sc0[13], sc0[14], sc0[15]);
        pf[2] = pack_bf8(sc1[0], sc1[1], sc1[2], sc1[3], sc1[4], sc1[5], sc1[6], sc1[7]); pf[3] = pack_bf8(sc1[8], sc1[9], sc1[10], sc1[11], sc1[12], sc1[13], sc1[14], sc1[15]);
    };
    constexpr bool K2 = MODE == 0;
    if (K2) { gloadK(0, 0); gloadK(1, 1); stK(0, 0); gloadK(2, 0); gloadV(0, 0); }
    else { gloadK(0, 0); stK(0, 0); gloadK(1, 0); gloadV(0, 0); }
    __syncthreads();
    qk(0, sc0, sc1);
    if (K2) stK(1, 1); else stK(1, 0);
    __syncthreads();
    auto iter = [&](int t, const int par, const bool first, const bool last) __attribute__((always_inline)) {
        if (K2) { if (t + 3 < NT) gloadK(t + 3, par ^ 1); } else { if (t + 2 < NT) gloadK(t + 2, 0); }
        if (!last) gloadV(t + 1, par ^ 1);
        if (K2) { if (!last) { if (t + 2 < NT) stK(par, par); } }
        stV(par, par);
        secA(par ^ 1, !first);
        float mx = fmaxf(mxa, __shfl_xor(mxa, 32));
        if (first || __any(mx > 8.f)) {
            const float dl = first ? mx : fmaxf(mx, 0.f), alpha = fast_exp2(-dl); m_run += dl; l_run *= alpha;
#pragma unroll
            for (int mb = 0; mb < NMB; ++mb)
#pragma unroll
                for (int r = 0; r < 16; ++r) o[mb][r] *= alpha;
#pragma unroll
            for (int r = 0; r < 16; ++r) { sc0[r] -= dl; sc1[r] -= dl; negm[r] = -m_run; }
            if (!first) {
#pragma unroll
                for (int j = 0; j < 4; ++j) { const u32x4 w = __builtin_bit_cast(u32x4, pf[j]); u32x4 z;
                    z.x = pkbf(bf_lo(w.x) * alpha, bf_hi(w.x) * alpha); z.y = pkbf(bf_lo(w.y) * alpha, bf_hi(w.y) * alpha); z.z = pkbf(bf_lo(w.z) * alpha, bf_hi(w.z) * alpha); z.w = pkbf(bf_lo(w.w) * alpha, bf_hi(w.w) * alpha);
                    pf[j] = __builtin_bit_cast(bf16x8, z); }
            }
        }
        f32x16 sn0, sn1;
        secB(par ^ 1, par ^ 1, !first, !last, sn0, sn1);
        if (!last) { if (!K2) { if (t + 2 < NT) stK(par, 0); } sc0 = sn0; sc1 = sn1; }
        __syncthreads();
    };
    iter(0, 0, true, false);
    iter(1, 1, false, false);
    for (int t = 2; t < NT - 2; t += 2) { iter(t, 0, false, false); iter(t + 1, 1, false, false); }
    iter(NT - 2, 0, false, false);
    iter(NT - 1, 1, false, true);
    pv_full(1);
    l_run += __shfl_xor(l_run, 32);
    const float inv = 1.f / l_run;
    __syncthreads();
    if (MODE == 0) {
        bf16* orow = A.MIX + (size_t)qrow * 1024 + A.h * 64;
#pragma unroll
        for (int mb = 0; mb < NMB; ++mb)
#pragma unroll
            for (int g = 0; g < 4; ++g) { u32x2 w; w.x = pkbf(o[mb][4 * g] * inv, o[mb][4 * g + 1] * inv); w.y = pkbf(o[mb][4 * g + 2] * inv, o[mb][4 * g + 3] * inv);
                *(u32x2*)(orow + 32 * mb + 8 * g + 4 * hi) = w; }
    } else {
        LAS float* xb = (LAS float*)lds + (size_t)(wid & 3) * 64 * 64;
        if (wid >= 4) {
#pragma unroll
            for (int mb = 0; mb < NMB; ++mb)
#pragma unroll
                for (int r = 0; r < 16; ++r) xb[(mb * 16 + r) * 64 + lane] = o[mb][r] * inv;
        }
        __syncthreads();
        if (wid < 4) {
            float ss = 0.f;
#pragma unroll
            for (int mb = 0; mb < NMB; ++mb)
#pragma unroll
                for (int r = 0; r < 16; ++r) { const float v = o[mb][r] * inv - A.lam * xb[(mb * 16 + r) * 64 + lane]; o[mb][r] = v; ss += v * v; }
            ss += __shfl_xor(ss, 32);
            const float rr = (1.f - LAM_INIT) / sqrtf(ss * (1.f / 128.f) + EPS);
            bf16* orow = A.MIX + (size_t)qrow * 1024 + A.h * 128;
#pragma unroll
            for (int mb = 0; mb < NMB; ++mb)
#pragma unroll
                for (int g = 0; g < 4; ++g) { const int d = 32 * mb + 8 * g + 4 * hi; const f32x4 gg = *(const f32x4*)(A.gout + d);
                    u32x2 w; w.x = pkbf(o[mb][4 * g] * rr * gg[0], o[mb][4 * g + 1] * rr * gg[1]); w.y = pkbf(o[mb][4 * g + 2] * rr * gg[2], o[mb][4 * g + 3] * rr * gg[3]);
                    *(u32x2*)(orow + d) = w; }
        }
        __syncthreads();
    }
}

__device__ __forceinline__ float logsig(float x) { return fminf(x, 0.f) - __logf(1.f + __expf(-fabsf(x))); }
__device__ __forceinline__ void gla_unit(ldsp lds, const Params& P, bool prompt, int b, int h, int dir) {
    constexpr int QSTR = 272, TSTR = 144;
    constexpr int L_QIN = 0, L_KIN = 64 * QSTR, L_KOT = 2 * 64 * QSTR, L_VT = L_KOT + 128 * TSTR, L_AM = L_VT + 128 * TSTR, L_LR = L_AM + 64 * TSTR, L_TOT = L_LR + 4096, L_DEC = L_TOT + 2048,
                  L_VRAW = L_DEC + 512;
    static_assert(L_VRAW + 64 * QSTR <= 131072, "gla lds");
    const int tid = tid_opaque(), lane = tid & 63, wid = tid >> 6, l16 = lane & 15, q4 = lane >> 4;
    const int L = prompt ? 256 : 4096, nch = L >> 6, rowbase = prompt ? b * 256 : MP + b * 4096;
    const bf16* PROJ = (const bf16*)(P.wsp() + B_PROJ);
    bf16* OD = dir == 0 ? (bf16*)(P.wsp() + B_PROJ) + h * 128 : (bf16*)(P.wsp() + A_MIX) + 512 + h * 128;
    const int ostr = dir == 0 ? PJ : 1024;
    LAS float* dec = (LAS float*)(lds + L_DEC);
    const int vcol = 16 * wid + l16;
    f32x4 S[8];
    if (prompt) {
#pragma unroll
        for (int db = 0; db < 8; ++db) S[db] = (f32x4){0.f, 0.f, 0.f, 0.f};
    } else {
        const float* sfp = P.inp(I_SF); const float* sbp = P.inp(I_SB); asm volatile("" : "+s"(sfp), "+s"(sbp));
        const float* s0 = (dir == 0 ? sfp : sbp) + ((size_t)(b * 4 + h) * 128) * 128 + (size_t)(4 * q4) * 128 + vcol; asm volatile("" : "+v"(s0));
#pragma unroll
        for (int db = 0; db < 8; ++db)
#pragma unroll
            for (int r = 0; r < 4; ++r) S[db][r] = s0[(16 * db + r) * 128];
    }
    const int dq = 16 * wid + l16;
    bf16x8 wgf;
    {
        float wv[8];
#pragma unroll
        for (int j = 0; j < 8; ++j) wv[j] = q4 < 2 ? P.inp(I_WGATE)[(size_t)(dir * 16 + 8 * q4 + j) * 512 + h * 128 + dq] : 0.f;
        wgf = pack_bf8(wv[0], wv[1], wv[2], wv[3], wv[4], wv[5], wv[6], wv[7]);
    }
    const float bg = P.inp(I_BGATE)[dir * 512 + h * 128 + dq];
    u32x4 rq[2], rk[2], rv[2], lrf[4];
    auto raw_load = [&](int ci) {
        const int n = dir == 0 ? ci : nch - 1 - ci; const int tok0 = rowbase + n * 64;
#pragma unroll
        for (int i = 0; i < 2; ++i) { const int idx = tid + 512 * i; const bf16* pr = PROJ + (size_t)(tok0 + (idx >> 4)) * PJ + h * 128 + (idx & 15) * 8;
            rq[i] = *(const u32x4*)(pr + C_GQ); rk[i] = *(const u32x4*)(pr + C_GK); rv[i] = *(const u32x4*)(pr + C_GV); }
        const bf16* pl = PROJ + (size_t)(tok0 + l16) * PJ + C_GGATE + dir * 16 + 8 * (q4 & 1); asm volatile("" : "+v"(pl));
#pragma unroll
        for (int mb = 0; mb < 4; ++mb) { const u32x4 t = *(const u32x4*)(pl + (size_t)(16 * mb) * PJ); lrf[mb] = q4 < 2 ? t : (u32x4){0u, 0u, 0u, 0u}; }
    };
    raw_load(0);
    for (int ci = 0; ci < nch; ++ci) {
        const int n = dir == 0 ? ci : nch - 1 - ci; const int tok0 = rowbase + n * 64;
#pragma unroll
        for (int i = 0; i < 2; ++i) { const int idx = tid + 512 * i, off = (idx >> 4) * QSTR + (idx & 15) * 16;
            *(LAS u32x4*)(lds + L_QIN + off) = rq[i]; *(LAS u32x4*)(lds + L_KIN + off) = rk[i]; *(LAS u32x4*)(lds + L_VRAW + off) = rv[i]; }
        float g[4][4];
#pragma unroll
        for (int mb = 0; mb < 4; ++mb) { const f32x4 acc = mfma16(__builtin_bit_cast(bf16x8, lrf[mb]), wgf, (f32x4){0.f, 0.f, 0.f, 0.f});
#pragma unroll
            for (int r = 0; r < 4; ++r) g[mb][r] = logsig(acc[r] + bg) * (1.f / 16.f); }
        if (ci + 1 < nch) raw_load(ci + 1);
        __syncthreads();
        float qv[4][4], kv[4][4]; bf16 vraw[4][4];
#pragma unroll
        for (int mb = 0; mb < 4; ++mb)
#pragma unroll
            for (int r = 0; r < 4; ++r) { const int off = (16 * mb + 4 * q4 + r) * QSTR + dq * 2;
                qv[mb][r] = bf1(*(const LAS bf16*)(lds + L_QIN + off)); kv[mb][r] = bf1(*(const LAS bf16*)(lds + L_KIN + off)); vraw[mb][r] = *(const LAS bf16*)(lds + L_VRAW + off); }
        float pfx[4][4], total = 0.f;
#pragma unroll
        for (int mb = 0; mb < 4; ++mb) {
            pfx[mb][0] = g[mb][0]; pfx[mb][1] = pfx[mb][0] + g[mb][1]; pfx[mb][2] = pfx[mb][1] + g[mb][2]; pfx[mb][3] = pfx[mb][2] + g[mb][3];
            const float R = pfx[mb][3];
            const float e1 = __shfl_up(R, 16), e2 = __shfl_up(R, 32), e3 = __shfl_up(R, 48);
            const float excl = (q4 >= 1 ? e1 : 0.f) + (q4 >= 2 ? e2 : 0.f) + (q4 >= 3 ? e3 : 0.f);
            const float blk = __shfl(excl + R, 48 + l16);
            const float base = excl + total;
#pragma unroll
            for (int r = 0; r < 4; ++r) pfx[mb][r] += base;
            total += blk;
        }
        if (q4 == 0) dec[dq] = __expf(total);
        {
            const float etot = __expf(total);
#pragma unroll
            for (int mb = 0; mb < 4; ++mb) {
                float ko[4];
#pragma unroll
                for (int r = 0; r < 4; ++r) { const float cum = dir == 0 ? pfx[mb][r] : total - pfx[mb][r] + g[mb][r]; const int s = 16 * mb + 4 * q4 + r;
                    const float ec = __expf(cum), en = fast_rcp(ec);
                    *(LAS bf16*)(lds + L_QIN + s * QSTR + dq * 2) = tobf(qv[mb][r] * 0.08838834764831845f * ec);
                    *(LAS bf16*)(lds + L_KIN + s * QSTR + dq * 2) = tobf(kv[mb][r] * en);
                    ko[r] = kv[mb][r] * en * etot; }
                u32x2 w; w.x = pkbf(ko[0], ko[1]); w.y = pkbf(ko[2], ko[3]);
                *(LAS u32x2*)(lds + L_KOT + dq * TSTR + (16 * mb + 4 * q4) * 2) = w;
                u32x2 v; v.x = vraw[mb][0] | ((unsigned)vraw[mb][1] << 16); v.y = vraw[mb][2] | ((unsigned)vraw[mb][3] << 16);
                *(LAS u32x2*)(lds + L_VT + dq * TSTR + (16 * mb + 4 * q4) * 2) = v;
            }
        }
        __syncthreads();
        {
            const int cb1 = wid >> 1, sh = wid & 1;
#pragma unroll
            for (int nb = 0; nb < 2; ++nb) {
                f32x4 acc = (f32x4){0.f, 0.f, 0.f, 0.f};
#pragma unroll
                for (int kb = 0; kb < 4; ++kb) {
                    const bf16x8 a = *(const LAS bf16x8*)(lds + L_QIN + (16 * cb1 + l16) * QSTR + (32 * kb + 8 * q4) * 2);
                    const bf16x8 bb = *(const LAS bf16x8*)(lds + L_KIN + (32 * sh + 16 * nb + l16) * QSTR + (32 * kb + 8 * q4) * 2);
                    acc = mfma16(a, bb, acc);
                }
                const int s = 32 * sh + 16 * nb + l16;
#pragma unroll
                for (int r = 0; r < 4; ++r) { const int c = 16 * cb1 + 4 * q4 + r; const bool keep = dir == 0 ? (s <= c) : (s >= c);
                    *(LAS bf16*)(lds + L_AM + c * TSTR + s * 2) = tobf(keep ? acc[r] : 0.f); }
            }
        }
        f32x4 o[4];
        {
            bf16x8 sb[4];
#pragma unroll
            for (int kb = 0; kb < 4; ++kb) sb[kb] = pack_bf8(S[2 * kb][0], S[2 * kb][1], S[2 * kb][2], S[2 * kb][3], S[2 * kb + 1][0], S[2 * kb + 1][1], S[2 * kb + 1][2], S[2 * kb + 1][3]);
#pragma unroll
            for (int cb = 0; cb < 4; ++cb) { o[cb] = (f32x4){0.f, 0.f, 0.f, 0.f};
#pragma unroll
                for (int kb = 0; kb < 4; ++kb) {
                    const s16x4 lo = *(const LAS s16x4*)(lds + L_QIN + (16 * cb + l16) * QSTR + (32 * kb + 4 * q4) * 2), hh = *(const LAS s16x4*)(lds + L_QIN + (16 * cb + l16) * QSTR + (32 * kb + 16 + 4 * q4) * 2);
                    const bf16x8 a = (bf16x8){lo[0], lo[1], lo[2], lo[3], hh[0], hh[1], hh[2], hh[3]};
                    o[cb] = mfma16(a, sb[kb], o[cb]);
                } }
        }
        __syncthreads();
        {
            bf16x8 vb[2];
#pragma unroll
            for (int kb = 0; kb < 2; ++kb) vb[kb] = *(const LAS bf16x8*)(lds + L_VT + vcol * TSTR + (32 * kb + 8 * q4) * 2);
#pragma unroll
            for (int cb = 0; cb < 4; ++cb)
#pragma unroll
                for (int kb = 0; kb < 2; ++kb) { const bf16x8 a = *(const LAS bf16x8*)(lds + L_AM + (16 * cb + l16) * TSTR + (32 * kb + 8 * q4) * 2); o[cb] = mfma16(a, vb[kb], o[cb]); }
#pragma unroll
            for (int db = 0; db < 8; ++db) { const f32x4 dc = *(const LAS f32x4*)(lds + L_DEC + (16 * db + 4 * q4) * 4); S[db] = S[db] * dc;
#pragma unroll
                for (int kb = 0; kb < 2; ++kb) { const bf16x8 a = *(const LAS bf16x8*)(lds + L_KOT + (16 * db + l16) * TSTR + (32 * kb + 8 * q4) * 2); S[db] = mfma16(a, vb[kb], S[db]); } }
        }
        {
            bf16* pw0 = OD + (size_t)(tok0 + 4 * q4) * ostr + vcol; asm volatile("" : "+v"(pw0));
#pragma unroll
            for (int cb = 0; cb < 4; ++cb)
#pragma unroll
                for (int r = 0; r < 4; ++r) pw0[(size_t)(16 * cb + r) * ostr] = tobf(o[cb][r]);
        }
        __syncthreads();
    }
    if (prompt) { float* so = P.outp() + (dir == 0 ? O_GF : O_GB) + ((size_t)(b * 4 + h) * 128) * 128 + (size_t)(4 * q4) * 128 + vcol; asm volatile("" : "+v"(so));
#pragma unroll
        for (int db = 0; db < 8; ++db)
#pragma unroll
            for (int r = 0; r < 4; ++r) so[(16 * db + r) * 128] = S[db][r]; }
    __syncthreads();
}
__device__ __forceinline__ void phase_gla_fin(const Params& P) {
    const int tid = tid_opaque(), lane = tid & 63, gw = blockIdx.x * 8 + (tid >> 6), NGW = gridDim.x * 8;
    const bf16* PROJ = (const bf16*)(P.wsp() + B_PROJ); bf16* MIX = (bf16*)(P.wsp() + A_MIX);
    const f32x4 g0 = *(const f32x4*)(P.inp(I_GGOUT) + (8 * lane & 127)), g1 = *(const f32x4*)(P.inp(I_GGOUT) + (8 * lane & 127) + 4);
    for (int row = gw; row < MT; row += NGW) {
        const u32x4 a = *(const u32x4*)(PROJ + (size_t)row * PJ + 8 * lane), bq = *(const u32x4*)(MIX + (size_t)row * 1024 + 512 + 8 * lane), gt = *(const u32x4*)(PROJ + (size_t)row * PJ + C_GOUT + 8 * lane);
        float v[8];
        v[0] = bf_lo(a.x) + bf_lo(bq.x); v[1] = bf_hi(a.x) + bf_hi(bq.x); v[2] = bf_lo(a.y) + bf_lo(bq.y); v[3] = bf_hi(a.y) + bf_hi(bq.y);
        v[4] = bf_lo(a.z) + bf_lo(bq.z); v[5] = bf_hi(a.z) + bf_hi(bq.z); v[6] = bf_lo(a.w) + bf_lo(bq.w); v[7] = bf_hi(a.w) + bf_hi(bq.w);
        float ss = 0.f;
#pragma unroll
        for (int i = 0; i < 8; ++i) ss += v[i] * v[i];
        ss += __shfl_xor(ss, 1); ss += __shfl_xor(ss, 2); ss += __shfl_xor(ss, 4); ss += __shfl_xor(ss, 8);
        const float rr = 1.f / sqrtf(ss * (1.f / 128.f) + EPS);
        u32x4 w;
        w.x = pkbf(v[0] * rr * g0[0] * silu_f(bf_lo(gt.x)), v[1] * rr * g0[1] * silu_f(bf_hi(gt.x))); w.y = pkbf(v[2] * rr * g0[2] * silu_f(bf_lo(gt.y)), v[3] * rr * g0[3] * silu_f(bf_hi(gt.y)));
        w.z = pkbf(v[4] * rr * g1[0] * silu_f(bf_lo(gt.z)), v[5] * rr * g1[1] * silu_f(bf_hi(gt.z))); w.w = pkbf(v[6] * rr * g1[2] * silu_f(bf_lo(gt.w)), v[7] * rr * g1[3] * silu_f(bf_hi(gt.w)));
        *(u32x4*)(MIX + (size_t)row * 1024 + 512 + 8 * lane) = w;
    }
}

#define RLX_AGENT __ATOMIC_RELAXED, __HIP_MEMORY_SCOPE_AGENT
#define XB_TMO      128
#define XB_XCNT(j)  (256  + 64 * (j))
#define XB_XSUB(j)  (1280 + 64 * (j))
#define XB_XGEN(j)  (2304 + 64 * (j))
#define XB_TOP      3328
#define XB_TOPGEN   3392
#define XCD_BAR_WORDS 3456
#define XB_SPIN_CAP (1u << 18)

__device__ __forceinline__ unsigned xb_ld(unsigned* p)              { return __hip_atomic_load(p, __ATOMIC_RELAXED, __HIP_MEMORY_SCOPE_AGENT); }
__device__ __forceinline__ unsigned xb_add(unsigned* p, unsigned v) { return __hip_atomic_fetch_add(p, v, __ATOMIC_RELAXED, __HIP_MEMORY_SCOPE_AGENT); }
__device__ __forceinline__ unsigned xb_xcc_id() { return (unsigned)__builtin_amdgcn_s_getreg((3 << 11) | 20) & 0xFu; }
#define XB_SPIN(cond, bar) do { unsigned _sp = 0; while (cond) { __builtin_amdgcn_s_sleep(1); \
    if ((++_sp & 255u) == 0u) { if (xb_ld(&(bar)[XB_TMO])) break; if (_sp > XB_SPIN_CAP) { atomicAdd(&(bar)[XB_TMO], 1u); break; } } } } while (0)

struct XcdBarrier {
    unsigned* bar; unsigned x;
    volatile LAS unsigned* st;
};

__device__ __forceinline__ XcdBarrier xcd_barrier_post(unsigned* bar, volatile LAS unsigned* st) {
    XcdBarrier b; b.bar = bar; b.x = xb_xcc_id(); b.st = st;
    if (threadIdx.x == 0) (void)xb_add(&bar[XB_XCNT(b.x)], 1u);
    return b;
}
__device__ __forceinline__ void xcd_barrier_complete(unsigned* bar, unsigned x, unsigned& nloc, unsigned& nx) {
    const unsigned G = gridDim.x * gridDim.y * gridDim.z;
    unsigned sum, cnt, mine, sp = 0u;
    for (;;) {
        sum = 0u; cnt = 0u; mine = 0u;
#pragma unroll
        for (unsigned j = 0; j < 16; ++j) { const unsigned c = xb_ld(&bar[XB_XCNT(j)]); sum += c; cnt += (c > 0u) ? 1u : 0u; mine = (j == x) ? c : mine; }
        if (sum == G) break;
        __builtin_amdgcn_s_sleep(1);
        if ((++sp & 255u) == 0u) { if (xb_ld(&bar[XB_TMO])) break; if (sp > XB_SPIN_CAP) { atomicAdd(&bar[XB_TMO], 1u); break; } }
    }
    nloc = mine > 0u ? mine : 1u; nx = cnt > 0u ? cnt : 1u;
}

__device__ __forceinline__ void xcd_barrier(const XcdBarrier& b) {
    asm volatile("s_waitcnt vmcnt(0)" ::: "memory");
    __syncthreads();
    if (threadIdx.x == 0) {
        unsigned* bar = b.bar;
        __builtin_amdgcn_s_waitcnt(0);
        unsigned nloc = b.st[0], nx = b.st[1];
        if (nloc == 0u) { xcd_barrier_complete(bar, b.x, nloc, nx); b.st[0] = nloc; b.st[1] = nx; }
        const unsigned old = xb_add(&bar[XB_XSUB(b.x)], 1u);
        const unsigned gen = old / nloc;
        if (old + 1u == (gen + 1u) * nloc) {
            __builtin_amdgcn_fence(__ATOMIC_RELEASE, "agent");
            asm volatile("s_waitcnt vmcnt(0)" ::: "memory");
            const unsigned og = xb_add(&bar[XB_TOP], 1u);
            const unsigned tg = og / nx;
            if (og + 1u == (tg + 1u) * nx) xb_add(&bar[XB_TOPGEN], 1u);
            else XB_SPIN(xb_ld(&bar[XB_TOPGEN]) == tg, bar);
            __builtin_amdgcn_fence(__ATOMIC_ACQUIRE, "agent");
            xb_add(&bar[XB_XGEN(b.x)], 1u);
            asm volatile("s_waitcnt vmcnt(0)" ::: "memory");
        } else {
            XB_SPIN(xb_ld(&bar[XB_XGEN(b.x)]) == gen, bar);
            __builtin_amdgcn_fence(__ATOMIC_ACQUIRE, "agent");
            asm volatile("s_waitcnt vmcnt(0)" ::: "memory");
        }
    }
    __syncthreads();
}


#ifndef NO_GEMM
#define RUN_GEMM(...) pg8::run_gemm(__VA_ARGS__)
#else
#define RUN_GEMM(...) do{}while(0)
#endif
#ifndef NO_ATT0
#define ATT0(...) attn_unit<0>(__VA_ARGS__)
#else
#define ATT0(...) do{}while(0)
#endif
#ifndef NO_ATT1
#define ATT1(...) attn_unit<1>(__VA_ARGS__)
#else
#define ATT1(...) do{}while(0)
#endif
#ifndef NO_GLA
#define GLA(...) gla_unit(__VA_ARGS__)
#else
#define GLA(...) do{}while(0)
#endif
#ifndef NO_EmPlain
#define RG_EmPlain(...) RUN_GEMM(__VA_ARGS__)
#else
#define RG_EmPlain(...) do{}while(0)
#endif
#ifndef NO_EmQ
#define RG_EmQ(...) RUN_GEMM(__VA_ARGS__)
#else
#define RG_EmQ(...) do{}while(0)
#endif
#ifndef NO_EmKV
#define RG_EmKV(...) RUN_GEMM(__VA_ARGS__)
#else
#define RG_EmKV(...) do{}while(0)
#endif
#ifndef NO_EmFFN
#define RG_EmFFN(...) RUN_GEMM(__VA_ARGS__)
#else
#define RG_EmFFN(...) do{}while(0)
#endif
#ifndef NO_EmQKV
#define RG_EmQKV(...) RUN_GEMM(__VA_ARGS__)
#else
#define RG_EmQKV(...) do{}while(0)
#endif
#ifndef PH_LO
#define PH_LO 0
#endif
#ifndef PH_HI
#define PH_HI 20
#endif
constexpr int LDS_BYTES = 147456;
__device__ __forceinline__ int next_item(unsigned* ctr, ldsp lds) {
    LAS int* slot = (LAS int*)(lds + 131072 + 64);
    __syncthreads();
    if (threadIdx.x == 0) *slot = (int)atomicAdd(ctr, 1u);
    __syncthreads();
    return *slot;
}
__global__ void __launch_bounds__(512, 2) fwd_megakernel(ParamsK Pkarg) {
    extern __shared__ __attribute__((aligned(16))) unsigned char lds_raw[];
    ldsp lds = (ldsp)lds_raw;
    cg::grid_group grid = cg::this_grid();
    XcdBarrier xbar;
    {
        volatile LAS unsigned* stw = (volatile LAS unsigned*)(lds + 131072 + 128);
        if (threadIdx.x < 2) stw[threadIdx.x] = 0u;
        __syncthreads();
#if defined(__HIP_DEVICE_COMPILE__)
        unsigned char* ws0 = *(unsigned char* const __attribute__((address_space(4)))*)((const __attribute__((address_space(4))) char*)__builtin_amdgcn_kernarg_segment_ptr() + 8 * 29);
#else
        unsigned char* ws0 = nullptr;
#endif
        xbar = xcd_barrier_post((unsigned*)(ws0 + WS_CTL) + 4096, stw);
    }
#pragma unroll 1
    for (int ph = PH_LO; ph < PH_HI; ++ph) {
        Params P;
#if defined(__HIP_DEVICE_COMPILE__)
        P.kp = (const __attribute__((address_space(4))) char*)__builtin_amdgcn_kernarg_segment_ptr(); asm volatile("" : "+s"(P.kp));
#else
        P.kp = nullptr;
#endif
        unsigned char* ws = P.wsp();
        unsigned* ctl = (unsigned*)(ws + WS_CTL);
        typedef pg8::bf16_t* bp; typedef const pg8::bf16_t* cbp;
        const float* rmc = (const float*)(ws + WS_RM_COS); const float* rms = (const float*)(ws + WS_RM_SIN); const float* rdc = (const float*)(ws + WS_RD_COS); const float* rds = (const float*)(ws + WS_RD_SIN);
#ifdef REPMASK
        const int nrep = 1 + ((REPMASK >> ph) & 1);
#else
        const int nrep = 1;
#endif
#pragma unroll 1
        for (int rep = 0; rep < nrep; ++rep) {
        if (rep) xcd_barrier(xbar);
        int kind = 0;
        cbp gA = nullptr, gB = nullptr; int gM = 0, gN = 0, gK = 0; bp gO = nullptr; int gldc = 0;
        bool rn_first = false, rn_doH = false; int rn_liA = 0, rn_gA = 0, rn_gate = 0, rn_liB = 0, rn_gB = 0, rn_sc = 0, rn_sh = 0;
        switch (ph) {
        case 0: phase0(P, lds); break;
        case 1: phase_norm0(P); break;
        case 2: kind = 1; gA = (cbp)(ws + A_H); gB = (cbp)(ws + W_IN); gM = MT; gN = PJ; gK = 1024; gO = (bp)(ws + B_PROJ); gldc = PJ; break;
        case 3: phase_mla_prep(P); break;
        case 4: RG_EmQ(lds, (cbp)(ws + A_QLN), (cbp)(ws + W_UQ), MT, 768, 384, pg8::EmQ{(bp)(ws + R_Q), rmc, rms});
                RG_EmKV(lds, (cbp)(ws + A_CKV), (cbp)(ws + W_UKV), KR, 1024, 256, pg8::EmKV{(bp)(ws + R_KN), (bp)(ws + R_VTM)}); break;
        case 5: break;
        case 6: {
            const int xcd = (int)(__builtin_amdgcn_s_getreg((3 << 11) | 20) & 7u);
            for (int qq = 0; qq < 8; ++qq) {
                const int x = (xcd + qq) & 7;
                for (;;) {
                    const int it = next_item(ctl + 64 * x + 1024 * rep, lds);
                    if (it >= 168) break;
                    if (it < 8) { const int u = x * 8 + it; GLA(lds, P, false, u >> 3, (u >> 1) & 3, u & 1); }
                    else if (it >= 136 && it < 152) { const int u = x * 16 + (it - 136); GLA(lds, P, true, u >> 3, (u >> 1) & 3, u & 1); }
                    else { AttnArgs<0> A; A.Q = (const bf16*)(ws + R_Q); A.K = (const bf16*)(ws + R_KN); A.K2 = (const bf16*)(ws + R_KROPE); A.MIX = (bf16*)(ws + A_MIX); A.lam = 0.f; A.gout = nullptr;
                        if (it < 136) { const int j = it - 8, pair = (j >> 4) * 8 + x, b = pair >> 3, h = pair & 7, qb = j & 15;
                            A.VTh = (const bf16*)(ws + R_VTM) + (size_t)16 * 512 * 256 + (size_t)b * 512 * 4608 + (size_t)h * 64 * 4608;
                            A.row0 = MP + b * 4096 + qb * 256; A.krow0 = MP + b * 4608; A.Lk = 4608; A.h = h; }
                        else { const int u = x * 16 + (it - 152), b = u >> 3, h = u & 7;
                            A.VTh = (const bf16*)(ws + R_VTM) + (size_t)b * 512 * 256 + (size_t)h * 64 * 256;
                            A.row0 = b * 256; A.krow0 = b * 256; A.Lk = 256; A.h = h; }
                        ATT0(lds, A); }
                }
            }
        } break;
        case 7: phase_gla_fin(P); break;
        case 8: kind = 1; gA = (cbp)(ws + A_MIX); gB = (cbp)(ws + W_ABO); gM = MT; gN = 1024; gK = 1024; gO = (bp)(ws + R_OUT); gldc = 1024; break;
        case 9: kind = 2; rn_first = true; rn_liA = 0; rn_gA = 1; rn_gate = 2; rn_doH = true; rn_liB = 0; rn_gB = 2; rn_sc = 4; rn_sh = 3; break;
        case 10: kind = 3; gA = (cbp)(ws + A_H); gB = (cbp)(ws + W_F1); gM = MT; gN = 5632; gK = 1024; gO = (bp)(ws + B_FFNH); break;
        case 11: kind = 1; gA = (cbp)(ws + B_FFNH); gB = (cbp)(ws + W_F2); gM = MT; gN = 1024; gK = 2816; gO = (bp)(ws + R_OUT); gldc = 1024; break;
        case 12: kind = 2; rn_liA = 0; rn_gA = 3; rn_gate = 5; rn_doH = true; rn_liB = 1; rn_gB = 0; rn_sc = 1; rn_sh = 0; phase_diff_ctx(P); break;
        case 13: RG_EmQKV(lds, (cbp)(ws + A_H), (cbp)(ws + W_QKV), MT, 3072, 1024, pg8::EmQKV{(bp)(ws + B_QD), (bp)(ws + B_KD), (bp)(ws + R_VTD), P.outp() + O_DK, P.outp() + O_DV, rdc, rds}); break;
        case 14: {
            const float lam = *(const float*)(ws + WS_LAM);
            const int xcd = (int)(__builtin_amdgcn_s_getreg((3 << 11) | 20) & 7u);
            for (int qq = 0; qq < 8; ++qq) {
                const int x = (xcd + qq) & 7;
                for (;;) {
                    const int it = next_item(ctl + 512 + 64 * x + 1024 * rep, lds);
                    if (it >= 288) break;
                    AttnArgs<1> A; A.Q = (const bf16*)(ws + B_QD); A.K = (const bf16*)(ws + B_KD); A.K2 = nullptr; A.MIX = (bf16*)(ws + A_MIX); A.lam = lam; A.gout = P.inp(I_DGOUT);
                    if (it < 256) { const int pair = (it >> 5) * 8 + x, b = pair >> 3, h = pair & 7, qb = it & 31;
                        A.VTh = (const bf16*)(ws + R_VTD) + (size_t)16 * 1024 * 256 + (size_t)b * 1024 * 4608 + (size_t)h * 128 * 4608;
                        A.row0 = MP + b * 4096 + qb * 128; A.krow0 = MP + b * 4608; A.Lk = 4608; A.h = h; }
                    else { const int u = x * 32 + (it - 256), b = u >> 4, h = (u >> 1) & 7, qb = u & 1;
                        A.VTh = (const bf16*)(ws + R_VTD) + (size_t)b * 1024 * 256 + (size_t)h * 128 * 256;
                        A.row0 = b * 256 + qb * 128; A.krow0 = b * 256; A.Lk = 256; A.h = h; }
#ifdef UNIT_REP
                    ATT1(lds, A);
#endif
                    ATT1(lds, A);
                }
            }
        } break;
        case 15: kind = 1; gA = (cbp)(ws + A_MIX); gB = (cbp)(ws + W_CO); gM = MT; gN = 1024; gK = 1024; gO = (bp)(ws + R_OUT); gldc = 1024; break;
        case 16: kind = 2; rn_liA = 1; rn_gA = 1; rn_gate = 2; rn_doH = true; rn_liB = 1; rn_gB = 2; rn_sc = 4; rn_sh = 3; break;
        case 17: kind = 3; gA = (cbp)(ws + A_H); gB = (cbp)(ws + W_F1 + 11 * MiB); gM = MT; gN = 5632; gK = 1024; gO = (bp)(ws + B_FFNH); break;
        case 18: kind = 1; gA = (cbp)(ws + B_FFNH); gB = (cbp)(ws + W_F2 + (size_t)2816 * 1024 * 2); gM = MT; gN = 1024; gK = 2816; gO = (bp)(ws + R_OUT); gldc = 1024; break;
        default: kind = 2; rn_liA = 1; rn_gA = 3; rn_gate = 5; rn_doH = false; break;
        }
        if (kind == 1) RG_EmPlain(lds, gA, gB, gM, gN, gK, pg8::EmPlain{gO, gldc});
        else if (kind == 3) RG_EmFFN(lds, gA, gB, gM, gN, gK, pg8::EmFFN{gO});
        else if (kind == 2) phase_resnorm(P, rn_first, rn_liA, rn_gA, rn_gate, rn_doH, rn_liB, rn_gB, rn_sc, rn_sh);
        }
        if (ph + 1 < PH_HI && ph != 4) { if (ph == 0) grid.sync(); else xcd_barrier(xbar); }
#ifdef EXTRA_SYNCS
        if (ph == 1) { for (int es = 0; es < EXTRA_SYNCS; ++es) xcd_barrier(xbar); }
#endif
    }
}

extern "C" void kernel_launch(void* const* d_in, const int* in_sizes, int n_in, void* d_out, int out_size, void* d_ws, size_t ws_size, hipStream_t stream) {
    static int grid = 0;
    if (grid == 0) {
        if (n_in != 28 || ws_size < WS_END) { fprintf(stderr, "kernel_launch: unexpected n_in %d / ws_size %zu (need %zu)\n", n_in, ws_size, (size_t)WS_END); grid = -1; return; }
        int dev = 0, cus = 0, per_cu = 0;
        hipGetDevice(&dev); hipDeviceGetAttribute(&cus, hipDeviceAttributeMultiprocessorCount, dev);
        if (hipFuncSetAttribute((const void*)fwd_megakernel, hipFuncAttributeMaxDynamicSharedMemorySize, LDS_BYTES) != hipSuccess) { fprintf(stderr, "kernel_launch: hipFuncSetAttribute failed\n"); grid = -1; return; }
        if (hipOccupancyMaxActiveBlocksPerMultiprocessor(&per_cu, (const void*)fwd_megakernel, 512, LDS_BYTES) != hipSuccess || per_cu < 1) { fprintf(stderr, "kernel_launch: occupancy query says %d\n", per_cu); per_cu = 1; }
        (void)hipGetLastError();
        grid = cus * 1;
    }
    if (grid < 0) return;
    hipMemsetAsync((char*)d_ws + WS_CTL, 0, 32768, stream);
    ParamsK p{};
    for (int i = 0; i < 28; ++i) p.in[i] = (const float*)d_in[i];
    p.out = (float*)d_out; p.ws = (unsigned char*)d_ws;
    void* args[] = {&p};
    hipError_t e = hipLaunchCooperativeKernel((const void*)fwd_megakernel, dim3(grid), dim3(512), args, LDS_BYTES, stream);
    if (e != hipSuccess) fprintf(stderr, "cooperative launch failed: %s (grid %d)\n", hipGetErrorString(e), grid);
}
```

```cpp
#include <hip/hip_runtime.h>
#include <hip/hip_cooperative_groups.h>
#include <cstdio>
#include <cstdint>
namespace cg = cooperative_groups;
__device__ __forceinline__ int tid_opaque() { int t = threadIdx.x; asm volatile("" : "+v"(t)); return t; }
namespace pg8 {
#define PG8_LAS __attribute__((address_space(3)))
typedef unsigned short bf16_t;
typedef short bf16x8 __attribute__((ext_vector_type(8)));
typedef float f32x4 __attribute__((ext_vector_type(4)));
typedef unsigned u32x4 __attribute__((ext_vector_type(4)));
constexpr int BM = 256, BK = 64, HALF = 128, HTB = HALF * BK * 2  , STAGE_BYTES = 8 * HTB, NXCD = 8, WGM = 8;

__host__ __device__ __forceinline__ int lds_byte(int r, int c) { const int st = (r >> 4) * 2 + (c >> 5), rr = r & 15, cc = c & 31, ob = rr * 64 + cc * 2; return st * 1024 + (ob ^ (((ob >> 9) & 1) << 5)); }
__host__ __device__ __forceinline__ void stage_rc(int b, int& R, int& C) { const int st = b / 1024, sb = b % 1024, swz = sb ^ (((sb >> 9) & 1) << 5); R = (st >> 1) * 16 + swz / 64; C = (st & 1) * 32 + (swz % 64) / 2; }
__host__ __device__ __forceinline__ int perm32(int rho) { const int n = rho >> 4, i = rho & 15; return 8 * (i >> 2) + 4 * n + (i & 3); }

struct Unit { int pm, pn; };
struct Gemm { const bf16_t* A; const bf16_t* Bt; int M, N, K; };

struct StaticOrder {
    int nM, nN, nwg, G, c;
    __host__ __device__ void init(int M, int N, int G_, int c_) { nM = M / BM; nN = N / BM; nwg = nM * nN; G = G_; c = c_; }
    __host__ __device__ bool next(int i, Unit& u) const {
        const long L = (long)i * G + c; if (L >= nwg) return false;
        int wgid = (int)L; { const int q = nwg / NXCD, r = nwg % NXCD, xcd = wgid % NXCD, off = wgid / NXCD; wgid = (xcd < r ? xcd * (q + 1) : r * (q + 1) + (xcd - r) * q) + off; }
        const int nig = WGM * nN, gid = wgid / nig, fm = gid * WGM, gsz = (nM - fm) < WGM ? (nM - fm) : WGM;
        u.pm = fm + ((wgid % nig) % gsz); u.pn = (wgid % nig) / gsz; return true;
    }
    __device__ __forceinline__ void a_ready(const Unit&) const {}
    __device__ __forceinline__ void done(const Unit&) const {}
};

__device__ __forceinline__ unsigned cvt_pk_bf16(float lo, float hi) { unsigned r; asm volatile("v_cvt_pk_bf16_f32 %0, %1, %2" : "=v"(r) : "v"(lo), "v"(hi)); return r; }
typedef float f32x2 __attribute__((ext_vector_type(2)));
template <class Epi, class Sched, bool ALIGN_EPI = false, bool SP2 = false>
__device__ __forceinline__ void gemm_phase(PG8_LAS unsigned char* lds, const Gemm g, const Sched& S, const Epi& E) {
    const int tid = tid_opaque(), wid = __builtin_amdgcn_readfirstlane(tid >> 6), lane = tid & 63, wr = wid >> 2, wc = wid & 3, fr = lane & 15, fq = lane >> 4;
    const int K = g.K, nt = K / BK;
    unsigned voffA[2], voffB[2];
#pragma unroll
    for (int i = 0; i < 2; ++i) { int R, C; stage_rc(tid * 16 + i * 8192, R, C); const int Rb = Epi::PERM ? ((R & ~31) + perm32(R & 31)) : R;
        voffA[i] = (unsigned)(R * K + C) * 2u; voffB[i] = (unsigned)(Rb * K + C) * 2u; }
    const size_t kstep = (size_t)(BK * 2);
    const size_t hstep = (size_t)HALF * K * 2;
    const size_t tstep = 2 * hstep;
    const unsigned ldsw = (unsigned)wid * 1024u;
    const int aoff = lds_byte(wr * 64 + fr, fq * 8), boff = lds_byte(wc * 32 + fr, fq * 8);
#define PG8_SA(b, h) (((b) * 2 + (h)) * HTB)
#define PG8_SB(b, h) ((4 + (b) * 2 + (h)) * HTB)
#define PG8_STAGE(bufoff, gbase, voff) do { _Pragma("unroll") for (int _i = 0; _i < 2; ++_i) \
        __builtin_amdgcn_global_load_lds((const unsigned*)((const char*)(gbase) + (voff)[_i]), (PG8_LAS unsigned*)(lds + (bufoff) + ldsw + _i * 8192), 16, 0, 0); } while (0)
#define PG8_LDA(dst, b, h) do { _Pragma("unroll") for (int m = 0; m < 4; ++m) _Pragma("unroll") for (int k = 0; k < 2; ++k) dst[m][k] = *(const PG8_LAS bf16x8*)(lds + PG8_SA(b, h) + aoff + m * 2048 + k * 1024); } while (0)
#define PG8_LDB(dst, b, h) do { _Pragma("unroll") for (int n = 0; n < 2; ++n) _Pragma("unroll") for (int k = 0; k < 2; ++k) dst[n][k] = *(const PG8_LAS bf16x8*)(lds + PG8_SB(b, h) + boff + n * 2048 + k * 1024); } while (0)
#define PG8_MMA(ai, bj, At, Bt) do { __builtin_amdgcn_s_setprio(1); _Pragma("unroll") for (int m = 0; m < 4; ++m) _Pragma("unroll") for (int n = 0; n < 2; ++n) _Pragma("unroll") for (int k = 0; k < 2; ++k) \
        acc[ai][bj][m][n] = __builtin_amdgcn_mfma_f32_16x16x32_bf16(Bt[n][k], At[m][k], acc[ai][bj][m][n], 0, 0, 0); __builtin_amdgcn_s_setprio(0); } while (0)
#define PG8_WAIT_V(n) asm volatile("s_waitcnt vmcnt(" #n ")" ::: "memory")
#define PG8_WAIT_L(n) asm volatile("s_waitcnt lgkmcnt(" #n ")" ::: "memory")
#define PG8_BAR __builtin_amdgcn_s_barrier()
#define PG8_SCHED __builtin_amdgcn_sched_barrier(0)
    Unit cur, nxt; int ui = 0;
    if (!S.next(0, cur)) return;
    f32x4 acc[2][2][4][2];
#pragma unroll
    for (int a = 0; a < 2; ++a)
#pragma unroll
        for (int b = 0; b < 2; ++b)
#pragma unroll
            for (int m = 0; m < 4; ++m)
#pragma unroll
                for (int n = 0; n < 2; ++n) acc[a][b][m][n] = (f32x4){0.f, 0.f, 0.f, 0.f};
    bf16x8 At[4][2], B0[2][2], B1[2][2];
    const char* cA = (const char*)g.A + (size_t)cur.pm * tstep; const char* cB = (const char*)g.Bt + (size_t)cur.pn * tstep;
    S.a_ready(cur);
    if constexpr (SP2) {
        PG8_STAGE(PG8_SB(0, 0), cB, voffB); PG8_STAGE(PG8_SB(0, 1), cB + hstep, voffB); PG8_STAGE(PG8_SA(0, 0), cA, voffA); PG8_STAGE(PG8_SA(0, 1), cA + hstep, voffA);
        if (wr == 1) PG8_BAR;
        PG8_WAIT_V(2); PG8_BAR;
        PG8_STAGE(PG8_SB(1, 0), cB + kstep, voffB); PG8_STAGE(PG8_SA(1, 0), cA + kstep, voffA); PG8_STAGE(PG8_SB(1, 1), cB + hstep + kstep, voffB);
        PG8_WAIT_V(6); PG8_BAR;
    } else {
        PG8_STAGE(PG8_SB(0, 0), cB, voffB); PG8_STAGE(PG8_SA(0, 0), cA, voffA); PG8_STAGE(PG8_SB(0, 1), cB + hstep, voffB); PG8_STAGE(PG8_SA(0, 1), cA + hstep, voffA);
        if (wr == 1) PG8_BAR;
        PG8_WAIT_V(4); PG8_BAR;
        PG8_STAGE(PG8_SB(1, 0), cB + kstep, voffB); PG8_STAGE(PG8_SA(1, 0), cA + kstep, voffA); PG8_STAGE(PG8_SB(1, 1), cB + hstep + kstep, voffB);
        PG8_WAIT_V(6); PG8_BAR;
    }
    for (;;) {
        const bool has_next = S.next(ui + 1, nxt);
        const char* nA = has_next ? (const char*)g.A + (size_t)nxt.pm * tstep : cA; const char* nB = has_next ? (const char*)g.Bt + (size_t)nxt.pn * tstep : cB;
        for (int t = 0; t < nt; t += 2) {
            const bool last = (t == nt - 2);
            const char* a1 = cA + (size_t)(t + 1) * kstep;
            const char* a2 = last ? nA : cA + (size_t)(t + 2) * kstep; const char* b2 = last ? nB : cB + (size_t)(t + 2) * kstep;
            const char* a3 = a2 + kstep; const char* b3 = b2 + kstep;
            if (last && has_next) S.a_ready(nxt);
            if constexpr (SP2) {
            PG8_LDB(B0, 0, 0); PG8_LDB(B1, 0, 1); PG8_SCHED; PG8_LDA(At, 0, 0); PG8_STAGE(PG8_SA(1, 1), a1 + hstep, voffA);
            PG8_WAIT_V(8); PG8_WAIT_L(0); PG8_BAR; PG8_MMA(0, 0, At, B0); PG8_MMA(0, 1, At, B1); PG8_BAR; PG8_SCHED;
            PG8_LDA(At, 0, 1); PG8_STAGE(PG8_SB(0, 0), b2, voffB); PG8_STAGE(PG8_SB(0, 1), b2 + hstep, voffB); PG8_STAGE(PG8_SA(0, 0), a2, voffA);
            PG8_WAIT_V(8); PG8_WAIT_L(0); PG8_BAR; PG8_MMA(1, 0, At, B0); PG8_MMA(1, 1, At, B1); PG8_BAR; PG8_SCHED;
            PG8_LDB(B0, 1, 0); PG8_LDB(B1, 1, 1); PG8_SCHED; PG8_LDA(At, 1, 0); PG8_STAGE(PG8_SA(0, 1), a2 + hstep, voffA);
            PG8_WAIT_V(8); PG8_WAIT_L(0); PG8_BAR; PG8_MMA(0, 0, At, B0); PG8_MMA(0, 1, At, B1); PG8_BAR; PG8_SCHED;
            PG8_LDA(At, 1, 1); PG8_STAGE(PG8_SB(1, 0), b3, voffB); PG8_STAGE(PG8_SB(1, 1), b3 + hstep, voffB); PG8_STAGE(PG8_SA(1, 0), a3, voffA);
            PG8_WAIT_V(8); PG8_WAIT_L(0); PG8_BAR; PG8_MMA(1, 0, At, B0); PG8_MMA(1, 1, At, B1); PG8_BAR; PG8_SCHED;
            } else {
            PG8_LDB(B0, 0, 0); PG8_SCHED; PG8_LDA(At, 0, 0); PG8_STAGE(PG8_SA(1, 1), a1 + hstep, voffA);
            PG8_WAIT_L(8); PG8_BAR; PG8_WAIT_L(0); PG8_MMA(0, 0, At, B0); PG8_BAR; PG8_SCHED;
            PG8_LDB(B1, 0, 1); PG8_STAGE(PG8_SB(0, 0), b2, voffB);
            PG8_BAR; PG8_WAIT_L(0); PG8_MMA(0, 1, At, B1); PG8_BAR;
            PG8_LDA(At, 0, 1); PG8_STAGE(PG8_SA(0, 0), a2, voffA);
            PG8_BAR; PG8_WAIT_L(0); PG8_MMA(1, 0, At, B0); PG8_BAR; PG8_SCHED;
            PG8_STAGE(PG8_SB(0, 1), b2 + hstep, voffB);
            PG8_WAIT_V(6); PG8_BAR; PG8_MMA(1, 1, At, B1); PG8_BAR;
            PG8_LDB(B0, 1, 0); PG8_SCHED; PG8_LDA(At, 1, 0); PG8_STAGE(PG8_SA(0, 1), a2 + hstep, voffA);
            PG8_WAIT_L(8); PG8_BAR; PG8_WAIT_L(0); PG8_MMA(0, 0, At, B0); PG8_BAR; PG8_SCHED;
            PG8_LDB(B1, 1, 1); PG8_STAGE(PG8_SB(1, 0), b3, voffB);
            PG8_BAR; PG8_WAIT_L(0); PG8_MMA(0, 1, At, B1); PG8_BAR;
            PG8_LDA(At, 1, 1); PG8_STAGE(PG8_SA(1, 0), a3, voffA);
            PG8_BAR; PG8_WAIT_L(0); PG8_MMA(1, 0, At, B0); PG8_BAR; PG8_SCHED;
            PG8_STAGE(PG8_SB(1, 1), b3 + hstep, voffB);
            PG8_WAIT_V(6); PG8_BAR; PG8_MMA(1, 1, At, B1); PG8_BAR;
            }
        }
        if constexpr (ALIGN_EPI) { if (wr == 0) PG8_BAR; }
        if constexpr (!Epi::AFTER_DRAIN) { E(acc, cur, wr, wc, fr, fq); S.done(cur); }
        if (!has_next) break;
#pragma unroll
        for (int a = 0; a < 2; ++a)
#pragma unroll
            for (int b = 0; b < 2; ++b)
#pragma unroll
                for (int m = 0; m < 4; ++m)
#pragma unroll
                    for (int n = 0; n < 2; ++n) acc[a][b][m][n] = (f32x4){0.f, 0.f, 0.f, 0.f};
        cur = nxt; cA = nA; cB = nB; ++ui;
        if constexpr (ALIGN_EPI) { if (wr == 1) PG8_BAR; }
    }
    PG8_WAIT_V(0);
    if constexpr (!ALIGN_EPI) { if (wr == 0) PG8_BAR; }
    PG8_BAR;
    if constexpr (Epi::AFTER_DRAIN) { E.fused(acc, cur, wr, wc, fr, fq, lds, wid, lane); S.done(cur); }
#undef PG8_SA
#undef PG8_SB
#undef PG8_STAGE
#undef PG8_LDA
#undef PG8_LDB
#undef PG8_MMA
#undef PG8_WAIT_V
#undef PG8_WAIT_L
#undef PG8_BAR
#undef PG8_SCHED
}
}

#define LAS __attribute__((address_space(3)))
typedef LAS unsigned char* ldsp;
typedef unsigned short bf16;
typedef float f32x4 __attribute__((ext_vector_type(4)));
typedef float f32x2 __attribute__((ext_vector_type(2)));
typedef float f32x16 __attribute__((ext_vector_type(16)));
typedef short bf16x8 __attribute__((ext_vector_type(8)));
typedef short s16x4 __attribute__((ext_vector_type(4)));
typedef unsigned u32x4 __attribute__((ext_vector_type(4)));
typedef unsigned u32x2 __attribute__((ext_vector_type(2)));

constexpr int DM = 1024, MP = 4096, MS = 32768, MT = MP + MS, KR = 4096 + 8 * 4608;
constexpr int FFH = 2816, PJ = 2816;
constexpr float EPS = 1e-6f;
constexpr float LAM_INIT = 0.35550907f;
constexpr int C_QLAT = 0, C_KVLAT = 384, C_KROPE = 640, C_GQ = 672, C_GK = 1184, C_GV = 1696, C_GGATE = 2208, C_GOUT = 2240;

constexpr size_t MiB = 1u << 20;
constexpr size_t WS_CTL = 0, WS_MOD = 1 * MiB, WS_ROPE = 2 * MiB, WS_W = 4 * MiB;
constexpr size_t WS_RM_COS = WS_ROPE, WS_RM_SIN = WS_ROPE + 256 * 1024, WS_RD_COS = WS_ROPE + 512 * 1024, WS_RD_SIN = WS_ROPE + 1024 * 1024, WS_LAM = WS_ROPE + 1536 * 1024;
constexpr size_t W_IN = WS_W, W_UQ = W_IN + (size_t)2816 * 1024 * 2, W_UKV = W_UQ + (size_t)768 * 384 * 2, W_ABO = W_UKV + (size_t)1024 * 256 * 2,
                 W_QKV = W_ABO + 2 * MiB, W_CO = W_QKV + 6 * MiB, W_F1 = W_CO + 2 * MiB, W_F2 = W_F1 + 22 * MiB, W_END = W_F2 + 11 * MiB;
constexpr size_t WS_A = 54 * MiB, WS_B = 126 * MiB, WS_C = 324 * MiB, WS_END = 476 * MiB;
static_assert(W_END <= WS_A, "weights fit");
constexpr size_t A_H = WS_A, A_MIX = WS_A, A_QLN = WS_A, A_CKV = WS_A + 28 * MiB;
constexpr size_t B_PROJ = WS_B, B_FFNH = WS_B, B_QD = WS_B, B_KD = WS_B + 72 * MiB;
constexpr size_t R_OUT = WS_C, R_Q = WS_C, R_KN = WS_C + 54 * MiB, R_KROPE = WS_C + 94 * MiB, R_VTM = WS_C + 97 * MiB, R_VTD = WS_C + 72 * MiB;

struct ParamsK {
    const float* in[28];
    float* out;
    unsigned char* ws;
};
struct Params {
    const __attribute__((address_space(4))) char* kp;
    __device__ __forceinline__ const float* inp(int i) const {
#if defined(__HIP_DEVICE_COMPILE__)
        return *(const float* const __attribute__((address_space(4)))*)(kp + 8 * i);
#else
        return nullptr;
#endif
    }
    __device__ __forceinline__ float* outp() const {
#if defined(__HIP_DEVICE_COMPILE__)
        return *(float* const __attribute__((address_space(4)))*)(kp + 8 * 28);
#else
        return nullptr;
#endif
    }
    __device__ __forceinline__ unsigned char* wsp() const {
#if defined(__HIP_DEVICE_COMPILE__)
        return *(unsigned char* const __attribute__((address_space(4)))*)(kp + 8 * 29);
#else
        return nullptr;
#endif
    }
};
enum { I_XP = 0, I_XS, I_CKV, I_CKROPE, I_SF, I_SB, I_CDK, I_CDV, I_C, I_CCTX, I_WMOD, I_BMOD, I_GNORM, I_ABWIN, I_GQ, I_GKV, I_WUQ, I_WUKV, I_WGATE, I_BGATE, I_GGOUT, I_ABWOUT,
       I_CWQKV, I_DLAM, I_DGOUT, I_CWOUT, I_WF1, I_WF2 };
constexpr size_t O_Y = 0, O_CKV = (size_t)MT * 1024, O_KROPE = O_CKV + (size_t)4096 * 256, O_GF = O_KROPE + (size_t)4096 * 32, O_GB = O_GF + (size_t)16 * 4 * 128 * 128,
                 O_DK = O_GB + (size_t)16 * 4 * 128 * 128, O_DV = O_DK + (size_t)4096 * 1024;

typedef float f32x2_cv __attribute__((ext_vector_type(2))); typedef __bf16 bf16x2_cv __attribute__((ext_vector_type(2)));
__device__ __forceinline__ unsigned pkbf(float lo, float hi) { f32x2_cv v = {lo, hi}; bf16x2_cv b = __builtin_convertvector(v, bf16x2_cv); return __builtin_bit_cast(unsigned, b); }
__device__ __forceinline__ float bf_lo(unsigned w) { return __uint_as_float(w << 16); }
__device__ __forceinline__ float bf_hi(unsigned w) { return __uint_as_float(w & 0xffff0000u); }
__device__ __forceinline__ float bf1(bf16 v) { return __uint_as_float((unsigned)v << 16); }
__device__ __forceinline__ bf16 tobf(float f) { return (bf16)(pkbf(f, 0.f) & 0xffffu); }
__device__ __forceinline__ float wave_sum(float v) {
#pragma unroll
    for (int o = 1; o < 64; o <<= 1) v += __shfl_xor(v, o);
    return v;
}
__device__ __forceinline__ float fast_exp2(float x) { return __builtin_amdgcn_exp2f(x); }
__device__ __forceinline__ float fast_rcp(float x) { return __builtin_amdgcn_rcpf(x); }
__device__ __forceinline__ float silu_f(float g) { return g * fast_rcp(1.f + fast_exp2(-1.4426950408889634f * g)); }
__device__ __forceinline__ int key_row(int row) { if (row < MP) return row; const int r = row - MP; return MP + (r >> 12) * 4608 + 512 + (r & 4095); }
__device__ __forceinline__ void vt_pos(int krow, int HD, size_t& base, int& pos, int& Lk) {
    if (krow < MP) { const int kb = krow >> 8; pos = krow & 255; Lk = 256; base = (size_t)kb * HD * 256; }
    else { const int r = krow - MP, b = r / 4608; pos = r - b * 4608; Lk = 4608; base = (size_t)16 * HD * 256 + (size_t)b * HD * 4608; }
}
__device__ __forceinline__ const float* xrow_in(const Params& P, int row) { return row < MP ? P.inp(I_XP) + (size_t)row * DM : P.inp(I_XS) + (size_t)(row - MP) * DM; }
__device__ __forceinline__ int cond_of(int row) { return row < MP ? 0 : 1 + ((row - MP) >> 12); }

namespace pg8 {
template <class F> struct Epi8 {
    static constexpr bool PERM = true, AFTER_DRAIN = false; F f;
    __device__ __forceinline__ void operator()(const f32x4 (&acc)[2][2][4][2], const Unit& u, int wr, int wc, int fr, int fq) const {
        const int row0 = u.pm * BM + wr * 64 + fr, col0 = u.pn * BM + wc * 32 + 8 * fq;
#pragma unroll
        for (int ai = 0; ai < 2; ++ai)
#pragma unroll
            for (int m = 0; m < 4; ++m)
#pragma unroll
                for (int bj = 0; bj < 2; ++bj) { f(row0 + ai * HALF + m * 16, col0 + bj * HALF, acc[ai][bj][m][0], acc[ai][bj][m][1]); asm volatile("" ::: "memory"); }
    }
};
__device__ __forceinline__ ::u32x4 pack8(::f32x4 v0, ::f32x4 v1) { ::u32x4 w; w.x = pkbf(v0[0], v0[1]); w.y = pkbf(v0[2], v0[3]); w.z = pkbf(v1[0], v1[1]); w.w = pkbf(v1[2], v1[3]); return w; }
__device__ __forceinline__ void rot8(::f32x4& v0, ::f32x4& v1, const float* cs, const float* sn) {
    const ::f32x4 c = *(const ::f32x4*)cs, s = *(const ::f32x4*)sn;
    ::f32x4 a, b;
    a[0] = v0[0] * c[0] - v0[1] * s[0]; a[1] = v0[0] * s[0] + v0[1] * c[0];
    a[2] = v0[2] * c[1] - v0[3] * s[1]; a[3] = v0[2] * s[1] + v0[3] * c[1];
    b[0] = v1[0] * c[2] - v1[1] * s[2]; b[1] = v1[0] * s[2] + v1[1] * c[2];
    b[2] = v1[2] * c[3] - v1[3] * s[3]; b[3] = v1[2] * s[3] + v1[3] * c[3];
    v0 = a; v1 = b;
}
struct EmPlain { bf16_t* O; int ldc;
    __device__ __forceinline__ void operator()(int row, int col, ::f32x4 v0, ::f32x4 v1) const { *(::u32x4*)(O + (size_t)row * ldc + col) = pack8(v0, v1); } };
struct EmQ { bf16_t* Q; const float* rc; const float* rs;
    __device__ __forceinline__ void operator()(int row, int col, ::f32x4 v0, ::f32x4 v1) const {
        const int o = col % 96;
        if (o >= 64 && row >= MP) { const int t = (row - MP) & 4095, p0 = (o - 64) >> 1; rot8(v0, v1, rc + t * 16 + p0, rs + t * 16 + p0); }
        *(::u32x4*)(Q + (size_t)row * 768 + col) = pack8(v0, v1); } };
struct EmKV { bf16_t* KN; bf16_t* VT;
    __device__ __forceinline__ void operator()(int row, int col, ::f32x4 v0, ::f32x4 v1) const {
        const int h = col >> 7, o = col & 127;
        if (o < 64) { *(::u32x4*)(KN + (size_t)row * 512 + h * 64 + o) = pack8(v0, v1); }
        else { size_t base; int pos, Lk; vt_pos(row, 512, base, pos, Lk); bf16_t* p = VT + base + (size_t)(h * 64 + o - 64) * Lk + pos;
            const ::u32x4 w = pack8(v0, v1);
            p[0] = (bf16_t)(w.x & 0xffff); p[(size_t)Lk] = (bf16_t)(w.x >> 16); p[(size_t)2 * Lk] = (bf16_t)(w.y & 0xffff); p[(size_t)3 * Lk] = (bf16_t)(w.y >> 16);
            p[(size_t)4 * Lk] = (bf16_t)(w.z & 0xffff); p[(size_t)5 * Lk] = (bf16_t)(w.z >> 16); p[(size_t)6 * Lk] = (bf16_t)(w.w & 0xffff); p[(size_t)7 * Lk] = (bf16_t)(w.w >> 16); } } };
struct EmFFN { bf16_t* O;
    __device__ __forceinline__ void operator()(int row, int col, ::f32x4 v0, ::f32x4 v1) const {
        ::u32x2 w; w.x = pkbf(silu_f(v0[0]) * v1[0], silu_f(v0[1]) * v1[1]); w.y = pkbf(silu_f(v0[2]) * v1[2], silu_f(v0[3]) * v1[3]);
        *(::u32x2*)(O + (size_t)row * FFH + (col >> 1)) = w; } };
struct EmQKV { bf16_t* QD; bf16_t* KD; bf16_t* VT; float* odk; float* odv; const float* rc; const float* rs;
    __device__ __forceinline__ void operator()(int row, int col, ::f32x4 v0, ::f32x4 v1) const {
        if (col < 2048) {
            const int cc = col & 1023;
            if (col >= 1024 && row < MP) { float* o = odk + (size_t)row * 1024 + cc; *(::f32x4*)o = v0; *(::f32x4*)(o + 4) = v1; }
            if (row >= MP) { const int t = (row - MP) & 4095, p0 = (cc & 63) >> 1; rot8(v0, v1, rc + t * 32 + p0, rs + t * 32 + p0); }
            if (col < 1024) *(::u32x4*)(QD + (size_t)row * 1024 + cc) = pack8(v0, v1);
            else *(::u32x4*)(KD + (size_t)key_row(row) * 1024 + cc) = pack8(v0, v1);
        } else {
            const int cc = col - 2048;
            if (row < MP) { float* o = odv + (size_t)row * 1024 + cc; *(::f32x4*)o = v0; *(::f32x4*)(o + 4) = v1; }
            size_t base; int pos, Lk; vt_pos(key_row(row), 1024, base, pos, Lk); bf16_t* p = VT + base + (size_t)cc * Lk + pos;
            const ::u32x4 w = pack8(v0, v1);
            p[0] = (bf16_t)(w.x & 0xffff); p[(size_t)Lk] = (bf16_t)(w.x >> 16); p[(size_t)2 * Lk] = (bf16_t)(w.y & 0xffff); p[(size_t)3 * Lk] = (bf16_t)(w.y >> 16);
            p[(size_t)4 * Lk] = (bf16_t)(w.z & 0xffff); p[(size_t)5 * Lk] = (bf16_t)(w.z >> 16); p[(size_t)6 * Lk] = (bf16_t)(w.w & 0xffff); p[(size_t)7 * Lk] = (bf16_t)(w.w >> 16);
        } } };
template <class F> __device__ __forceinline__ void run_gemm(PG8_LAS unsigned char* lds, const bf16_t* A, const bf16_t* Bt, int M, int N, int K, const F& f) {
    asm volatile("" : "+s"(M), "+s"(N), "+s"(K));
    Gemm g{A, Bt, M, N, K}; StaticOrder S; S.init(M, N, (int)gridDim.x, (int)blockIdx.x);
    Epi8<F> E{f};
    gemm_phase<Epi8<F>, StaticOrder, true, true>(lds, g, S, E);
}
}

template <int MAPMODE> __device__ __forceinline__ int wrow_map(int n) {
    if (MAPMODE == 1) { return n < FFH ? 8 * (n >> 2) + (n & 3) : 8 * ((n - FFH) >> 2) + 4 + ((n - FFH) & 3); }
    return n;
}
template <int MAPMODE> __device__ __forceinline__ void transpose_item(const float* W, int K, int N, bf16* WT, LAS float* scr, int item, int lane) {
    const int nblk = N / 32, kb = item / nblk, nb = item % nblk, k0 = 64 * kb, n0 = 32 * nb;
#pragma unroll 8
    for (int i = 0; i < 32; ++i) { const int kk = 2 * i + (lane >> 5); scr[kk * 33 + (lane & 31)] = W[(size_t)(k0 + kk) * N + n0 + (lane & 31)]; }
    asm volatile("s_waitcnt lgkmcnt(0)" ::: "memory");
    const int c = lane & 7;
#pragma unroll
    for (int j = 0; j < 4; ++j) { const int n = (lane >> 3) + 8 * j; const LAS float* s = scr + (8 * c) * 33 + n;
        u32x4 o; o.x = pkbf(s[0 * 33], s[1 * 33]); o.y = pkbf(s[2 * 33], s[3 * 33]); o.z = pkbf(s[4 * 33], s[5 * 33]); o.w = pkbf(s[6 * 33], s[7 * 33]);
        *(u32x4*)(WT + (size_t)wrow_map<MAPMODE>(n0 + n) * K + k0 + 8 * c) = o; }
    asm volatile("s_waitcnt lgkmcnt(0)" ::: "memory");
}

__device__ __forceinline__ void phase0(const Params& P, ldsp lds) {
    const int tid = tid_opaque(), lane = tid & 63, wave = tid >> 6, G = gridDim.x, bid = blockIdx.x;
    unsigned char* ws = P.wsp();
    {
        LAS float* sc = (LAS float*)lds;
        LAS float* red = (LAS float*)(lds + 9 * 1024 * 4);
        for (int e = tid; e < 9 * 1024; e += 512) { const int ci = e >> 10, k = e & 1023; const float v = ci == 0 ? P.inp(I_CCTX)[k] : P.inp(I_C)[(ci - 1) * 1024 + k]; sc[e] = silu_f(v); }
        __syncthreads();
        float* MOD = (float*)(ws + WS_MOD);
        for (int item = bid; item < 192; item += G) {
            const int li = item / 96, j0 = (item % 96) * 64;
            const float* wm = P.inp(I_WMOD) + (size_t)li * 1024 * 6144 + j0 + lane;
            float acc[9];
#pragma unroll
            for (int c = 0; c < 9; ++c) acc[c] = 0.f;
            const int kbeg = wave * 128;
#pragma unroll 4
            for (int k = kbeg; k < kbeg + 128; ++k) { const float wv = wm[(size_t)k * 6144];
#pragma unroll
                for (int c = 0; c < 9; ++c) acc[c] += sc[c * 1024 + k] * wv; }
#pragma unroll
            for (int c = 0; c < 9; ++c) red[(wave * 9 + c) * 64 + lane] = acc[c];
            __syncthreads();
            for (int e = tid; e < 576; e += 512) { const int c = e >> 6, l = e & 63; float s = 0.f;
#pragma unroll
                for (int w = 0; w < 8; ++w) s += red[(w * 9 + c) * 64 + l];
                MOD[((size_t)li * 9 + c) * 6144 + j0 + l] = s + P.inp(I_BMOD)[li * 6144 + j0 + l]; }
            __syncthreads();
        }
    }
    __syncthreads();
    {
        LAS float* scr = (LAS float*)(lds + wave * 16384);
        const int gw = bid * 8 + wave, NGW = G * 8;
        constexpr int I1 = 16 * 86, I2 = 6 * 24, I3 = 4 * 32, I4 = 16 * 32, I5 = 16 * 96, I6 = 16 * 32, I7 = 16 * 176, I8 = 44 * 32;
        constexpr int NIT = I1 + I2 + I3 + I4 + I5 + I6 + 2 * I7 + 2 * I8;
        for (int it = gw; it < NIT; it += NGW) {
            int r = it;
            if (r < I1) { transpose_item<0>(P.inp(I_ABWIN), 1024, 2752, (bf16*)(ws + W_IN), scr, r, lane); continue; } r -= I1;
            if (r < I2) { transpose_item<0>(P.inp(I_WUQ), 384, 768, (bf16*)(ws + W_UQ), scr, r, lane); continue; } r -= I2;
            if (r < I3) { transpose_item<0>(P.inp(I_WUKV), 256, 1024, (bf16*)(ws + W_UKV), scr, r, lane); continue; } r -= I3;
            if (r < I4) { transpose_item<0>(P.inp(I_ABWOUT), 1024, 1024, (bf16*)(ws + W_ABO), scr, r, lane); continue; } r -= I4;
            if (r < I5) { transpose_item<0>(P.inp(I_CWQKV), 1024, 3072, (bf16*)(ws + W_QKV), scr, r, lane); continue; } r -= I5;
            if (r < I6) { transpose_item<0>(P.inp(I_CWOUT), 1024, 1024, (bf16*)(ws + W_CO), scr, r, lane); continue; } r -= I6;
            if (r < 2 * I7) { const int li = r / I7; transpose_item<1>(P.inp(I_WF1) + (size_t)li * 1024 * 5632, 1024, 5632, (bf16*)(ws + W_F1 + (size_t)li * 11 * MiB), scr, r % I7, lane); continue; } r -= 2 * I7;
            { const int li = r / I8; transpose_item<0>(P.inp(I_WF2) + (size_t)li * 2816 * 1024, 2816, 1024, (bf16*)(ws + W_F2 + (size_t)li * 2816 * 1024 * 2), scr, r % I8, lane); }
        }
    }
    const int gt = bid * 512 + tid, NT = G * 512;
    { u32x4* z = (u32x4*)(ws + W_IN + (size_t)2752 * 1024 * 2); for (int e = gt; e < 64 * 1024 * 2 / 16; e += NT) z[e] = (u32x4){0u, 0u, 0u, 0u}; }
    {
        float* rmc = (float*)(ws + WS_RM_COS); float* rms = (float*)(ws + WS_RM_SIN); float* rdc = (float*)(ws + WS_RD_COS); float* rds = (float*)(ws + WS_RD_SIN);
        for (int e = gt; e < 4096 * 16 + 4096 * 32; e += NT) {
            const bool isd = e >= 4096 * 16; const int ee = isd ? e - 4096 * 16 : e; const int np = isd ? 32 : 16, nf = np >> 1;
            const int t = ee / np, p = ee % np; const int fi = p % nf; const float posv = (float)(p < nf ? (t >> 6) : (t & 63));
            const float inv = exp2f(-(float)fi / (float)nf * 13.287712379549449f);
            const float ang = posv * inv; float rev = ang * 0.15915494309189535f; rev -= rintf(rev);
            const float sn = __builtin_amdgcn_sinf(rev), cs = __builtin_amdgcn_cosf(rev);
            if (isd) { rdc[ee] = cs; rds[ee] = sn; } else { rmc[ee] = cs; rms[ee] = sn; }
        }
    }
    if (bid == 0 && wave == 0) {
        const float* lp = P.inp(I_DLAM);
        const float a = wave_sum(lp[lane] * lp[64 + lane]), b = wave_sum(lp[128 + lane] * lp[192 + lane]);
        if (lane == 0) *(float*)(ws + WS_LAM) = __expf(a) - __expf(b) + LAM_INIT;
    }
}

__device__ __forceinline__ void norm_mod_store(const f32x4 (&v)[4], float ss, const float* g, const float* scale, const float* shift, bf16* hrow, int lane) {
    const float r = 1.f / sqrtf(ss * (1.f / 1024.f) + EPS);
#pragma unroll
    for (int j = 0; j < 4; ++j) { const int c = 4 * lane + 256 * j;
        const f32x4 gg = *(const f32x4*)(g + c), sc = *(const f32x4*)(scale + c), sh = *(const f32x4*)(shift + c);
        const f32x4 h = v[j] * r * gg * (sc + 1.f) + sh;
        u32x2 w; w.x = pkbf(h[0], h[1]); w.y = pkbf(h[2], h[3]); *(u32x2*)(hrow + c) = w; }
}
__device__ __forceinline__ void phase_norm0(const Params& P) {
    const int tid = tid_opaque(), lane = tid & 63, gw = blockIdx.x * 8 + (tid >> 6), NGW = gridDim.x * 8;
    const float* MOD = (const float*)(P.wsp() + WS_MOD); bf16* H = (bf16*)(P.wsp() + A_H);
    for (int row = gw; row < MT; row += NGW) {
        const float* x = xrow_in(P, row); const float* md = MOD + (size_t)(0 * 9 + cond_of(row)) * 6144;
        f32x4 v[4]; float ss = 0.f;
#pragma unroll
        for (int j = 0; j < 4; ++j) { v[j] = *(const f32x4*)(x + 4 * lane + 256 * j); ss += v[j][0] * v[j][0] + v[j][1] * v[j][1] + v[j][2] * v[j][2] + v[j][3] * v[j][3]; }
        ss = wave_sum(ss);
        norm_mod_store(v, ss, P.inp(I_GNORM) + 0, md + 1024, md + 0, H + (size_t)row * DM, lane);
    }
}
__device__ __forceinline__ void phase_resnorm(const Params& P, bool first, int liA, int gA, int gateIdx, bool doH, int liB, int gB, int scaleIdx, int shiftIdx) {
    const int tid = tid_opaque(), lane = tid & 63, gw = blockIdx.x * 8 + (tid >> 6), NGW = gridDim.x * 8;
    const float* MOD = (const float*)(P.wsp() + WS_MOD); bf16* H = (bf16*)(P.wsp() + A_H); const bf16* OUT = (const bf16*)(P.wsp() + R_OUT);
    float* X = P.outp() + O_Y;
    const float* ga = P.inp(I_GNORM) + (liA * 4 + gA) * 1024;
    constexpr int NR = 3;
    for (int row0 = gw; row0 < MT; row0 += NR * NGW) {
        int rows[NR];
#pragma unroll
        for (int u = 0; u < NR; ++u) rows[u] = row0 + u * NGW;
        f32x4 o[NR][4], v[NR][4]; float so[NR];
#pragma unroll
        for (int u = 0; u < NR; ++u) so[u] = 0.f;
#pragma unroll
        for (int u = 0; u < NR; ++u) { if (rows[u] >= MT) break; const int row = rows[u];
            const float* xo = first ? xrow_in(P, row) : X + (size_t)row * DM;
#pragma unroll
            for (int j = 0; j < 4; ++j) { const u32x2 w = *(const u32x2*)(OUT + (size_t)row * DM + 4 * lane + 256 * j);
                o[u][j] = (f32x4){bf_lo(w.x), bf_hi(w.x), bf_lo(w.y), bf_hi(w.y)}; v[u][j] = *(const f32x4*)(xo + 4 * lane + 256 * j); } }
#pragma unroll
        for (int u = 0; u < NR; ++u) { if (rows[u] >= MT) break;
#pragma unroll
            for (int j = 0; j < 4; ++j) so[u] += o[u][j][0] * o[u][j][0] + o[u][j][1] * o[u][j][1] + o[u][j][2] * o[u][j][2] + o[u][j][3] * o[u][j][3]; }
#pragma unroll
        for (int off = 1; off < 64; off <<= 1) {
#pragma unroll
            for (int u = 0; u < NR; ++u) so[u] += __shfl_xor(so[u], off); }
        float ss[NR];
#pragma unroll
        for (int u = 0; u < NR; ++u) ss[u] = 0.f;
#pragma unroll
        for (int u = 0; u < NR; ++u) { if (rows[u] >= MT) break; const int row = rows[u];
            const float* gate = MOD + (size_t)(liA * 9 + cond_of(row)) * 6144 + gateIdx * 1024; const float ro = 1.f / sqrtf(so[u] * (1.f / 1024.f) + EPS);
#pragma unroll
            for (int j = 0; j < 4; ++j) { const int c = 4 * lane + 256 * j; const f32x4 gg = *(const f32x4*)(ga + c), gt = *(const f32x4*)(gate + c);
                v[u][j] = v[u][j] + gt * (o[u][j] * ro * gg); ss[u] += v[u][j][0] * v[u][j][0] + v[u][j][1] * v[u][j][1] + v[u][j][2] * v[u][j][2] + v[u][j][3] * v[u][j][3];
                *(f32x4*)(X + (size_t)row * DM + c) = v[u][j]; } }
        if (doH) {
#pragma unroll
            for (int off = 1; off < 64; off <<= 1) {
#pragma unroll
                for (int u = 0; u < NR; ++u) ss[u] += __shfl_xor(ss[u], off); }
#pragma unroll
            for (int u = 0; u < NR; ++u) { if (rows[u] >= MT) break; const int row = rows[u]; const float* mdB = MOD + (size_t)(liB * 9 + cond_of(row)) * 6144;
                norm_mod_store(v[u], ss[u], P.inp(I_GNORM) + (liB * 4 + gB) * 1024, mdB + scaleIdx * 1024, mdB + shiftIdx * 1024, H + (size_t)row * DM, lane); }
        }
    }
}
__device__ __forceinline__ void phase_mla_prep(const Params& P) {
    const int tid = tid_opaque(), lane = tid & 63, gw = blockIdx.x * 8 + (tid >> 6), NGW = gridDim.x * 8;
    unsigned char* ws = P.wsp(); const bf16* PROJ = (const bf16*)(ws + B_PROJ); bf16* QLN = (bf16*)(ws + A_QLN); bf16* CKV = (bf16*)(ws + A_CKV); bf16* KROPE = (bf16*)(ws + R_KROPE);
    const float* rmc = (const float*)(ws + WS_RM_COS); const float* rms = (const float*)(ws + WS_RM_SIN);
    for (int row = gw; row < MT; row += NGW) {
        const bf16* pr = PROJ + (size_t)row * PJ; const int kr = key_row(row);
        float q[6]; float ss = 0.f;
#pragma unroll
        for (int j = 0; j < 3; ++j) { const unsigned w = *(const unsigned*)(pr + C_QLAT + 2 * lane + 128 * j); q[2 * j] = bf_lo(w); q[2 * j + 1] = bf_hi(w); ss += q[2 * j] * q[2 * j] + q[2 * j + 1] * q[2 * j + 1]; }
        ss = wave_sum(ss); const float rq = 1.f / sqrtf(ss * (1.f / 384.f) + EPS);
#pragma unroll
        for (int j = 0; j < 3; ++j) { const int c = 2 * lane + 128 * j; *(unsigned*)(QLN + (size_t)row * 384 + c) = pkbf(q[2 * j] * rq * P.inp(I_GQ)[c], q[2 * j + 1] * rq * P.inp(I_GQ)[c + 1]); }
        const u32x2 w = *(const u32x2*)(pr + C_KVLAT + 4 * lane); f32x4 kv = (f32x4){bf_lo(w.x), bf_hi(w.x), bf_lo(w.y), bf_hi(w.y)};
        float s2 = wave_sum(kv[0] * kv[0] + kv[1] * kv[1] + kv[2] * kv[2] + kv[3] * kv[3]); const float rk = 1.f / sqrtf(s2 * (1.f / 256.f) + EPS);
        kv = kv * rk * *(const f32x4*)(P.inp(I_GKV) + 4 * lane);
        { u32x2 o; o.x = pkbf(kv[0], kv[1]); o.y = pkbf(kv[2], kv[3]); *(u32x2*)(CKV + (size_t)kr * 256 + 4 * lane) = o; }
        if (row < MP) *(f32x4*)(P.outp() + O_CKV + (size_t)row * 256 + 4 * lane) = kv;
        if (lane < 16) { const unsigned wr = *(const unsigned*)(pr + C_KROPE + 2 * lane); float e = bf_lo(wr), od = bf_hi(wr);
            if (row < MP) { *(f32x2*)(P.outp() + O_KROPE + (size_t)row * 32 + 2 * lane) = (f32x2){e, od}; }
            else { const int t = (row - MP) & 4095; const float c = rmc[t * 16 + lane], s = rms[t * 16 + lane]; const float ne = e * c - od * s, no = e * s + od * c; e = ne; od = no; }
            *(unsigned*)(KROPE + (size_t)kr * 32 + 2 * lane) = pkbf(e, od); }
    }
    const int gt = blockIdx.x * 512 + tid, NT = gridDim.x * 512;
    for (int i = gt; i < 4096 * 256 / 4; i += NT) { const int e = i * 4, sr = e >> 8, col = e & 255; const int dr = MP + (sr >> 9) * 4608 + (sr & 511);
        const f32x4 v = *(const f32x4*)(P.inp(I_CKV) + e); u32x2 o; o.x = pkbf(v[0], v[1]); o.y = pkbf(v[2], v[3]); *(u32x2*)(CKV + (size_t)dr * 256 + col) = o; }
    for (int i = gt; i < 4096 * 32 / 4; i += NT) { const int e = i * 4, sr = e >> 5, col = e & 31; const int dr = MP + (sr >> 9) * 4608 + (sr & 511);
        const f32x4 v = *(const f32x4*)(P.inp(I_CKROPE) + e); u32x2 o; o.x = pkbf(v[0], v[1]); o.y = pkbf(v[2], v[3]); *(u32x2*)(KROPE + (size_t)dr * 32 + col) = o; }
}
__device__ __forceinline__ void phase_diff_ctx(const Params& P) {
    const int gt = blockIdx.x * 512 + tid_opaque(), NT = gridDim.x * 512;
    bf16* KD = (bf16*)(P.wsp() + B_KD); bf16* VT = (bf16*)(P.wsp() + R_VTD);
    for (int i = gt; i < 4096 * 1024 / 4; i += NT) { const int e = i * 4, sr = e >> 10, col = e & 1023; const int dr = MP + (sr >> 9) * 4608 + (sr & 511);
        const f32x4 v = *(const f32x4*)(P.inp(I_CDK) + e); u32x2 o; o.x = pkbf(v[0], v[1]); o.y = pkbf(v[2], v[3]); *(u32x2*)(KD + (size_t)dr * 1024 + col) = o; }
    for (int i = gt; i < 8 * 64 * 1024; i += NT) { const int hd = i & 1023, jg = (i >> 10) & 63, b = i >> 16;
        const float* src = P.inp(I_CDV) + ((size_t)(b * 512 + jg * 8)) * 1024 + hd; float f[8];
#pragma unroll
        for (int k = 0; k < 8; ++k) f[k] = src[(size_t)k * 1024];
        u32x4 o; o.x = pkbf(f[0], f[1]); o.y = pkbf(f[2], f[3]); o.z = pkbf(f[4], f[5]); o.w = pkbf(f[6], f[7]);
        *(u32x4*)(VT + (size_t)16 * 1024 * 256 + (size_t)b * 1024 * 4608 + (size_t)hd * 4608 + jg * 8) = o; }
}

__device__ __forceinline__ f32x16 mfma32(bf16x8 a, bf16x8 b, f32x16 c) { return __builtin_amdgcn_mfma_f32_32x32x16_bf16(a, b, c, 0, 0, 0); }
__device__ __forceinline__ f32x4 mfma16(bf16x8 a, bf16x8 b, f32x4 c) { return __builtin_amdgcn_mfma_f32_16x16x32_bf16(a, b, c, 0, 0, 0); }
__device__ __forceinline__ bf16x8 pack_bf8(float a0, float a1, float a2, float a3, float a4, float a5, float a6, float a7) {
    u32x4 w; w.x = pkbf(a0, a1); w.y = pkbf(a2, a3); w.z = pkbf(a4, a5); w.w = pkbf(a6, a7); return __builtin_bit_cast(bf16x8, w);
}
constexpr int VSTR = 144;
template <int MODE> struct AttnArgs {
    const bf16* Q; const bf16* K; const bf16* K2; const bf16* VTh; bf16* MIX; int row0, krow0, Lk, h; float lam; const float* gout;
};
__device__ __forceinline__ float max3f(float a, float b, float c) { float r; asm("v_max3_f32 %0, %1, %2, %3" : "=v"(r) : "v"(a), "v"(b), "v"(c)); return r; }
template <int MODE> __device__ __forceinline__ void attn_unit(ldsp lds, const AttnArgs<MODE>& A) {
    constexpr int ND = MODE == 0 ? 6 : 4, NMB = MODE == 0 ? 2 : 4, KSTR = MODE == 0 ? 208 : 272, DV = MODE == 0 ? 64 : 128;
    constexpr int KBUF = 64 * KSTR, VBUF = DV * VSTR;
    constexpr float CS = (MODE == 0 ? 0.10206207261596577f : 0.125f) * 1.4426950408889634f;
    const int tid = tid_opaque(), lane = tid & 63, r32 = lane & 31, hi = lane >> 5, wid = tid >> 6;
    const int map = MODE == 1 ? (wid >> 2) : 0;
    const int qrow = A.row0 + (MODE == 0 ? wid * 32 : (wid & 3) * 32) + r32;
    constexpr bool QLDS = MODE == 1;
    constexpr int QST_OFF = 2 * KBUF + 2 * VBUF;
    bf16x8 qf[ND];
#pragma unroll
    for (int d0 = 0; d0 < ND; ++d0) {
        const u32x4 w = MODE == 0 ? *(const u32x4*)(A.Q + (size_t)qrow * 768 + A.h * 96 + 16 * d0 + 8 * hi) : *(const u32x4*)(A.Q + (size_t)qrow * 1024 + A.h * 128 + map * 64 + 16 * d0 + 8 * hi);
        u32x4 s; s.x = pkbf(bf_lo(w.x) * CS, bf_hi(w.x) * CS); s.y = pkbf(bf_lo(w.y) * CS, bf_hi(w.y) * CS); s.z = pkbf(bf_lo(w.z) * CS, bf_hi(w.z) * CS); s.w = pkbf(bf_lo(w.w) * CS, bf_hi(w.w) * CS);
        if (QLDS) *(LAS u32x4*)(lds + QST_OFF + wid * 4608 + r32 * 144 + hi * 16 + d0 * 32) = s; else qf[d0] = __builtin_bit_cast(bf16x8, s);
    }
    const int koff = r32 * KSTR + (MODE == 1 ? map * 128 : 0) + hi * 16;
    const int voff = r32 * VSTR + hi * 16;
    f32x16 o[NMB];
#pragma unroll
    for (int mb = 0; mb < NMB; ++mb) o[mb] = (f32x16){0.f, 0.f, 0.f, 0.f, 0.f, 0.f, 0.f, 0.f, 0.f, 0.f, 0.f, 0.f, 0.f, 0.f, 0.f, 0.f};
    float m_run = 0.f, l_run = 0.f;
    f32x16 negm = (f32x16){0.f, 0.f, 0.f, 0.f, 0.f, 0.f, 0.f, 0.f, 0.f, 0.f, 0.f, 0.f, 0.f, 0.f, 0.f, 0.f};
    const int NT = A.Lk >> 6;
    u32x4 rk0[2], rk1[2], rv0[2], rv1[2];
    const bf16* kg0; const bf16* kg1; const bf16* vg0; const bf16* vg1;
    if (MODE == 0) { kg0 = A.K + (size_t)(A.krow0 + (tid >> 3)) * 512 + A.h * 64 + (tid & 7) * 8; kg1 = A.K2 + (size_t)(A.krow0 + ((tid & 255) >> 2)) * 32 + (tid & 3) * 8;
                     vg0 = A.VTh + (size_t)(tid >> 3) * A.Lk + (tid & 7) * 8; vg1 = vg0; }
    else { kg0 = A.K + (size_t)(A.krow0 + (tid >> 4)) * 1024 + A.h * 128 + (tid & 15) * 8; kg1 = kg0;
           vg0 = A.VTh + (size_t)(tid >> 3) * A.Lk + (tid & 7) * 8; vg1 = vg0; }
    auto gloadK = [&](int t, const int s) {
        if (MODE == 0) { rk0[s] = *(const u32x4*)(kg0 + (size_t)t * 64 * 512); if (tid < 256) rk1[s] = *(const u32x4*)(kg1 + (size_t)t * 64 * 32); }
        else { const bf16* kp = kg0 + (size_t)t * 64 * 1024; rk0[s] = *(const u32x4*)kp; rk1[s] = *(const u32x4*)(kp + (size_t)32 * 1024); }
    };
    auto gloadV = [&](int t, const int s) { const bf16* vp = vg0 + 64 * t; rv0[s] = *(const u32x4*)vp; if (MODE == 1) rv1[s] = *(const u32x4*)(vp + (size_t)64 * A.Lk); };
    auto stK = [&](int buf, const int s) {
        ldsp kb = lds + buf * KBUF;
        if (MODE == 0) { *(LAS u32x4*)(kb + (tid >> 3) * KSTR + (tid & 7) * 16) = rk0[s]; if (tid < 256) *(LAS u32x4*)(kb + (tid >> 2) * KSTR + 128 + (tid & 3) * 16) = rk1[s]; }
        else { *(LAS u32x4*)(kb + (tid >> 4) * KSTR + (tid & 15) * 16) = rk0[s]; *(LAS u32x4*)(kb + (32 + (tid >> 4)) * KSTR + (tid & 15) * 16) = rk1[s]; }
    };
    auto stV = [&](int buf, const int s) {
        ldsp vb = lds + 2 * KBUF + buf * VBUF;
        const int cc = tid & 7, vpo = ((cc >> 1) * 16 + (cc & 1) * 4) * 2;
        LAS u32x2* vp = (LAS u32x2*)(vb + (tid >> 3) * VSTR + vpo); vp[0] = (u32x2){rv0[s].x, rv0[s].y}; vp[2] = (u32x2){rv0[s].z, rv0[s].w};
        if (MODE == 1) { LAS u32x2* vq = (LAS u32x2*)(vb + (64 + (tid >> 3)) * VSTR + vpo); vq[0] = (u32x2){rv1[s].x, rv1[s].y}; vq[2] = (u32x2){rv1[s].z, rv1[s].w}; }
    };
    auto qk = [&](int buf, f32x16& s0, f32x16& s1) {
        ldsp kb = lds + buf * KBUF;
        s0 = negm; s1 = negm;
#pragma unroll
        for (int d0 = 0; d0 < ND; ++d0) {
            const bf16x8 a0 = *(const LAS bf16x8*)(kb + koff + d0 * 32), a1 = *(const LAS bf16x8*)(kb + koff + 32 * KSTR + d0 * 32);
            const bf16x8 qq = QLDS ? *(const LAS bf16x8*)(lds + QST_OFF + wid * 4608 + r32 * 144 + hi * 16 + d0 * 32) : qf[d0];
            s0 = mfma32(a0, qq, s0); s1 = mfma32(a1, qq, s1);
        }
    };
    bf16x8 pf[4];
    f32x16 sc0, sc1;
    float mxa, mxb;
    auto mxstep = [&](int k) {
        if (k == 0) mxa = max3f(sc0[0], sc0[1], sc1[0]);
        else if (k == 1) mxb = max3f(sc0[2], sc0[3], sc1[1]);
        else if (k == 2) mxa = max3f(mxa, sc1[2], sc1[3]);
        else if (k < 15) { const int q = k - 3, r = 4 + 4 * (q >> 2), w = q & 3;
            if (w == 0) mxa = max3f(mxa, sc0[r], sc0[r + 1]); else if (w == 1) mxb = max3f(mxb, sc0[r + 2], sc0[r + 3]);
            else if (w == 2) mxa = max3f(mxa, sc1[r], sc1[r + 1]); else mxb = max3f(mxb, sc1[r + 2], sc1[r + 3]); }
        else mxa = max3f(mxa, mxb, mxb);
    };
    auto pv_max = [&](int buf, const bool dopv) {
        if (!dopv) {
#pragma unroll
            for (int k = 0; k < 16; ++k) mxstep(k);
            return;
        }
        ldsp vb = lds + 2 * KBUF + buf * VBUF;
        constexpr int NS = 2 * NMB;
        bf16x8 vf[2][2];
        auto ldv = [&](int s, bf16x8 (&dst)[2]) {
            const int j = s / (NMB / 2), mp = s % (NMB / 2);
#pragma unroll
            for (int e = 0; e < 2; ++e) { const int mb = 2 * mp + e;
                dst[e] = *(const LAS bf16x8*)(vb + mb * 32 * VSTR + voff + j * 32); }
        };
        ldv(0, vf[0]);
        __builtin_amdgcn_sched_barrier(0);
#pragma unroll
        for (int s = 0; s < NS; ++s) {
            if (s + 1 < NS) { ldv(s + 1, vf[(s + 1) & 1]); __builtin_amdgcn_sched_barrier(0); }
            const int j = s / (NMB / 2), mp = s % (NMB / 2);
#pragma unroll
            for (int e = 0; e < 2; ++e) { const int mb = 2 * mp + e; o[mb] = mfma32(vf[s & 1][e], pf[j], o[mb]);
#pragma unroll
                for (int q = 0; q < 16 / (2 * NS); ++q) mxstep((2 * s + e) * (16 / (2 * NS)) + q); }
            __builtin_amdgcn_sched_barrier(0);
        }
    };
    gloadK(0, 0); gloadK(1, 1); stK(0, 0); stK(1, 1); gloadK(2, 0); gloadV(0, 0);
    __syncthreads();
    qk(0, sc0, sc1);
    __syncthreads();
    auto iter = [&](int t, const int par, const bool first, const bool last) {
        stV(par, 0);
        if (t + 2 < NT) stK(par, 0);
        if (t + 3 < NT) gloadK(t + 3, 0);
        if (!last) gloadV(t + 1, 0);
        pv_max(par ^ 1, !first);
        float mx = fmaxf(mxa, __shfl_xor(mxa, 32));
        if (first || __any(mx > 8.f)) {
            const float dl = first ? mx : fmaxf(mx, 0.f), alpha = fast_exp2(-dl); m_run += dl; l_run *= alpha;
#pragma unroll
            for (int mb = 0; mb < NMB; ++mb)
#pragma unroll
                for (int r = 0; r < 16; ++r) o[mb][r] *= alpha;
#pragma unroll
            for (int r = 0; r < 16; ++r) { sc0[r] -= dl; sc1[r] -= dl; negm[r] = -m_run; }
        }
        f32x16 sn0, sn1;
        if (!last) qk(par ^ 1, sn0, sn1);
        float rs = 0.f;
#pragma unroll
        for (int r = 0; r < 16; ++r) { sc0[r] = fast_exp2(sc0[r]); sc1[r] = fast_exp2(sc1[r]); rs += sc0[r] + sc1[r]; }
        l_run += rs;
        pf[0] = pack_bf8(sc0[0], sc0[1], sc0[2], sc0[3], sc0[4], sc0[5], sc0[6], sc0[7]); pf[1] = pack_bf8(sc0[8], sc0[9], sc0[10], sc0[11], sc0[12], sc0[13], sc0[14], sc0[15]);
        pf[2] = pack_bf8(sc1[0], sc1[1], sc1[2], sc1[3], sc1[4], sc1[5], sc1[6], sc1[7]); pf[3] = pack_bf8(sc1[8], sc1[9], sc1[10], sc1[11], sc1[12], sc1[13], sc1[14], sc1[15]);
        if (!last) { sc0 = sn0; sc1 = sn1; }
        __syncthreads();
    };
    iter(0, 0, true, false);
    iter(1, 1, false, false);
    for (int t = 2; t < NT - 2; t += 2) { iter(t, 0, false, false); iter(t + 1, 1, false, false); }
    iter(NT - 2, 0, false, false);
    iter(NT - 1, 1, false, true);
    pv_max(1, true);
    l_run += __shfl_xor(l_run, 32);
    const float inv = 1.f / l_run;
    __syncthreads();
    if (MODE == 0) {
        bf16* orow = A.MIX + (size_t)qrow * 1024 + A.h * 64;
#pragma unroll
        for (int mb = 0; mb < NMB; ++mb)
#pragma unroll
            for (int g = 0; g < 4; ++g) { u32x2 w; w.x = pkbf(o[mb][4 * g] * inv, o[mb][4 * g + 1] * inv); w.y = pkbf(o[mb][4 * g + 2] * inv, o[mb][4 * g + 3] * inv);
                *(u32x2*)(orow + 32 * mb + 8 * g + 4 * hi) = w; }
    } else {
        LAS float* xb = (LAS float*)lds + (size_t)(wid & 3) * 64 * 64;
        if (wid >= 4) {
#pragma unroll
            for (int mb = 0; mb < NMB; ++mb)
#pragma unroll
                for (int r = 0; r < 16; ++r) xb[(mb * 16 + r) * 64 + lane] = o[mb][r] * inv;
        }
        __syncthreads();
        if (wid < 4) {
            float ss = 0.f;
#pragma unroll
            for (int mb = 0; mb < NMB; ++mb)
#pragma unroll
                for (int r = 0; r < 16; ++r) { const float v = o[mb][r] * inv - A.lam * xb[(mb * 16 + r) * 64 + lane]; o[mb][r] = v; ss += v * v; }
            ss += __shfl_xor(ss, 32);
            const float rr = (1.f - LAM_INIT) / sqrtf(ss * (1.f / 128.f) + EPS);
            bf16* orow = A.MIX + (size_t)qrow * 1024 + A.h * 128;
#pragma unroll
            for (int mb = 0; mb < NMB; ++mb)
#pragma unroll
                for (int g = 0; g < 4; ++g) { const int d = 32 * mb + 8 * g + 4 * hi; const f32x4 gg = *(const f32x4*)(A.gout + d);
                    u32x2 w; w.x = pkbf(o[mb][4 * g] * rr * gg[0], o[mb][4 * g + 1] * rr * gg[1]); w.y = pkbf(o[mb][4 * g + 2] * rr * gg[2], o[mb][4 * g + 3] * rr * gg[3]);
                    *(u32x2*)(orow + d) = w; }
        }
        __syncthreads();
    }
}

__device__ __forceinline__ float logsig(float x) { return fminf(x, 0.f) - __logf(1.f + __expf(-fabsf(x))); }
__device__ __forceinline__ void gla_unit(ldsp lds, const Params& P, bool prompt, int b, int h, int dir) {
    constexpr int QSTR = 272, TSTR = 144;
    constexpr int L_QIN = 0, L_KIN = 64 * QSTR, L_KOT = 2 * 64 * QSTR, L_VT = L_KOT + 128 * TSTR, L_AM = L_VT + 128 * TSTR, L_LR = L_AM + 64 * TSTR, L_TOT = L_LR + 4096, L_DEC = L_TOT + 2048,
                  L_VRAW = L_DEC + 512;
    static_assert(L_VRAW + 64 * QSTR <= 131072, "gla lds");
    const int tid = tid_opaque(), lane = tid & 63, wid = tid >> 6, l16 = lane & 15, q4 = lane >> 4;
    const int L = prompt ? 256 : 4096, nch = L >> 6, rowbase = prompt ? b * 256 : MP + b * 4096;
    const bf16* PROJ = (const bf16*)(P.wsp() + B_PROJ);
    bf16* OD = dir == 0 ? (bf16*)(P.wsp() + B_PROJ) + h * 128 : (bf16*)(P.wsp() + A_MIX) + 512 + h * 128;
    const int ostr = dir == 0 ? PJ : 1024;
    LAS float* dec = (LAS float*)(lds + L_DEC);
    const int vcol = 16 * wid + l16;
    f32x4 S[8];
    if (prompt) {
#pragma unroll
        for (int db = 0; db < 8; ++db) S[db] = (f32x4){0.f, 0.f, 0.f, 0.f};
    } else {
        const float* sfp = P.inp(I_SF); const float* sbp = P.inp(I_SB); asm volatile("" : "+s"(sfp), "+s"(sbp));
        const float* s0 = (dir == 0 ? sfp : sbp) + ((size_t)(b * 4 + h) * 128) * 128 + (size_t)(4 * q4) * 128 + vcol; asm volatile("" : "+v"(s0));
#pragma unroll
        for (int db = 0; db < 8; ++db)
#pragma unroll
            for (int r = 0; r < 4; ++r) S[db][r] = s0[(16 * db + r) * 128];
    }
    const int dq = 16 * wid + l16;
    bf16x8 wgf;
    {
        float wv[8];
#pragma unroll
        for (int j = 0; j < 8; ++j) wv[j] = q4 < 2 ? P.inp(I_WGATE)[(size_t)(dir * 16 + 8 * q4 + j) * 512 + h * 128 + dq] : 0.f;
        wgf = pack_bf8(wv[0], wv[1], wv[2], wv[3], wv[4], wv[5], wv[6], wv[7]);
    }
    const float bg = P.inp(I_BGATE)[dir * 512 + h * 128 + dq];
    u32x4 rq[2], rk[2], rv[2], lrf[4];
    auto raw_load = [&](int ci) {
        const int n = dir == 0 ? ci : nch - 1 - ci; const int tok0 = rowbase + n * 64;
#pragma unroll
        for (int i = 0; i < 2; ++i) { const int idx = tid + 512 * i; const bf16* pr = PROJ + (size_t)(tok0 + (idx >> 4)) * PJ + h * 128 + (idx & 15) * 8;
            rq[i] = *(const u32x4*)(pr + C_GQ); rk[i] = *(const u32x4*)(pr + C_GK); rv[i] = *(const u32x4*)(pr + C_GV); }
        const bf16* pl = PROJ + (size_t)(tok0 + l16) * PJ + C_GGATE + dir * 16 + 8 * (q4 & 1); asm volatile("" : "+v"(pl));
#pragma unroll
        for (int mb = 0; mb < 4; ++mb) { const u32x4 t = *(const u32x4*)(pl + (size_t)(16 * mb) * PJ); lrf[mb] = q4 < 2 ? t : (u32x4){0u, 0u, 0u, 0u}; }
    };
    raw_load(0);
    for (int ci = 0; ci < nch; ++ci) {
        const int n = dir == 0 ? ci : nch - 1 - ci; const int tok0 = rowbase + n * 64;
#pragma unroll
        for (int i = 0; i < 2; ++i) { const int idx = tid + 512 * i, off = (idx >> 4) * QSTR + (idx & 15) * 16;
            *(LAS u32x4*)(lds + L_QIN + off) = rq[i]; *(LAS u32x4*)(lds + L_KIN + off) = rk[i]; *(LAS u32x4*)(lds + L_VRAW + off) = rv[i]; }
        float g[4][4];
#pragma unroll
        for (int mb = 0; mb < 4; ++mb) { const f32x4 acc = mfma16(__builtin_bit_cast(bf16x8, lrf[mb]), wgf, (f32x4){0.f, 0.f, 0.f, 0.f});
#pragma unroll
            for (int r = 0; r < 4; ++r) g[mb][r] = logsig(acc[r] + bg) * (1.f / 16.f); }
        if (ci + 1 < nch) raw_load(ci + 1);
        __syncthreads();
        float qv[4][4], kv[4][4]; bf16 vraw[4][4];
#pragma unroll
        for (int mb = 0; mb < 4; ++mb)
#pragma unroll
            for (int r = 0; r < 4; ++r) { const int off = (16 * mb + 4 * q4 + r) * QSTR + dq * 2;
                qv[mb][r] = bf1(*(const LAS bf16*)(lds + L_QIN + off)); kv[mb][r] = bf1(*(const LAS bf16*)(lds + L_KIN + off)); vraw[mb][r] = *(const LAS bf16*)(lds + L_VRAW + off); }
        float pfx[4][4], total = 0.f;
#pragma unroll
        for (int mb = 0; mb < 4; ++mb) {
            pfx[mb][0] = g[mb][0]; pfx[mb][1] = pfx[mb][0] + g[mb][1]; pfx[mb][2] = pfx[mb][1] + g[mb][2]; pfx[mb][3] = pfx[mb][2] + g[mb][3];
            const float R = pfx[mb][3];
            const float e1 = __shfl_up(R, 16), e2 = __shfl_up(R, 32), e3 = __shfl_up(R, 48);
            const float excl = (q4 >= 1 ? e1 : 0.f) + (q4 >= 2 ? e2 : 0.f) + (q4 >= 3 ? e3 : 0.f);
            const float blk = __shfl(excl + R, 48 + l16);
            const float base = excl + total;
#pragma unroll
            for (int r = 0; r < 4; ++r) pfx[mb][r] += base;
            total += blk;
        }
        if (q4 == 0) dec[dq] = __expf(total);
        {
            const float etot = __expf(total);
#pragma unroll
            for (int mb = 0; mb < 4; ++mb) {
                float ko[4];
#pragma unroll
                for (int r = 0; r < 4; ++r) { const float cum = dir == 0 ? pfx[mb][r] : total - pfx[mb][r] + g[mb][r]; const int s = 16 * mb + 4 * q4 + r;
                    const float ec = __expf(cum), en = fast_rcp(ec);
                    *(LAS bf16*)(lds + L_QIN + s * QSTR + dq * 2) = tobf(qv[mb][r] * 0.08838834764831845f * ec);
                    *(LAS bf16*)(lds + L_KIN + s * QSTR + dq * 2) = tobf(kv[mb][r] * en);
                    ko[r] = kv[mb][r] * en * etot; }
                u32x2 w; w.x = pkbf(ko[0], ko[1]); w.y = pkbf(ko[2], ko[3]);
                *(LAS u32x2*)(lds + L_KOT + dq * TSTR + (16 * mb + 4 * q4) * 2) = w;
                u32x2 v; v.x = vraw[mb][0] | ((unsigned)vraw[mb][1] << 16); v.y = vraw[mb][2] | ((unsigned)vraw[mb][3] << 16);
                *(LAS u32x2*)(lds + L_VT + dq * TSTR + (16 * mb + 4 * q4) * 2) = v;
            }
        }
        __syncthreads();
        {
            const int cb1 = wid >> 1, sh = wid & 1;
#pragma unroll
            for (int nb = 0; nb < 2; ++nb) {
                f32x4 acc = (f32x4){0.f, 0.f, 0.f, 0.f};
#pragma unroll
                for (int kb = 0; kb < 4; ++kb) {
                    const bf16x8 a = *(const LAS bf16x8*)(lds + L_QIN + (16 * cb1 + l16) * QSTR + (32 * kb + 8 * q4) * 2);
                    const bf16x8 bb = *(const LAS bf16x8*)(lds + L_KIN + (32 * sh + 16 * nb + l16) * QSTR + (32 * kb + 8 * q4) * 2);
                    acc = mfma16(a, bb, acc);
                }
                const int s = 32 * sh + 16 * nb + l16;
#pragma unroll
                for (int r = 0; r < 4; ++r) { const int c = 16 * cb1 + 4 * q4 + r; const bool keep = dir == 0 ? (s <= c) : (s >= c);
                    *(LAS bf16*)(lds + L_AM + c * TSTR + s * 2) = tobf(keep ? acc[r] : 0.f); }
            }
        }
        f32x4 o[4];
        {
            bf16x8 sb[4];
#pragma unroll
            for (int kb = 0; kb < 4; ++kb) sb[kb] = pack_bf8(S[2 * kb][0], S[2 * kb][1], S[2 * kb][2], S[2 * kb][3], S[2 * kb + 1][0], S[2 * kb + 1][1], S[2 * kb + 1][2], S[2 * kb + 1][3]);
#pragma unroll
            for (int cb = 0; cb < 4; ++cb) { o[cb] = (f32x4){0.f, 0.f, 0.f, 0.f};
#pragma unroll
                for (int kb = 0; kb < 4; ++kb) {
                    const s16x4 lo = *(const LAS s16x4*)(lds + L_QIN + (16 * cb + l16) * QSTR + (32 * kb + 4 * q4) * 2), hh = *(const LAS s16x4*)(lds + L_QIN + (16 * cb + l16) * QSTR + (32 * kb + 16 + 4 * q4) * 2);
                    const bf16x8 a = (bf16x8){lo[0], lo[1], lo[2], lo[3], hh[0], hh[1], hh[2], hh[3]};
                    o[cb] = mfma16(a, sb[kb], o[cb]);
                } }
        }
        __syncthreads();
        {
            bf16x8 vb[2];
#pragma unroll
            for (int kb = 0; kb < 2; ++kb) vb[kb] = *(const LAS bf16x8*)(lds + L_VT + vcol * TSTR + (32 * kb + 8 * q4) * 2);
#pragma unroll
            for (int cb = 0; cb < 4; ++cb)
#pragma unroll
                for (int kb = 0; kb < 2; ++kb) { const bf16x8 a = *(const LAS bf16x8*)(lds + L_AM + (16 * cb + l16) * TSTR + (32 * kb + 8 * q4) * 2); o[cb] = mfma16(a, vb[kb], o[cb]); }
#pragma unroll
            for (int db = 0; db < 8; ++db) { const f32x4 dc = *(const LAS f32x4*)(lds + L_DEC + (16 * db + 4 * q4) * 4); S[db] = S[db] * dc;
#pragma unroll
                for (int kb = 0; kb < 2; ++kb) { const bf16x8 a = *(const LAS bf16x8*)(lds + L_KOT + (16 * db + l16) * TSTR + (32 * kb + 8 * q4) * 2); S[db] = mfma16(a, vb[kb], S[db]); } }
        }
        {
            bf16* pw0 = OD + (size_t)(tok0 + 4 * q4) * ostr + vcol; asm volatile("" : "+v"(pw0));
#pragma unroll
            for (int cb = 0; cb < 4; ++cb)
#pragma unroll
                for (int r = 0; r < 4; ++r) pw0[(size_t)(16 * cb + r) * ostr] = tobf(o[cb][r]);
        }
        __syncthreads();
    }
    if (prompt) { float* so = P.outp() + (dir == 0 ? O_GF : O_GB) + ((size_t)(b * 4 + h) * 128) * 128 + (size_t)(4 * q4) * 128 + vcol; asm volatile("" : "+v"(so));
#pragma unroll
        for (int db = 0; db < 8; ++db)
#pragma unroll
            for (int r = 0; r < 4; ++r) so[(16 * db + r) * 128] = S[db][r]; }
    __syncthreads();
}
__device__ __forceinline__ void phase_gla_fin(const Params& P) {
    const int tid = tid_opaque(), lane = tid & 63, gw = blockIdx.x * 8 + (tid >> 6), NGW = gridDim.x * 8;
    const bf16* PROJ = (const bf16*)(P.wsp() + B_PROJ); bf16* MIX = (bf16*)(P.wsp() + A_MIX);
    const f32x4 g0 = *(const f32x4*)(P.inp(I_GGOUT) + (8 * lane & 127)), g1 = *(const f32x4*)(P.inp(I_GGOUT) + (8 * lane & 127) + 4);
    for (int row = gw; row < MT; row += NGW) {
        const u32x4 a = *(const u32x4*)(PROJ + (size_t)row * PJ + 8 * lane), bq = *(const u32x4*)(MIX + (size_t)row * 1024 + 512 + 8 * lane), gt = *(const u32x4*)(PROJ + (size_t)row * PJ + C_GOUT + 8 * lane);
        float v[8];
        v[0] = bf_lo(a.x) + bf_lo(bq.x); v[1] = bf_hi(a.x) + bf_hi(bq.x); v[2] = bf_lo(a.y) + bf_lo(bq.y); v[3] = bf_hi(a.y) + bf_hi(bq.y);
        v[4] = bf_lo(a.z) + bf_lo(bq.z); v[5] = bf_hi(a.z) + bf_hi(bq.z); v[6] = bf_lo(a.w) + bf_lo(bq.w); v[7] = bf_hi(a.w) + bf_hi(bq.w);
        float ss = 0.f;
#pragma unroll
        for (int i = 0; i < 8; ++i) ss += v[i] * v[i];
        ss += __shfl_xor(ss, 1); ss += __shfl_xor(ss, 2); ss += __shfl_xor(ss, 4); ss += __shfl_xor(ss, 8);
        const float rr = 1.f / sqrtf(ss * (1.f / 128.f) + EPS);
        u32x4 w;
        w.x = pkbf(v[0] * rr * g0[0] * silu_f(bf_lo(gt.x)), v[1] * rr * g0[1] * silu_f(bf_hi(gt.x))); w.y = pkbf(v[2] * rr * g0[2] * silu_f(bf_lo(gt.y)), v[3] * rr * g0[3] * silu_f(bf_hi(gt.y)));
        w.z = pkbf(v[4] * rr * g1[0] * silu_f(bf_lo(gt.z)), v[5] * rr * g1[1] * silu_f(bf_hi(gt.z))); w.w = pkbf(v[6] * rr * g1[2] * silu_f(bf_lo(gt.w)), v[7] * rr * g1[3] * silu_f(bf_hi(gt.w)));
        *(u32x4*)(MIX + (size_t)row * 1024 + 512 + 8 * lane) = w;
    }
}

#define RLX_AGENT __ATOMIC_RELAXED, __HIP_MEMORY_SCOPE_AGENT
#define XB_TMO      128
#define XB_XCNT(j)  (256  + 64 * (j))
#define XB_XSUB(j)  (1280 + 64 * (j))
#define XB_XGEN(j)  (2304 + 64 * (j))
#define XB_TOP      3328
#define XB_TOPGEN   3392
#define XCD_BAR_WORDS 3456
#define XB_SPIN_CAP (1u << 18)

__device__ __forceinline__ unsigned xb_ld(unsigned* p)              { return __hip_atomic_load(p, __ATOMIC_RELAXED, __HIP_MEMORY_SCOPE_AGENT); }
__device__ __forceinline__ unsigned xb_add(unsigned* p, unsigned v) { return __hip_atomic_fetch_add(p, v, __ATOMIC_RELAXED, __HIP_MEMORY_SCOPE_AGENT); }
__device__ __forceinline__ unsigned xb_xcc_id() { return (unsigned)__builtin_amdgcn_s_getreg((3 << 11) | 20) & 0xFu; }
#define XB_SPIN(cond, bar) do { unsigned _sp = 0; while (cond) { __builtin_amdgcn_s_sleep(1); \
    if ((++_sp & 255u) == 0u) { if (xb_ld(&(bar)[XB_TMO])) break; if (_sp > XB_SPIN_CAP) { atomicAdd(&(bar)[XB_TMO], 1u); break; } } } } while (0)

struct XcdBarrier {
    unsigned* bar; unsigned x;
    volatile LAS unsigned* st;
};

__device__ __forceinline__ XcdBarrier xcd_barrier_post(unsigned* bar, volatile LAS unsigned* st) {
    XcdBarrier b; b.bar = bar; b.x = xb_xcc_id(); b.st = st;
    if (threadIdx.x == 0) (void)xb_add(&bar[XB_XCNT(b.x)], 1u);
    return b;
}
__device__ __forceinline__ void xcd_barrier_complete(unsigned* bar, unsigned x, unsigned& nloc, unsigned& nx) {
    const unsigned G = gridDim.x * gridDim.y * gridDim.z;
    unsigned sum, cnt, mine, sp = 0u;
    for (;;) {
        sum = 0u; cnt = 0u; mine = 0u;
#pragma unroll
        for (unsigned j = 0; j < 16; ++j) { const unsigned c = xb_ld(&bar[XB_XCNT(j)]); sum += c; cnt += (c > 0u) ? 1u : 0u; mine = (j == x) ? c : mine; }
        if (sum == G) break;
        __builtin_amdgcn_s_sleep(1);
        if ((++sp & 255u) == 0u) { if (xb_ld(&bar[XB_TMO])) break; if (sp > XB_SPIN_CAP) { atomicAdd(&bar[XB_TMO], 1u); break; } }
    }
    nloc = mine > 0u ? mine : 1u; nx = cnt > 0u ? cnt : 1u;
}

__device__ __forceinline__ void xcd_barrier(const XcdBarrier& b) {
    asm volatile("s_waitcnt vmcnt(0)" ::: "memory");
    __syncthreads();
    if (threadIdx.x == 0) {
        unsigned* bar = b.bar;
        __builtin_amdgcn_s_waitcnt(0);
        unsigned nloc = b.st[0], nx = b.st[1];
        if (nloc == 0u) { xcd_barrier_complete(bar, b.x, nloc, nx); b.st[0] = nloc; b.st[1] = nx; }
        const unsigned old = xb_add(&bar[XB_XSUB(b.x)], 1u);
        const unsigned gen = old / nloc;
        if (old + 1u == (gen + 1u) * nloc) {
            __builtin_amdgcn_fence(__ATOMIC_RELEASE, "agent");
            asm volatile("s_waitcnt vmcnt(0)" ::: "memory");
            const unsigned og = xb_add(&bar[XB_TOP], 1u);
            const unsigned tg = og / nx;
            if (og + 1u == (tg + 1u) * nx) xb_add(&bar[XB_TOPGEN], 1u);
            else XB_SPIN(xb_ld(&bar[XB_TOPGEN]) == tg, bar);
            __builtin_amdgcn_fence(__ATOMIC_ACQUIRE, "agent");
            xb_add(&bar[XB_XGEN(b.x)], 1u);
            asm volatile("s_waitcnt vmcnt(0)" ::: "memory");
        } else {
            XB_SPIN(xb_ld(&bar[XB_XGEN(b.x)]) == gen, bar);
            __builtin_amdgcn_fence(__ATOMIC_ACQUIRE, "agent");
            asm volatile("s_waitcnt vmcnt(0)" ::: "memory");
        }
    }
    __syncthreads();
}


#ifndef NO_GEMM
#define RUN_GEMM(...) pg8::run_gemm(__VA_ARGS__)
#else
#define RUN_GEMM(...) do{}while(0)
#endif
#ifndef NO_ATT0
#define ATT0(...) attn_unit<0>(__VA_ARGS__)
#else
#define ATT0(...) do{}while(0)
#endif
#ifndef NO_ATT1
#define ATT1(...) attn_unit<1>(__VA_ARGS__)
#else
#define ATT1(...) do{}while(0)
#endif
#ifndef NO_GLA
#define GLA(...) gla_unit(__VA_ARGS__)
#else
#define GLA(...) do{}while(0)
#endif
#ifndef NO_EmPlain
#define RG_EmPlain(...) RUN_GEMM(__VA_ARGS__)
#else
#define RG_EmPlain(...) do{}while(0)
#endif
#ifndef NO_EmQ
#define RG_EmQ(...) RUN_GEMM(__VA_ARGS__)
#else
#define RG_EmQ(...) do{}while(0)
#endif
#ifndef NO_EmKV
#define RG_EmKV(...) RUN_GEMM(__VA_ARGS__)
#else
#define RG_EmKV(...) do{}while(0)
#endif
#ifndef NO_EmFFN
#define RG_EmFFN(...) RUN_GEMM(__VA_ARGS__)
#else
#define RG_EmFFN(...) do{}while(0)
#endif
#ifndef NO_EmQKV
#define RG_EmQKV(...) RUN_GEMM(__VA_ARGS__)
#else
#define RG_EmQKV(...) do{}while(0)
#endif
#ifndef PH_LO
#define PH_LO 0
#endif
#ifndef PH_HI
#define PH_HI 20
#endif
constexpr int LDS_BYTES = 147456;
__device__ __forceinline__ int next_item(unsigned* ctr, ldsp lds) {
    LAS int* slot = (LAS int*)(lds + 131072 + 64);
    __syncthreads();
    if (threadIdx.x == 0) *slot = (int)atomicAdd(ctr, 1u);
    __syncthreads();
    return *slot;
}
__global__ void __launch_bounds__(512, 2) fwd_megakernel(ParamsK Pkarg) {
    extern __shared__ __attribute__((aligned(16))) unsigned char lds_raw[];
    ldsp lds = (ldsp)lds_raw;
    cg::grid_group grid = cg::this_grid();
    XcdBarrier xbar;
    {
        volatile LAS unsigned* stw = (volatile LAS unsigned*)(lds + 131072 + 128);
        if (threadIdx.x < 2) stw[threadIdx.x] = 0u;
        __syncthreads();
#if defined(__HIP_DEVICE_COMPILE__)
        unsigned char* ws0 = *(unsigned char* const __attribute__((address_space(4)))*)((const __attribute__((address_space(4))) char*)__builtin_amdgcn_kernarg_segment_ptr() + 8 * 29);
#else
        unsigned char* ws0 = nullptr;
#endif
        xbar = xcd_barrier_post((unsigned*)(ws0 + WS_CTL) + 4096, stw);
    }
#pragma unroll 1
    for (int ph = PH_LO; ph < PH_HI; ++ph) {
        Params P;
#if defined(__HIP_DEVICE_COMPILE__)
        P.kp = (const __attribute__((address_space(4))) char*)__builtin_amdgcn_kernarg_segment_ptr(); asm volatile("" : "+s"(P.kp));
#else
        P.kp = nullptr;
#endif
        unsigned char* ws = P.wsp();
        unsigned* ctl = (unsigned*)(ws + WS_CTL);
        typedef pg8::bf16_t* bp; typedef const pg8::bf16_t* cbp;
        const float* rmc = (const float*)(ws + WS_RM_COS); const float* rms = (const float*)(ws + WS_RM_SIN); const float* rdc = (const float*)(ws + WS_RD_COS); const float* rds = (const float*)(ws + WS_RD_SIN);
#ifdef REPMASK
        const int nrep = 1 + ((REPMASK >> ph) & 1);
#else
        const int nrep = 1;
#endif
#pragma unroll 1
        for (int rep = 0; rep < nrep; ++rep) {
        if (rep) xcd_barrier(xbar);
        int kind = 0;
        cbp gA = nullptr, gB = nullptr; int gM = 0, gN = 0, gK = 0; bp gO = nullptr; int gldc = 0;
        bool rn_first = false, rn_doH = false; int rn_liA = 0, rn_gA = 0, rn_gate = 0, rn_liB = 0, rn_gB = 0, rn_sc = 0, rn_sh = 0;
        switch (ph) {
        case 0: phase0(P, lds); break;
        case 1: phase_norm0(P); break;
        case 2: kind = 1; gA = (cbp)(ws + A_H); gB = (cbp)(ws + W_IN); gM = MT; gN = PJ; gK = 1024; gO = (bp)(ws + B_PROJ); gldc = PJ; break;
        case 3: phase_mla_prep(P); break;
        case 4: RG_EmQ(lds, (cbp)(ws + A_QLN), (cbp)(ws + W_UQ), MT, 768, 384, pg8::EmQ{(bp)(ws + R_Q), rmc, rms});
                RG_EmKV(lds, (cbp)(ws + A_CKV), (cbp)(ws + W_UKV), KR, 1024, 256, pg8::EmKV{(bp)(ws + R_KN), (bp)(ws + R_VTM)}); break;
        case 5: break;
        case 6: {
            const int xcd = (int)(__builtin_amdgcn_s_getreg((3 << 11) | 20) & 7u);
            for (int qq = 0; qq < 8; ++qq) {
                const int x = (xcd + qq) & 7;
                for (;;) {
                    const int it = next_item(ctl + 64 * x + 1024 * rep, lds);
                    if (it >= 168) break;
                    if (it < 8) { const int u = x * 8 + it; GLA(lds, P, false, u >> 3, (u >> 1) & 3, u & 1); }
                    else if (it >= 136 && it < 152) { const int u = x * 16 + (it - 136); GLA(lds, P, true, u >> 3, (u >> 1) & 3, u & 1); }
                    else { AttnArgs<0> A; A.Q = (const bf16*)(ws + R_Q); A.K = (const bf16*)(ws + R_KN); A.K2 = (const bf16*)(ws + R_KROPE); A.MIX = (bf16*)(ws + A_MIX); A.lam = 0.f; A.gout = nullptr;
                        if (it < 136) { const int j = it - 8, pair = (j >> 4) * 8 + x, b = pair >> 3, h = pair & 7, qb = j & 15;
                            A.VTh = (const bf16*)(ws + R_VTM) + (size_t)16 * 512 * 256 + (size_t)b * 512 * 4608 + (size_t)h * 64 * 4608;
                            A.row0 = MP + b * 4096 + qb * 256; A.krow0 = MP + b * 4608; A.Lk = 4608; A.h = h; }
                        else { const int u = x * 16 + (it - 152), b = u >> 3, h = u & 7;
                            A.VTh = (const bf16*)(ws + R_VTM) + (size_t)b * 512 * 256 + (size_t)h * 64 * 256;
                            A.row0 = b * 256; A.krow0 = b * 256; A.Lk = 256; A.h = h; }
                        ATT0(lds, A); }
                }
            }
        } break;
        case 7: phase_gla_fin(P); break;
        case 8: kind = 1; gA = (cbp)(ws + A_MIX); gB = (cbp)(ws + W_ABO); gM = MT; gN = 1024; gK = 1024; gO = (bp)(ws + R_OUT); gldc = 1024; break;
        case 9: kind = 2; rn_first = true; rn_liA = 0; rn_gA = 1; rn_gate = 2; rn_doH = true; rn_liB = 0; rn_gB = 2; rn_sc = 4; rn_sh = 3; break;
        case 10: kind = 3; gA = (cbp)(ws + A_H); gB = (cbp)(ws + W_F1); gM = MT; gN = 5632; gK = 1024; gO = (bp)(ws + B_FFNH); break;
        case 11: kind = 1; gA = (cbp)(ws + B_FFNH); gB = (cbp)(ws + W_F2); gM = MT; gN = 1024; gK = 2816; gO = (bp)(ws + R_OUT); gldc = 1024; break;
        case 12: kind = 2; rn_liA = 0; rn_gA = 3; rn_gate = 5; rn_doH = true; rn_liB = 1; rn_gB = 0; rn_sc = 1; rn_sh = 0; phase_diff_ctx(P); break;
        case 13: RG_EmQKV(lds, (cbp)(ws + A_H), (cbp)(ws + W_QKV), MT, 3072, 1024, pg8::EmQKV{(bp)(ws + B_QD), (bp)(ws + B_KD), (bp)(ws + R_VTD), P.outp() + O_DK, P.outp() + O_DV, rdc, rds}); break;
        case 14: {
            const float lam = *(const float*)(ws + WS_LAM);
            const int xcd = (int)(__builtin_amdgcn_s_getreg((3 << 11) | 20) & 7u);
            for (int qq = 0; qq < 8; ++qq) {
                const int x = (xcd + qq) & 7;
                for (;;) {
                    const int it = next_item(ctl + 512 + 64 * x + 1024 * rep, lds);
                    if (it >= 288) break;
                    AttnArgs<1> A; A.Q = (const bf16*)(ws + B_QD); A.K = (const bf16*)(ws + B_KD); A.K2 = nullptr; A.MIX = (bf16*)(ws + A_MIX); A.lam = lam; A.gout = P.inp(I_DGOUT);
                    if (it < 256) { const int pair = (it >> 5) * 8 + x, b = pair >> 3, h = pair & 7, qb = it & 31;
                        A.VTh = (const bf16*)(ws + R_VTD) + (size_t)16 * 1024 * 256 + (size_t)b * 1024 * 4608 + (size_t)h * 128 * 4608;
                        A.row0 = MP + b * 4096 + qb * 128; A.krow0 = MP + b * 4608; A.Lk = 4608; A.h = h; }
                    else { const int u = x * 32 + (it - 256), b = u >> 4, h = (u >> 1) & 7, qb = u & 1;
                        A.VTh = (const bf16*)(ws + R_VTD) + (size_t)b * 1024 * 256 + (size_t)h * 128 * 256;
                        A.row0 = b * 256 + qb * 128; A.krow0 = b * 256; A.Lk = 256; A.h = h; }
#ifdef UNIT_REP
                    ATT1(lds, A);
#endif
                    ATT1(lds, A);
                }
            }
        } break;
        case 15: kind = 1; gA = (cbp)(ws + A_MIX); gB = (cbp)(ws + W_CO); gM = MT; gN = 1024; gK = 1024; gO = (bp)(ws + R_OUT); gldc = 1024; break;
        case 16: kind = 2; rn_liA = 1; rn_gA = 1; rn_gate = 2; rn_doH = true; rn_liB = 1; rn_gB = 2; rn_sc = 4; rn_sh = 3; break;
        case 17: kind = 3; gA = (cbp)(ws + A_H); gB = (cbp)(ws + W_F1 + 11 * MiB); gM = MT; gN = 5632; gK = 1024; gO = (bp)(ws + B_FFNH); break;
        case 18: kind = 1; gA = (cbp)(ws + B_FFNH); gB = (cbp)(ws + W_F2 + (size_t)2816 * 1024 * 2); gM = MT; gN = 1024; gK = 2816; gO = (bp)(ws + R_OUT); gldc = 1024; break;
        default: kind = 2; rn_liA = 1; rn_gA = 3; rn_gate = 5; rn_doH = false; break;
        }
        if (kind == 1) RG_EmPlain(lds, gA, gB, gM, gN, gK, pg8::EmPlain{gO, gldc});
        else if (kind == 3) RG_EmFFN(lds, gA, gB, gM, gN, gK, pg8::EmFFN{gO});
        else if (kind == 2) phase_resnorm(P, rn_first, rn_liA, rn_gA, rn_gate, rn_doH, rn_liB, rn_gB, rn_sc, rn_sh);
        }
        if (ph + 1 < PH_HI && ph != 4) { if (ph == 0) grid.sync(); else xcd_barrier(xbar); }
#ifdef EXTRA_SYNCS
        if (ph == 1) { for (int es = 0; es < EXTRA_SYNCS; ++es) xcd_barrier(xbar); }
#endif
    }
}

extern "C" void kernel_launch(void* const* d_in, const int* in_sizes, int n_in, void* d_out, int out_size, void* d_ws, size_t ws_size, hipStream_t stream) {
    static int grid = 0;
    if (grid == 0) {
        if (n_in != 28 || ws_size < WS_END) { fprintf(stderr, "kernel_launch: unexpected n_in %d / ws_size %zu (need %zu)\n", n_in, ws_size, (size_t)WS_END); grid = -1; return; }
        int dev = 0, cus = 0, per_cu = 0;
        hipGetDevice(&dev); hipDeviceGetAttribute(&cus, hipDeviceAttributeMultiprocessorCount, dev);
        if (hipFuncSetAttribute((const void*)fwd_megakernel, hipFuncAttributeMaxDynamicSharedMemorySize, LDS_BYTES) != hipSuccess) { fprintf(stderr, "kernel_launch: hipFuncSetAttribute failed\n"); grid = -1; return; }
        if (hipOccupancyMaxActiveBlocksPerMultiprocessor(&per_cu, (const void*)fwd_megakernel, 512, LDS_BYTES) != hipSuccess || per_cu < 1) { fprintf(stderr, "kernel_launch: occupancy query says %d\n", per_cu); per_cu = 1; }
        (void)hipGetLastError();
        grid = cus * 1;
    }
    if (grid < 0) return;
    hipMemsetAsync((char*)d_ws + WS_CTL, 0, 32768, stream);
    ParamsK p{};
    for (int i = 0; i < 28; ++i) p.in[i] = (const float*)d_in[i];
    p.out = (float*)d_out; p.ws = (unsigned char*)d_ws;
    void* args[] = {&p};
    hipError_t e = hipLaunchCooperativeKernel((const void*)fwd_megakernel, dim3(grid), dim3(512), args, LDS_BYTES, stream);
    if (e != hipSuccess) fprintf(stderr, "cooperative launch failed: %s (grid %d)\n", hipGetErrorString(e), grid);
}
```

```cpp
#include <hip/hip_runtime.h>
#include <hip/hip_cooperative_groups.h>
#include <cstdio>
#include <cstdint>
namespace cg = cooperative_groups;
__device__ __forceinline__ int tid_opaque() { int t = threadIdx.x; asm volatile("" : "+v"(t)); return t; }
namespace pg8 {
#define PG8_LAS __attribute__((address_space(3)))
typedef unsigned short bf16_t;
typedef short bf16x8 __attribute__((ext_vector_type(8)));
typedef float f32x4 __attribute__((ext_vector_type(4)));
typedef unsigned u32x4 __attribute__((ext_vector_type(4)));
constexpr int BM = 256, BK = 64, HALF = 128, HTB = HALF * BK * 2  , STAGE_BYTES = 8 * HTB, NXCD = 8, WGM = 8;

__host__ __device__ __forceinline__ int lds_byte(int r, int c) { const int st = (r >> 4) * 2 + (c >> 5), rr = r & 15, cc = c & 31, ob = rr * 64 + cc * 2; return st * 1024 + (ob ^ (((ob >> 9) & 1) << 5)); }
__host__ __device__ __forceinline__ void stage_rc(int b, int& R, int& C) { const int st = b / 1024, sb = b % 1024, swz = sb ^ (((sb >> 9) & 1) << 5); R = (st >> 1) * 16 + swz / 64; C = (st & 1) * 32 + (swz % 64) / 2; }
__host__ __device__ __forceinline__ int perm32(int rho) { const int n = rho >> 4, i = rho & 15; return 8 * (i >> 2) + 4 * n + (i & 3); }

struct Unit { int pm, pn; };
struct Gemm { const bf16_t* A; const bf16_t* Bt; int M, N, K; };

struct StaticOrder {
    int nM, nN, nwg, G, c;
    __host__ __device__ void init(int M, int N, int G_, int c_) { nM = M / BM; nN = N / BM; nwg = nM * nN; G = G_; c = c_; }
    __host__ __device__ bool next(int i, Unit& u) const {
        const long L = (long)i * G + c; if (L >= nwg) return false;
        int wgid = (int)L; { const int q = nwg / NXCD, r = nwg % NXCD, xcd = wgid % NXCD, off = wgid / NXCD; wgid = (xcd < r ? xcd * (q + 1) : r * (q + 1) + (xcd - r) * q) + off; }
        const int nig = WGM * nN, gid = wgid / nig, fm = gid * WGM, gsz = (nM - fm) < WGM ? (nM - fm) : WGM;
        u.pm = fm + ((wgid % nig) % gsz); u.pn = (wgid % nig) / gsz; return true;
    }
    __device__ __forceinline__ void a_ready(const Unit&) const {}
    __device__ __forceinline__ void done(const Unit&) const {}
};

__device__ __forceinline__ unsigned cvt_pk_bf16(float lo, float hi) { unsigned r; asm volatile("v_cvt_pk_bf16_f32 %0, %1, %2" : "=v"(r) : "v"(lo), "v"(hi)); return r; }
typedef float f32x2 __attribute__((ext_vector_type(2)));
template <class Epi, class Sched, bool ALIGN_EPI = false, bool SP2 = false>
__device__ __forceinline__ void gemm_phase(PG8_LAS unsigned char* lds, const Gemm g, const Sched& S, const Epi& E) {
    const int tid = tid_opaque(), wid = __builtin_amdgcn_readfirstlane(tid >> 6), lane = tid & 63, wr = wid >> 2, wc = wid & 3, fr = lane & 15, fq = lane >> 4;
    const int K = g.K, nt = K / BK;
    unsigned voffA[2], voffB[2];
#pragma unroll
    for (int i = 0; i < 2; ++i) { int R, C; stage_rc(tid * 16 + i * 8192, R, C); const int Rb = Epi::PERM ? ((R & ~31) + perm32(R & 31)) : R;
        voffA[i] = (unsigned)(R * K + C) * 2u; voffB[i] = (unsigned)(Rb * K + C) * 2u; }
    const size_t kstep = (size_t)(BK * 2);
    const size_t hstep = (size_t)HALF * K * 2;
    const size_t tstep = 2 * hstep;
    const unsigned ldsw = (unsigned)wid * 1024u;
    const int aoff = lds_byte(wr * 64 + fr, fq * 8), boff = lds_byte(wc * 32 + fr, fq * 8);
#define PG8_SA(b, h) (((b) * 2 + (h)) * HTB)
#define PG8_SB(b, h) ((4 + (b) * 2 + (h)) * HTB)
#define PG8_STAGE(bufoff, gbase, voff) do { _Pragma("unroll") for (int _i = 0; _i < 2; ++_i) \
        __builtin_amdgcn_global_load_lds((const unsigned*)((const char*)(gbase) + (voff)[_i]), (PG8_LAS unsigned*)(lds + (bufoff) + ldsw + _i * 8192), 16, 0, 0); } while (0)
#define PG8_LDA(dst, b, h) do { _Pragma("unroll") for (int m = 0; m < 4; ++m) _Pragma("unroll") for (int k = 0; k < 2; ++k) dst[m][k] = *(const PG8_LAS bf16x8*)(lds + PG8_SA(b, h) + aoff + m * 2048 + k * 1024); } while (0)
#define PG8_LDB(dst, b, h) do { _Pragma("unroll") for (int n = 0; n < 2; ++n) _Pragma("unroll") for (int k = 0; k < 2; ++k) dst[n][k] = *(const PG8_LAS bf16x8*)(lds + PG8_SB(b, h) + boff + n * 2048 + k * 1024); } while (0)
#define PG8_MMA(ai, bj, At, Bt) do { __builtin_amdgcn_s_setprio(1); _Pragma("unroll") for (int m = 0; m < 4; ++m) _Pragma("unroll") for (int n = 0; n < 2; ++n) _Pragma("unroll") for (int k = 0; k < 2; ++k) \
        acc[ai][bj][m][n] = __builtin_amdgcn_mfma_f32_16x16x32_bf16(Bt[n][k], At[m][k], acc[ai][bj][m][n], 0, 0, 0); __builtin_amdgcn_s_setprio(0); } while (0)
#define PG8_WAIT_V(n) asm volatile("s_waitcnt vmcnt(" #n ")" ::: "memory")
#define PG8_WAIT_L(n) asm volatile("s_waitcnt lgkmcnt(" #n ")" ::: "memory")
#define PG8_BAR __builtin_amdgcn_s_barrier()
#define PG8_SCHED __builtin_amdgcn_sched_barrier(0)
    Unit cur, nxt; int ui = 0;
    if (!S.next(0, cur)) return;
    f32x4 acc[2][2][4][2];
#pragma unroll
    for (int a = 0; a < 2; ++a)
#pragma unroll
        for (int b = 0; b < 2; ++b)
#pragma unroll
            for (int m = 0; m < 4; ++m)
#pragma unroll
                for (int n = 0; n < 2; ++n) acc[a][b][m][n] = (f32x4){0.f, 0.f, 0.f, 0.f};
    bf16x8 At[4][2], B0[2][2], B1[2][2];
    const char* cA = (const char*)g.A + (size_t)cur.pm * tstep; const char* cB = (const char*)g.Bt + (size_t)cur.pn * tstep;
    S.a_ready(cur);
    if constexpr (SP2) {
        PG8_STAGE(PG8_SB(0, 0), cB, voffB); PG8_STAGE(PG8_SB(0, 1), cB + hstep, voffB); PG8_STAGE(PG8_SA(0, 0), cA, voffA); PG8_STAGE(PG8_SA(0, 1), cA + hstep, voffA);
        if (wr == 1) PG8_BAR;
        PG8_WAIT_V(2); PG8_BAR;
        PG8_STAGE(PG8_SB(1, 0), cB + kstep, voffB); PG8_STAGE(PG8_SA(1, 0), cA + kstep, voffA); PG8_STAGE(PG8_SB(1, 1), cB + hstep + kstep, voffB);
        PG8_WAIT_V(6); PG8_BAR;
    } else {
        PG8_STAGE(PG8_SB(0, 0), cB, voffB); PG8_STAGE(PG8_SA(0, 0), cA, voffA); PG8_STAGE(PG8_SB(0, 1), cB + hstep, voffB); PG8_STAGE(PG8_SA(0, 1), cA + hstep, voffA);
        if (wr == 1) PG8_BAR;
        PG8_WAIT_V(4); PG8_BAR;
        PG8_STAGE(PG8_SB(1, 0), cB + kstep, voffB); PG8_STAGE(PG8_SA(1, 0), cA + kstep, voffA); PG8_STAGE(PG8_SB(1, 1), cB + hstep + kstep, voffB);
        PG8_WAIT_V(6); PG8_BAR;
    }
    for (;;) {
        const bool has_next = S.next(ui + 1, nxt);
        const char* nA = has_next ? (const char*)g.A + (size_t)nxt.pm * tstep : cA; const char* nB = has_next ? (const char*)g.Bt + (size_t)nxt.pn * tstep : cB;
        for (int t = 0; t < nt; t += 2) {
            const bool last = (t == nt - 2);
            const char* a1 = cA + (size_t)(t + 1) * kstep;
            const char* a2 = last ? nA : cA + (size_t)(t + 2) * kstep; const char* b2 = last ? nB : cB + (size_t)(t + 2) * kstep;
            const char* a3 = a2 + kstep; const char* b3 = b2 + kstep;
            if (last && has_next) S.a_ready(nxt);
            if constexpr (SP2) {
            PG8_LDB(B0, 0, 0); PG8_LDB(B1, 0, 1); PG8_SCHED; PG8_LDA(At, 0, 0); PG8_STAGE(PG8_SA(1, 1), a1 + hstep, voffA);
            PG8_WAIT_V(8); PG8_WAIT_L(0); PG8_BAR; PG8_MMA(0, 0, At, B0); PG8_MMA(0, 1, At, B1); PG8_BAR; PG8_SCHED;
            PG8_LDA(At, 0, 1); PG8_STAGE(PG8_SB(0, 0), b2, voffB); PG8_STAGE(PG8_SB(0, 1), b2 + hstep, voffB); PG8_STAGE(PG8_SA(0, 0), a2, voffA);
            PG8_WAIT_V(8); PG8_WAIT_L(0); PG8_BAR; PG8_MMA(1, 0, At, B0); PG8_MMA(1, 1, At, B1); PG8_BAR; PG8_SCHED;
            PG8_LDB(B0, 1, 0); PG8_LDB(B1, 1, 1); PG8_SCHED; PG8_LDA(At, 1, 0); PG8_STAGE(PG8_SA(0, 1), a2 + hstep, voffA);
            PG8_WAIT_V(8); PG8_WAIT_L(0); PG8_BAR; PG8_MMA(0, 0, At, B0); PG8_MMA(0, 1, At, B1); PG8_BAR; PG8_SCHED;
            PG8_LDA(At, 1, 1); PG8_STAGE(PG8_SB(1, 0), b3, voffB); PG8_STAGE(PG8_SB(1, 1), b3 + hstep, voffB); PG8_STAGE(PG8_SA(1, 0), a3, voffA);
            PG8_WAIT_V(8); PG8_WAIT_L(0); PG8_BAR; PG8_MMA(1, 0, At, B0); PG8_MMA(1, 1, At, B1); PG8_BAR; PG8_SCHED;
            } else {
            PG8_LDB(B0, 0, 0); PG8_SCHED; PG8_LDA(At, 0, 0); PG8_STAGE(PG8_SA(1, 1), a1 + hstep, voffA);
            PG8_WAIT_L(8); PG8_BAR; PG8_WAIT_L(0); PG8_MMA(0, 0, At, B0); PG8_BAR; PG8_SCHED;
            PG8_LDB(B1, 0, 1); PG8_STAGE(PG8_SB(0, 0), b2, voffB);
            PG8_BAR; PG8_WAIT_L(0); PG8_MMA(0, 1, At, B1); PG8_BAR;
            PG8_LDA(At, 0, 1); PG8_STAGE(PG8_SA(0, 0), a2, voffA);
            PG8_BAR; PG8_WAIT_L(0); PG8_MMA(1, 0, At, B0); PG8_BAR; PG8_SCHED;
            PG8_STAGE(PG8_SB(0, 1), b2 + hstep, voffB);
            PG8_WAIT_V(6); PG8_BAR; PG8_MMA(1, 1, At, B1); PG8_BAR;
            PG8_LDB(B0, 1, 0); PG8_SCHED; PG8_LDA(At, 1, 0); PG8_STAGE(PG8_SA(0, 1), a2 + hstep, voffA);
            PG8_WAIT_L(8); PG8_BAR; PG8_WAIT_L(0); PG8_MMA(0, 0, At, B0); PG8_BAR; PG8_SCHED;
            PG8_LDB(B1, 1, 1); PG8_STAGE(PG8_SB(1, 0), b3, voffB);
            PG8_BAR; PG8_WAIT_L(0); PG8_MMA(0, 1, At, B1); PG8_BAR;
            PG8_LDA(At, 1, 1); PG8_STAGE(PG8_SA(1, 0), a3, voffA);
            PG8_BAR; PG8_WAIT_L(0); PG8_MMA(1, 0, At, B0); PG8_BAR; PG8_SCHED;
            PG8_STAGE(PG8_SB(1, 1), b3 + hstep, voffB);
            PG8_WAIT_V(6); PG8_BAR; PG8_MMA(1, 1, At, B1); PG8_BAR;
            }
        }
        if constexpr (ALIGN_EPI) { if (wr == 0) PG8_BAR; }
        if constexpr (!Epi::AFTER_DRAIN) { E(acc, cur, wr, wc, fr, fq); S.done(cur); }
        if (!has_next) break;
#pragma unroll
        for (int a = 0; a < 2; ++a)
#pragma unroll
            for (int b = 0; b < 2; ++b)
#pragma unroll
                for (int m = 0; m < 4; ++m)
#pragma unroll
                    for (int n = 0; n < 2; ++n) acc[a][b][m][n] = (f32x4){0.f, 0.f, 0.f, 0.f};
        cur = nxt; cA = nA; cB = nB; ++ui;
        if constexpr (ALIGN_EPI) { if (wr == 1) PG8_BAR; }
    }
    PG8_WAIT_V(0);
    if constexpr (!ALIGN_EPI) { if (wr == 0) PG8_BAR; }
    PG8_BAR;
    if constexpr (Epi::AFTER_DRAIN) { E.fused(acc, cur, wr, wc, fr, fq, lds, wid, lane); S.done(cur); }
#undef PG8_SA
#undef PG8_SB
#undef PG8_STAGE
#undef PG8_LDA
#undef PG8_LDB
#undef PG8_MMA
#undef PG8_WAIT_V
#undef PG8_WAIT_L
#undef PG8_BAR
#undef PG8_SCHED
}
}

#define LAS __attribute__((address_space(3)))
typedef LAS unsigned char* ldsp;
typedef unsigned short bf16;
typedef float f32x4 __attribute__((ext_vector_type(4)));
typedef float f32x2 __attribute__((ext_vector_type(2)));
typedef float f32x16 __attribute__((ext_vector_type(16)));
typedef short bf16x8 __attribute__((ext_vector_type(8)));
typedef short s16x4 __attribute__((ext_vector_type(4)));
typedef unsigned u32x4 __attribute__((ext_vector_type(4)));
typedef unsigned u32x2 __attribute__((ext_vector_type(2)));

constexpr int DM = 1024, MP = 4096, MS = 32768, MT = MP + MS, KR = 4096 + 8 * 4608;
constexpr int FFH = 2816, PJ = 2816;
constexpr float EPS = 1e-6f;
constexpr float LAM_INIT = 0.35550907f;
constexpr int C_QLAT = 0, C_KVLAT = 384, C_KROPE = 640, C_GQ = 672, C_GK = 1184, C_GV = 1696, C_GGATE = 2208, C_GOUT = 2240;

constexpr size_t MiB = 1u << 20;
constexpr size_t WS_CTL = 0, WS_MOD = 1 * MiB, WS_ROPE = 2 * MiB, WS_W = 4 * MiB;
constexpr size_t WS_RM_COS = WS_ROPE, WS_RM_SIN = WS_ROPE + 256 * 1024, WS_RD_COS = WS_ROPE + 512 * 1024, WS_RD_SIN = WS_ROPE + 1024 * 1024, WS_LAM = WS_ROPE + 1536 * 1024;
constexpr size_t W_IN = WS_W, W_UQ = W_IN + (size_t)2816 * 1024 * 2, W_UKV = W_UQ + (size_t)768 * 384 * 2, W_ABO = W_UKV + (size_t)1024 * 256 * 2,
                 W_QKV = W_ABO + 2 * MiB, W_CO = W_QKV + 6 * MiB, W_F1 = W_CO + 2 * MiB, W_F2 = W_F1 + 22 * MiB, W_END = W_F2 + 11 * MiB;
constexpr size_t WS_A = 54 * MiB, WS_B = 126 * MiB, WS_C = 324 * MiB, WS_END = 476 * MiB;
static_assert(W_END <= WS_A, "weights fit");
constexpr size_t A_H = WS_A, A_MIX = WS_A, A_QLN = WS_A, A_CKV = WS_A + 28 * MiB;
constexpr size_t B_PROJ = WS_B, B_FFNH = WS_B, B_QD = WS_B, B_KD = WS_B + 72 * MiB;
constexpr size_t R_OUT = WS_C, R_Q = WS_C, R_KN = WS_C + 54 * MiB, R_KROPE = WS_C + 94 * MiB, R_VTM = WS_C + 97 * MiB, R_VTD = WS_C + 72 * MiB;

struct ParamsK {
    const float* in[28];
    float* out;
    unsigned char* ws;
};
struct Params {
    const __attribute__((address_space(4))) char* kp;
    __device__ __forceinline__ const float* inp(int i) const {
#if defined(__HIP_DEVICE_COMPILE__)
        return *(const float* const __attribute__((address_space(4)))*)(kp + 8 * i);
#else
        return nullptr;
#endif
    }
    __device__ __forceinline__ float* outp() const {
#if defined(__HIP_DEVICE_COMPILE__)
        return *(float* const __attribute__((address_space(4)))*)(kp + 8 * 28);
#else
        return nullptr;
#endif
    }
    __device__ __forceinline__ unsigned char* wsp() const {
#if defined(__HIP_DEVICE_COMPILE__)
        return *(unsigned char* const __attribute__((address_space(4)))*)(kp + 8 * 29);
#else
        return nullptr;
#endif
    }
};
enum { I_XP = 0, I_XS, I_CKV, I_CKROPE, I_SF, I_SB, I_CDK, I_CDV, I_C, I_CCTX, I_WMOD, I_BMOD, I_GNORM, I_ABWIN, I_GQ, I_GKV, I_WUQ, I_WUKV, I_WGATE, I_BGATE, I_GGOUT, I_ABWOUT,
       I_CWQKV, I_DLAM, I_DGOUT, I_CWOUT, I_WF1, I_WF2 };
constexpr size_t O_Y = 0, O_CKV = (size_t)MT * 1024, O_KROPE = O_CKV + (size_t)4096 * 256, O_GF = O_KROPE + (size_t)4096 * 32, O_GB = O_GF + (size_t)16 * 4 * 128 * 128,
                 O_DK = O_GB + (size_t)16 * 4 * 128 * 128, O_DV = O_DK + (size_t)4096 * 1024;

typedef float f32x2_cv __attribute__((ext_vector_type(2))); typedef __bf16 bf16x2_cv __attribute__((ext_vector_type(2)));
__device__ __forceinline__ unsigned pkbf(float lo, float hi) { f32x2_cv v = {lo, hi}; bf16x2_cv b = __builtin_convertvector(v, bf16x2_cv); return __builtin_bit_cast(unsigned, b); }
__device__ __forceinline__ float bf_lo(unsigned w) { return __uint_as_float(w << 16); }
__device__ __forceinline__ float bf_hi(unsigned w) { return __uint_as_float(w & 0xffff0000u); }
__device__ __forceinline__ float bf1(bf16 v) { return __uint_as_float((unsigned)v << 16); }
__device__ __forceinline__ bf16 tobf(float f) { return (bf16)(pkbf(f, 0.f) & 0xffffu); }
__device__ __forceinline__ float wave_sum(float v) {
#pragma unroll
    for (int o = 1; o < 64; o <<= 1) v += __shfl_xor(v, o);
    return v;
}
__device__ __forceinline__ float fast_exp2(float x) { return __builtin_amdgcn_exp2f(x); }
__device__ __forceinline__ float fast_rcp(float x) { return __builtin_amdgcn_rcpf(x); }
__device__ __forceinline__ float silu_f(float g) { return g * fast_rcp(1.f + fast_exp2(-1.4426950408889634f * g)); }
__device__ __forceinline__ int key_row(int row) { if (row < MP) return row; const int r = row - MP; return MP + (r >> 12) * 4608 + 512 + (r & 4095); }
__device__ __forceinline__ void vt_pos(int krow, int HD, size_t& base, int& pos, int& Lk) {
    if (krow < MP) { const int kb = krow >> 8; pos = krow & 255; Lk = 256; base = (size_t)kb * HD * 256; }
    else { const int r = krow - MP, b = r / 4608; pos = r - b * 4608; Lk = 4608; base = (size_t)16 * HD * 256 + (size_t)b * HD * 4608; }
}
__device__ __forceinline__ const float* xrow_in(const Params& P, int row) { return row < MP ? P.inp(I_XP) + (size_t)row * DM : P.inp(I_XS) + (size_t)(row - MP) * DM; }
__device__ __forceinline__ int cond_of(int row) { return row < MP ? 0 : 1 + ((row - MP) >> 12); }

namespace pg8 {
template <class F> struct Epi8 {
    static constexpr bool PERM = true, AFTER_DRAIN = false; F f;
    __device__ __forceinline__ void operator()(const f32x4 (&acc)[2][2][4][2], const Unit& u, int wr, int wc, int fr, int fq) const {
        const int row0 = u.pm * BM + wr * 64 + fr, col0 = u.pn * BM + wc * 32 + 8 * fq;
#pragma unroll
        for (int ai = 0; ai < 2; ++ai)
#pragma unroll
            for (int m = 0; m < 4; ++m)
#pragma unroll
                for (int bj = 0; bj < 2; ++bj) { f(row0 + ai * HALF + m * 16, col0 + bj * HALF, acc[ai][bj][m][0], acc[ai][bj][m][1]); asm volatile("" ::: "memory"); }
    }
};
__device__ __forceinline__ ::u32x4 pack8(::f32x4 v0, ::f32x4 v1) { ::u32x4 w; w.x = pkbf(v0[0], v0[1]); w.y = pkbf(v0[2], v0[3]); w.z = pkbf(v1[0], v1[1]); w.w = pkbf(v1[2], v1[3]); return w; }
__device__ __forceinline__ void rot8(::f32x4& v0, ::f32x4& v1, const float* cs, const float* sn) {
    const ::f32x4 c = *(const ::f32x4*)cs, s = *(const ::f32x4*)sn;
    ::f32x4 a, b;
    a[0] = v0[0] * c[0] - v0[1] * s[0]; a[1] = v0[0] * s[0] + v0[1] * c[0];
    a[2] = v0[2] * c[1] - v0[3] * s[1]; a[3] = v0[2] * s[1] + v0[3] * c[1];
    b[0] = v1[0] * c[2] - v1[1] * s[2]; b[1] = v1[0] * s[2] + v1[1] * c[2];
    b[2] = v1[2] * c[3] - v1[3] * s[3]; b[3] = v1[2] * s[3] + v1[3] * c[3];
    v0 = a; v1 = b;
}
struct EmPlain { bf16_t* O; int ldc;
    __device__ __forceinline__ void operator()(int row, int col, ::f32x4 v0, ::f32x4 v1) const { *(::u32x4*)(O + (size_t)row * ldc + col) = pack8(v0, v1); } };
struct EmQ { bf16_t* Q; const float* rc; const float* rs;
    __device__ __forceinline__ void operator()(int row, int col, ::f32x4 v0, ::f32x4 v1) const {
        const int o = col % 96;
        if (o >= 64 && row >= MP) { const int t = (row - MP) & 4095, p0 = (o - 64) >> 1; rot8(v0, v1, rc + t * 16 + p0, rs + t * 16 + p0); }
        *(::u32x4*)(Q + (size_t)row * 768 + col) = pack8(v0, v1); } };
struct EmKV { bf16_t* KN; bf16_t* VT;
    __device__ __forceinline__ void operator()(int row, int col, ::f32x4 v0, ::f32x4 v1) const {
        const int h = col >> 7, o = col & 127;
        if (o < 64) { *(::u32x4*)(KN + (size_t)row * 512 + h * 64 + o) = pack8(v0, v1); }
        else { size_t base; int pos, Lk; vt_pos(row, 512, base, pos, Lk); bf16_t* p = VT + base + (size_t)(h * 64 + o - 64) * Lk + pos;
            const ::u32x4 w = pack8(v0, v1);
            p[0] = (bf16_t)(w.x & 0xffff); p[(size_t)Lk] = (bf16_t)(w.x >> 16); p[(size_t)2 * Lk] = (bf16_t)(w.y & 0xffff); p[(size_t)3 * Lk] = (bf16_t)(w.y >> 16);
            p[(size_t)4 * Lk] = (bf16_t)(w.z & 0xffff); p[(size_t)5 * Lk] = (bf16_t)(w.z >> 16); p[(size_t)6 * Lk] = (bf16_t)(w.w & 0xffff); p[(size_t)7 * Lk] = (bf16_t)(w.w >> 16); } } };
struct EmFFN { bf16_t* O;
    __device__ __forceinline__ void operator()(int row, int col, ::f32x4 v0, ::f32x4 v1) const {
        ::u32x2 w; w.x = pkbf(silu_f(v0[0]) * v1[0], silu_f(v0[1]) * v1[1]); w.y = pkbf(silu_f(v0[2]) * v1[2], silu_f(v0[3]) * v1[3]);
        *(::u32x2*)(O + (size_t)row * FFH + (col >> 1)) = w; } };
struct EmQKV { bf16_t* QD; bf16_t* KD; bf16_t* VT; float* odk; float* odv; const float* rc; const float* rs;
    __device__ __forceinline__ void operator()(int row, int col, ::f32x4 v0, ::f32x4 v1) const {
        if (col < 2048) {
            const int cc = col & 1023;
            if (col >= 1024 && row < MP) { float* o = odk + (size_t)row * 1024 + cc; *(::f32x4*)o = v0; *(::f32x4*)(o + 4) = v1; }
            if (row >= MP) { const int t = (row - MP) & 4095, p0 = (cc & 63) >> 1; rot8(v0, v1, rc + t * 32 + p0, rs + t * 32 + p0); }
            if (col < 1024) *(::u32x4*)(QD + (size_t)row * 1024 + cc) = pack8(v0, v1);
            else *(::u32x4*)(KD + (size_t)key_row(row) * 1024 + cc) = pack8(v0, v1);
        } else {
            const int cc = col - 2048;
            if (row < MP) { float* o = odv + (size_t)row * 1024 + cc; *(::f32x4*)o = v0; *(::f32x4*)(o + 4) = v1; }
            size_t base; int pos, Lk; vt_pos(key_row(row), 1024, base, pos, Lk); bf16_t* p = VT + base + (size_t)cc * Lk + pos;
            const ::u32x4 w = pack8(v0, v1);
            p[0] = (bf16_t)(w.x & 0xffff); p[(size_t)Lk] = (bf16_t)(w.x >> 16); p[(size_t)2 * Lk] = (bf16_t)(w.y & 0xffff); p[(size_t)3 * Lk] = (bf16_t)(w.y >> 16);
            p[(size_t)4 * Lk] = (bf16_t)(w.z & 0xffff); p[(size_t)5 * Lk] = (bf16_t)(w.z >> 16); p[(size_t)6 * Lk] = (bf16_t)(w.w & 0xffff); p[(size_t)7 * Lk] = (bf16_t)(w.w >> 16);
        } } };
template <class F> __device__ __forceinline__ void run_gemm(PG8_LAS unsigned char* lds, const bf16_t* A, const bf16_t* Bt, int M, int N, int K, const F& f) {
    asm volatile("" : "+s"(M), "+s"(N), "+s"(K));
    Gemm g{A, Bt, M, N, K}; StaticOrder S; S.init(M, N, (int)gridDim.x, (int)blockIdx.x);
    Epi8<F> E{f};
    gemm_phase<Epi8<F>, StaticOrder, true, true>(lds, g, S, E);
}
}

template <int MAPMODE> __device__ __forceinline__ int wrow_map(int n) {
    if (MAPMODE == 1) { return n < FFH ? 8 * (n >> 2) + (n & 3) : 8 * ((n - FFH) >> 2) + 4 + ((n - FFH) & 3); }
    return n;
}
template <int MAPMODE> __device__ __forceinline__ void transpose_item(const float* W, int K, int N, bf16* WT, LAS float* scr, int item, int lane) {
    const int nblk = N / 32, kb = item / nblk, nb = item % nblk, k0 = 64 * kb, n0 = 32 * nb;
#pragma unroll 8
    for (int i = 0; i < 32; ++i) { const int kk = 2 * i + (lane >> 5); scr[kk * 33 + (lane & 31)] = W[(size_t)(k0 + kk) * N + n0 + (lane & 31)]; }
    asm volatile("s_waitcnt lgkmcnt(0)" ::: "memory");
    const int c = lane & 7;
#pragma unroll
    for (int j = 0; j < 4; ++j) { const int n = (lane >> 3) + 8 * j; const LAS float* s = scr + (8 * c) * 33 + n;
        u32x4 o; o.x = pkbf(s[0 * 33], s[1 * 33]); o.y = pkbf(s[2 * 33], s[3 * 33]); o.z = pkbf(s[4 * 33], s[5 * 33]); o.w = pkbf(s[6 * 33], s[7 * 33]);
        *(u32x4*)(WT + (size_t)wrow_map<MAPMODE>(n0 + n) * K + k0 + 8 * c) = o; }
    asm volatile("s_waitcnt lgkmcnt(0)" ::: "memory");
}

__device__ __forceinline__ void phase0(const Params& P, ldsp lds) {
    const int tid = tid_opaque(), lane = tid & 63, wave = tid >> 6, G = gridDim.x, bid = blockIdx.x;
    unsigned char* ws = P.wsp();
    {
        LAS float* sc = (LAS float*)lds;
        LAS float* red = (LAS float*)(lds + 9 * 1024 * 4);
        for (int e = tid; e < 9 * 1024; e += 512) { const int ci = e >> 10, k = e & 1023; const float v = ci == 0 ? P.inp(I_CCTX)[k] : P.inp(I_C)[(ci - 1) * 1024 + k]; sc[e] = silu_f(v); }
        __syncthreads();
        float* MOD = (float*)(ws + WS_MOD);
        for (int item = bid; item < 192; item += G) {
            const int li = item / 96, j0 = (item % 96) * 64;
            const float* wm = P.inp(I_WMOD) + (size_t)li * 1024 * 6144 + j0 + lane;
            float acc[9];
#pragma unroll
            for (int c = 0; c < 9; ++c) acc[c] = 0.f;
            const int kbeg = wave * 128;
#pragma unroll 4
            for (int k = kbeg; k < kbeg + 128; ++k) { const float wv = wm[(size_t)k * 6144];
#pragma unroll
                for (int c = 0; c < 9; ++c) acc[c] += sc[c * 1024 + k] * wv; }
#pragma unroll
            for (int c = 0; c < 9; ++c) red[(wave * 9 + c) * 64 + lane] = acc[c];
            __syncthreads();
            for (int e = tid; e < 576; e += 512) { const int c = e >> 6, l = e & 63; float s = 0.f;
#pragma unroll
                for (int w = 0; w < 8; ++w) s += red[(w * 9 + c) * 64 + l];
                MOD[((size_t)li * 9 + c) * 6144 + j0 + l] = s + P.inp(I_BMOD)[li * 6144 + j0 + l]; }
            __syncthreads();
        }
    }
    __syncthreads();
    {
        LAS float* scr = (LAS float*)(lds + wave * 16384);
        const int gw = bid * 8 + wave, NGW = G * 8;
        constexpr int I1 = 16 * 86, I2 = 6 * 24, I3 = 4 * 32, I4 = 16 * 32, I5 = 16 * 96, I6 = 16 * 32, I7 = 16 * 176, I8 = 44 * 32;
        constexpr int NIT = I1 + I2 + I3 + I4 + I5 + I6 + 2 * I7 + 2 * I8;
        for (int it = gw; it < NIT; it += NGW) {
            int r = it;
            if (r < I1) { transpose_item<0>(P.inp(I_ABWIN), 1024, 2752, (bf16*)(ws + W_IN), scr, r, lane); continue; } r -= I1;
            if (r < I2) { transpose_item<0>(P.inp(I_WUQ), 384, 768, (bf16*)(ws + W_UQ), scr, r, lane); continue; } r -= I2;
            if (r < I3) { transpose_item<0>(P.inp(I_WUKV), 256, 1024, (bf16*)(ws + W_UKV), scr, r, lane); continue; } r -= I3;
            if (r < I4) { transpose_item<0>(P.inp(I_ABWOUT), 1024, 1024, (bf16*)(ws + W_ABO), scr, r, lane); continue; } r -= I4;
            if (r < I5) { transpose_item<0>(P.inp(I_CWQKV), 1024, 3072, (bf16*)(ws + W_QKV), scr, r, lane); continue; } r -= I5;
            if (r < I6) { transpose_item<0>(P.inp(I_CWOUT), 1024, 1024, (bf16*)(ws + W_CO), scr, r, lane); continue; } r -= I6;
            if (r < 2 * I7) { const int li = r / I7; transpose_item<1>(P.inp(I_WF1) + (size_t)li * 1024 * 5632, 1024, 5632, (bf16*)(ws + W_F1 + (size_t)li * 11 * MiB), scr, r % I7, lane); continue; } r -= 2 * I7;
            { const int li = r / I8; transpose_item<0>(P.inp(I_WF2) + (size_t)li * 2816 * 1024, 2816, 1024, (bf16*)(ws + W_F2 + (size_t)li * 2816 * 1024 * 2), scr, r % I8, lane); }
        }
    }
    const int gt = bid * 512 + tid, NT = G * 512;
    { u32x4* z = (u32x4*)(ws + W_IN + (size_t)2752 * 1024 * 2); for (int e = gt; e < 64 * 1024 * 2 / 16; e += NT) z[e] = (u32x4){0u, 0u, 0u, 0u}; }
    {
        float* rmc = (float*)(ws + WS_RM_COS); float* rms = (float*)(ws + WS_RM_SIN); float* rdc = (float*)(ws + WS_RD_COS); float* rds = (float*)(ws + WS_RD_SIN);
        for (int e = gt; e < 4096 * 16 + 4096 * 32; e += NT) {
            const bool isd = e >= 4096 * 16; const int ee = isd ? e - 4096 * 16 : e; const int np = isd ? 32 : 16, nf = np >> 1;
            const int t = ee / np, p = ee % np; const int fi = p % nf; const float posv = (float)(p < nf ? (t >> 6) : (t & 63));
            const float inv = exp2f(-(float)fi / (float)nf * 13.287712379549449f);
            const float ang = posv * inv; float rev = ang * 0.15915494309189535f; rev -= rintf(rev);
            const float sn = __builtin_amdgcn_sinf(rev), cs = __builtin_amdgcn_cosf(rev);
            if (isd) { rdc[ee] = cs; rds[ee] = sn; } else { rmc[ee] = cs; rms[ee] = sn; }
        }
    }
    if (bid == 0 && wave == 0) {
        const float* lp = P.inp(I_DLAM);
        const float a = wave_sum(lp[lane] * lp[64 + lane]), b = wave_sum(lp[128 + lane] * lp[192 + lane]);
        if (lane == 0) *(float*)(ws + WS_LAM) = __expf(a) - __expf(b) + LAM_INIT;
    }
}

__device__ __forceinline__ void norm_mod_store(const f32x4 (&v)[4], float ss, const float* g, const float* scale, const float* shift, bf16* hrow, int lane) {
    const float r = 1.f / sqrtf(ss * (1.f / 1024.f) + EPS);
#pragma unroll
    for (int j = 0; j < 4; ++j) { const int c = 4 * lane + 256 * j;
        const f32x4 gg = *(const f32x4*)(g + c), sc = *(const f32x4*)(scale + c), sh = *(const f32x4*)(shift + c);
        const f32x4 h = v[j] * r * gg * (sc + 1.f) + sh;
        u32x2 w; w.x = pkbf(h[0], h[1]); w.y = pkbf(h[2], h[3]); *(u32x2*)(hrow + c) = w; }
}
__device__ __forceinline__ void phase_norm0(const Params& P) {
    const int tid = tid_opaque(), lane = tid & 63, gw = blockIdx.x * 8 + (tid >> 6), NGW = gridDim.x * 8;
    const float* MOD = (const float*)(P.wsp() + WS_MOD); bf16* H = (bf16*)(P.wsp() + A_H);
    for (int row = gw; row < MT; row += NGW) {
        const float* x = xrow_in(P, row); const float* md = MOD + (size_t)(0 * 9 + cond_of(row)) * 6144;
        f32x4 v[4]; float ss = 0.f;
#pragma unroll
        for (int j = 0; j < 4; ++j) { v[j] = *(const f32x4*)(x + 4 * lane + 256 * j); ss += v[j][0] * v[j][0] + v[j][1] * v[j][1] + v[j][2] * v[j][2] + v[j][3] * v[j][3]; }
        ss = wave_sum(ss);
        norm_mod_store(v, ss, P.inp(I_GNORM) + 0, md + 1024, md + 0, H + (size_t)row * DM, lane);
    }
}
__device__ __forceinline__ void phase_resnorm(const Params& P, bool first, int liA, int gA, int gateIdx, bool doH, int liB, int gB, int scaleIdx, int shiftIdx) {
    const int tid = tid_opaque(), lane = tid & 63, gw = blockIdx.x * 8 + (tid >> 6), NGW = gridDim.x * 8;
    const float* MOD = (const float*)(P.wsp() + WS_MOD); bf16* H = (bf16*)(P.wsp() + A_H); const bf16* OUT = (const bf16*)(P.wsp() + R_OUT);
    float* X = P.outp() + O_Y;
    const float* ga = P.inp(I_GNORM) + (liA * 4 + gA) * 1024;
    constexpr int NR = 3;
    for (int row0 = gw; row0 < MT; row0 += NR * NGW) {
        int rows[NR];
#pragma unroll
        for (int u = 0; u < NR; ++u) rows[u] = row0 + u * NGW;
        f32x4 o[NR][4], v[NR][4]; float so[NR];
#pragma unroll
        for (int u = 0; u < NR; ++u) so[u] = 0.f;
#pragma unroll
        for (int u = 0; u < NR; ++u) { if (rows[u] >= MT) break; const int row = rows[u];
            const float* xo = first ? xrow_in(P, row) : X + (size_t)row * DM;
#pragma unroll
            for (int j = 0; j < 4; ++j) { const u32x2 w = *(const u32x2*)(OUT + (size_t)row * DM + 4 * lane + 256 * j);
                o[u][j] = (f32x4){bf_lo(w.x), bf_hi(w.x), bf_lo(w.y), bf_hi(w.y)}; v[u][j] = *(const f32x4*)(xo + 4 * lane + 256 * j); } }
#pragma unroll
        for (int u = 0; u < NR; ++u) { if (rows[u] >= MT) break;
#pragma unroll
            for (int j = 0; j < 4; ++j) so[u] += o[u][j][0] * o[u][j][0] + o[u][j][1] * o[u][j][1] + o[u][j][2] * o[u][j][2] + o[u][j][3] * o[u][j][3]; }
#pragma unroll
        for (int off = 1; off < 64; off <<= 1) {
#pragma unroll
            for (int u = 0; u < NR; ++u) so[u] += __shfl_xor(so[u], off); }
        float ss[NR];
#pragma unroll
        for (int u = 0; u < NR; ++u) ss[u] = 0.f;
#pragma unroll
        for (int u = 0; u < NR; ++u) { if (rows[u] >= MT) break; const int row = rows[u];
            const float* gate = MOD + (size_t)(liA * 9 + cond_of(row)) * 6144 + gateIdx * 1024; const float ro = 1.f / sqrtf(so[u] * (1.f / 1024.f) + EPS);
#pragma unroll
            for (int j = 0; j < 4; ++j) { const int c = 4 * lane + 256 * j; const f32x4 gg = *(const f32x4*)(ga + c), gt = *(const f32x4*)(gate + c);
                v[u][j] = v[u][j] + gt * (o[u][j] * ro * gg); ss[u] += v[u][j][0] * v[u][j][0] + v[u][j][1] * v[u][j][1] + v[u][j][2] * v[u][j][2] + v[u][j][3] * v[u][j][3];
                *(f32x4*)(X + (size_t)row * DM + c) = v[u][j]; } }
        if (doH) {
#pragma unroll
            for (int off = 1; off < 64; off <<= 1) {
#pragma unroll
                for (int u = 0; u < NR; ++u) ss[u] += __shfl_xor(ss[u], off); }
#pragma unroll
            for (int u = 0; u < NR; ++u) { if (rows[u] >= MT) break; const int row = rows[u]; const float* mdB = MOD + (size_t)(liB * 9 + cond_of(row)) * 6144;
                norm_mod_store(v[u], ss[u], P.inp(I_GNORM) + (liB * 4 + gB) * 1024, mdB + scaleIdx * 1024, mdB + shiftIdx * 1024, H + (size_t)row * DM, lane); }
        }
    }
}
__device__ __forceinline__ void phase_mla_prep(const Params& P) {
    const int tid = tid_opaque(), lane = tid & 63, gw = blockIdx.x * 8 + (tid >> 6), NGW = gridDim.x * 8;
    unsigned char* ws = P.wsp(); const bf16* PROJ = (const bf16*)(ws + B_PROJ); bf16* QLN = (bf16*)(ws + A_QLN); bf16* CKV = (bf16*)(ws + A_CKV); bf16* KROPE = (bf16*)(ws + R_KROPE);
    const float* rmc = (const float*)(ws + WS_RM_COS); const float* rms = (const float*)(ws + WS_RM_SIN);
    for (int row = gw; row < MT; row += NGW) {
        const bf16* pr = PROJ + (size_t)row * PJ; const int kr = key_row(row);
        float q[6]; float ss = 0.f;
#pragma unroll
        for (int j = 0; j < 3; ++j) { const unsigned w = *(const unsigned*)(pr + C_QLAT + 2 * lane + 128 * j); q[2 * j] = bf_lo(w); q[2 * j + 1] = bf_hi(w); ss += q[2 * j] * q[2 * j] + q[2 * j + 1] * q[2 * j + 1]; }
        ss = wave_sum(ss); const float rq = 1.f / sqrtf(ss * (1.f / 384.f) + EPS);
#pragma unroll
        for (int j = 0; j < 3; ++j) { const int c = 2 * lane + 128 * j; *(unsigned*)(QLN + (size_t)row * 384 + c) = pkbf(q[2 * j] * rq * P.inp(I_GQ)[c], q[2 * j + 1] * rq * P.inp(I_GQ)[c + 1]); }
        const u32x2 w = *(const u32x2*)(pr + C_KVLAT + 4 * lane); f32x4 kv = (f32x4){bf_lo(w.x), bf_hi(w.x), bf_lo(w.y), bf_hi(w.y)};
        float s2 = wave_sum(kv[0] * kv[0] + kv[1] * kv[1] + kv[2] * kv[2] + kv[3] * kv[3]); const float rk = 1.f / sqrtf(s2 * (1.f / 256.f) + EPS);
        kv = kv * rk * *(const f32x4*)(P.inp(I_GKV) + 4 * lane);
        { u32x2 o; o.x = pkbf(kv[0], kv[1]); o.y = pkbf(kv[2], kv[3]); *(u32x2*)(CKV + (size_t)kr * 256 + 4 * lane) = o; }
        if (row < MP) *(f32x4*)(P.outp() + O_CKV + (size_t)row * 256 + 4 * lane) = kv;
        if (lane < 16) { const unsigned wr = *(const unsigned*)(pr + C_KROPE + 2 * lane); float e = bf_lo(wr), od = bf_hi(wr);
            if (row < MP) { *(f32x2*)(P.outp() + O_KROPE + (size_t)row * 32 + 2 * lane) = (f32x2){e, od}; }
            else { const int t = (row - MP) & 4095; const float c = rmc[t * 16 + lane], s = rms[t * 16 + lane]; const float ne = e * c - od * s, no = e * s + od * c; e = ne; od = no; }
            *(unsigned*)(KROPE + (size_t)kr * 32 + 2 * lane) = pkbf(e, od); }
    }
    const int gt = blockIdx.x * 512 + tid, NT = gridDim.x * 512;
    for (int i = gt; i < 4096 * 256 / 4; i += NT) { const int e = i * 4, sr = e >> 8, col = e & 255; const int dr = MP + (sr >> 9) * 4608 + (sr & 511);
        const f32x4 v = *(const f32x4*)(P.inp(I_CKV) + e); u32x2 o; o.x = pkbf(v[0], v[1]); o.y = pkbf(v[2], v[3]); *(u32x2*)(CKV + (size_t)dr * 256 + col) = o; }
    for (int i = gt; i < 4096 * 32 / 4; i += NT) { const int e = i * 4, sr = e >> 5, col = e & 31; const int dr = MP + (sr >> 9) * 4608 + (sr & 511);
        const f32x4 v = *(const f32x4*)(P.inp(I_CKROPE) + e); u32x2 o; o.x = pkbf(v[0], v[1]); o.y = pkbf(v[2], v[3]); *(u32x2*)(KROPE + (size_t)dr * 32 + col) = o; }
}
__device__ __forceinline__ void phase_diff_ctx(const Params& P) {
    const int gt = blockIdx.x * 512 + tid_opaque(), NT = gridDim.x * 512;
    bf16* KD = (bf16*)(P.wsp() + B_KD); bf16* VT = (bf16*)(P.wsp() + R_VTD);
    for (int i = gt; i < 4096 * 1024 / 4; i += NT) { const int e = i * 4, sr = e >> 10, col = e & 1023; const int dr = MP + (sr >> 9) * 4608 + (sr & 511);
        const f32x4 v = *(const f32x4*)(P.inp(I_CDK) + e); u32x2 o; o.x = pkbf(v[0], v[1]); o.y = pkbf(v[2], v[3]); *(u32x2*)(KD + (size_t)dr * 1024 + col) = o; }
    for (int i = gt; i < 8 * 64 * 1024; i += NT) { const int hd = i & 1023, jg = (i >> 10) & 63, b = i >> 16;
        const float* src = P.inp(I_CDV) + ((size_t)(b * 512 + jg * 8)) * 1024 + hd; float f[8];
#pragma unroll
        for (int k = 0; k < 8; ++k) f[k] = src[(size_t)k * 1024];
        u32x4 o; o.x = pkbf(f[0], f[1]); o.y = pkbf(f[2], f[3]); o.z = pkbf(f[4], f[5]); o.w = pkbf(f[6], f[7]);
        *(u32x4*)(VT + (size_t)16 * 1024 * 256 + (size_t)b * 1024 * 4608 + (size_t)hd * 4608 + jg * 8) = o; }
}

__device__ __forceinline__ f32x16 mfma32(bf16x8 a, bf16x8 b, f32x16 c) { return __builtin_amdgcn_mfma_f32_32x32x16_bf16(a, b, c, 0, 0, 0); }
__device__ __forceinline__ f32x4 mfma16(bf16x8 a, bf16x8 b, f32x4 c) { return __builtin_amdgcn_mfma_f32_16x16x32_bf16(a, b, c, 0, 0, 0); }
__device__ __forceinline__ bf16x8 pack_bf8(float a0, float a1, float a2, float a3, float a4, float a5, float a6, float a7) {
    u32x4 w; w.x = pkbf(a0, a1); w.y = pkbf(a2, a3); w.z = pkbf(a4, a5); w.w = pkbf(a6, a7); return __builtin_bit_cast(bf16x8, w);
}
constexpr int VSTR = 144;
template <int MODE> struct AttnArgs {
    const bf16* Q; const bf16* K; const bf16* K2; const bf16* VTh; bf16* MIX; int row0, krow0, Lk, h; float lam; const float* gout;
};
__device__ __forceinline__ float max3f(float a, float b, float c) { float r; asm("v_max3_f32 %0, %1, %2, %3" : "=v"(r) : "v"(a), "v"(b), "v"(c)); return r; }
template <int MODE> __device__ __forceinline__ void attn_unit(ldsp lds, const AttnArgs<MODE>& A) {
    constexpr int ND = MODE == 0 ? 6 : 4, NMB = MODE == 0 ? 2 : 4, KSTR = MODE == 0 ? 208 : 272, DV = MODE == 0 ? 64 : 128;
    constexpr int KBUF = 64 * KSTR, VBUF = DV * VSTR;
    constexpr float CS = (MODE == 0 ? 0.10206207261596577f : 0.125f) * 1.4426950408889634f;
    const int tid = tid_opaque(), lane = tid & 63, r32 = lane & 31, hi = lane >> 5, wid = tid >> 6;
    const int map = MODE == 1 ? (wid >> 2) : 0;
    const int qrow = A.row0 + (MODE == 0 ? wid * 32 : (wid & 3) * 32) + r32;
    constexpr bool QLDS = false;
    constexpr int QST_OFF = 2 * KBUF + 2 * VBUF;
    bf16x8 qf[ND];
#pragma unroll
    for (int d0 = 0; d0 < ND; ++d0) {
        const u32x4 w = MODE == 0 ? *(const u32x4*)(A.Q + (size_t)qrow * 768 + A.h * 96 + 16 * d0 + 8 * hi) : *(const u32x4*)(A.Q + (size_t)qrow * 1024 + A.h * 128 + map * 64 + 16 * d0 + 8 * hi);
        u32x4 s; s.x = pkbf(bf_lo(w.x) * CS, bf_hi(w.x) * CS); s.y = pkbf(bf_lo(w.y) * CS, bf_hi(w.y) * CS); s.z = pkbf(bf_lo(w.z) * CS, bf_hi(w.z) * CS); s.w = pkbf(bf_lo(w.w) * CS, bf_hi(w.w) * CS);
        if (QLDS) *(LAS u32x4*)(lds + QST_OFF + wid * 4608 + r32 * 144 + hi * 16 + d0 * 32) = s; else qf[d0] = __builtin_bit_cast(bf16x8, s);
    }
    const int koff = r32 * KSTR + (MODE == 1 ? map * 128 : 0) + hi * 16;
    const int voff = r32 * VSTR + hi * 16;
    f32x16 o[NMB];
#pragma unroll
    for (int mb = 0; mb < NMB; ++mb) o[mb] = (f32x16){0.f, 0.f, 0.f, 0.f, 0.f, 0.f, 0.f, 0.f, 0.f, 0.f, 0.f, 0.f, 0.f, 0.f, 0.f, 0.f};
    float m_run = 0.f, l_run = 0.f;
    f32x16 negm = (f32x16){0.f, 0.f, 0.f, 0.f, 0.f, 0.f, 0.f, 0.f, 0.f, 0.f, 0.f, 0.f, 0.f, 0.f, 0.f, 0.f};
    const int NT = A.Lk >> 6;
    u32x4 rk0[2], rk1[2], rv0[2], rv1[2];
    const bf16* kg0; const bf16* kg1; const bf16* vg0; const bf16* vg1;
    if (MODE == 0) { kg0 = A.K + (size_t)(A.krow0 + (tid >> 3)) * 512 + A.h * 64 + (tid & 7) * 8; kg1 = A.K2 + (size_t)(A.krow0 + ((tid & 255) >> 2)) * 32 + (tid & 3) * 8;
                     vg0 = A.VTh + (size_t)(tid >> 3) * A.Lk + (tid & 7) * 8; vg1 = vg0; }
    else { kg0 = A.K + (size_t)(A.krow0 + (tid >> 4)) * 1024 + A.h * 128 + (tid & 15) * 8; kg1 = kg0;
           vg0 = A.VTh + (size_t)(tid >> 3) * A.Lk + (tid & 7) * 8; vg1 = vg0; }
    auto gloadK = [&](int t, const int s) {
        if (MODE == 0) { rk0[s] = *(const u32x4*)(kg0 + (size_t)t * 64 * 512); if (tid < 256) rk1[s] = *(const u32x4*)(kg1 + (size_t)t * 64 * 32); }
        else { const bf16* kp = kg0 + (size_t)t * 64 * 1024; rk0[s] = *(const u32x4*)kp; rk1[s] = *(const u32x4*)(kp + (size_t)32 * 1024); }
    };
    auto gloadV = [&](int t, const int s) { const bf16* vp = vg0 + 64 * t; rv0[s] = *(const u32x4*)vp; if (MODE == 1) rv1[s] = *(const u32x4*)(vp + (size_t)64 * A.Lk); };
    auto stK = [&](int buf, const int s) {
        ldsp kb = lds + buf * KBUF;
        if (MODE == 0) { *(LAS u32x4*)(kb + (tid >> 3) * KSTR + (tid & 7) * 16) = rk0[s]; if (tid < 256) *(LAS u32x4*)(kb + (tid >> 2) * KSTR + 128 + (tid & 3) * 16) = rk1[s]; }
        else { *(LAS u32x4*)(kb + (tid >> 4) * KSTR + (tid & 15) * 16) = rk0[s]; *(LAS u32x4*)(kb + (32 + (tid >> 4)) * KSTR + (tid & 15) * 16) = rk1[s]; }
    };
    auto stV = [&](int buf, const int s) {
        ldsp vb = lds + 2 * KBUF + buf * VBUF;
        const int cc = tid & 7, vpo = ((cc >> 1) * 16 + (cc & 1) * 4) * 2;
        LAS u32x2* vp = (LAS u32x2*)(vb + (tid >> 3) * VSTR + vpo); vp[0] = (u32x2){rv0[s].x, rv0[s].y}; vp[2] = (u32x2){rv0[s].z, rv0[s].w};
        if (MODE == 1) { LAS u32x2* vq = (LAS u32x2*)(vb + (64 + (tid >> 3)) * VSTR + vpo); vq[0] = (u32x2){rv1[s].x, rv1[s].y}; vq[2] = (u32x2){rv1[s].z, rv1[s].w}; }
    };
    auto qk = [&](int buf, f32x16& s0, f32x16& s1) {
        ldsp kb = lds + buf * KBUF;
        s0 = negm; s1 = negm;
#pragma unroll
        for (int d0 = 0; d0 < ND; ++d0) {
            const bf16x8 a0 = *(const LAS bf16x8*)(kb + koff + d0 * 32), a1 = *(const LAS bf16x8*)(kb + koff + 32 * KSTR + d0 * 32);
            const bf16x8 qq = QLDS ? *(const LAS bf16x8*)(lds + QST_OFF + wid * 4608 + r32 * 144 + hi * 16 + d0 * 32) : qf[d0];
            s0 = mfma32(a0, qq, s0); s1 = mfma32(a1, qq, s1);
        }
    };
    bf16x8 pf[4];
    f32x16 sc0, sc1;
    float mxa, mxb;
    auto mxstep = [&](int k) {
        if (k == 0) mxa = max3f(sc0[0], sc0[1], sc1[0]);
        else if (k == 1) mxb = max3f(sc0[2], sc0[3], sc1[1]);
        else if (k == 2) mxa = max3f(mxa, sc1[2], sc1[3]);
        else if (k < 15) { const int q = k - 3, r = 4 + 4 * (q >> 2), w = q & 3;
            if (w == 0) mxa = max3f(mxa, sc0[r], sc0[r + 1]); else if (w == 1) mxb = max3f(mxb, sc0[r + 2], sc0[r + 3]);
            else if (w == 2) mxa = max3f(mxa, sc1[r], sc1[r + 1]); else mxb = max3f(mxb, sc1[r + 2], sc1[r + 3]); }
        else mxa = max3f(mxa, mxb, mxb);
    };
    auto pv_max = [&](int buf, const bool dopv) {
        if (!dopv) {
#pragma unroll
            for (int k = 0; k < 16; ++k) mxstep(k);
            return;
        }
        ldsp vb = lds + 2 * KBUF + buf * VBUF;
        constexpr int NS = 2 * NMB;
        bf16x8 vf[2][2];
        auto ldv = [&](int s, bf16x8 (&dst)[2]) {
            const int j = s / (NMB / 2), mp = s % (NMB / 2);
#pragma unroll
            for (int e = 0; e < 2; ++e) { const int mb = 2 * mp + e;
                dst[e] = *(const LAS bf16x8*)(vb + mb * 32 * VSTR + voff + j * 32); }
        };
        ldv(0, vf[0]);
        __builtin_amdgcn_sched_barrier(0);
#pragma unroll
        for (int s = 0; s < NS; ++s) {
            if (s + 1 < NS) { ldv(s + 1, vf[(s + 1) & 1]); __builtin_amdgcn_sched_barrier(0); }
            const int j = s / (NMB / 2), mp = s % (NMB / 2);
#pragma unroll
            for (int e = 0; e < 2; ++e) { const int mb = 2 * mp + e; o[mb] = mfma32(vf[s & 1][e], pf[j], o[mb]);
#pragma unroll
                for (int q = 0; q < 16 / (2 * NS); ++q) mxstep((2 * s + e) * (16 / (2 * NS)) + q); }
            __builtin_amdgcn_sched_barrier(0);
        }
    };
    gloadK(0, 0); gloadK(1, 1); stK(0, 0); stK(1, 1); gloadK(2, 0); gloadV(0, 0);
    __syncthreads();
    qk(0, sc0, sc1);
    __syncthreads();
    auto iter = [&](int t, const int par, const bool first, const bool last) {
        stV(par, 0);
        if (t + 2 < NT) stK(par, 0);
        if (t + 3 < NT) gloadK(t + 3, 0);
        if (!last) gloadV(t + 1, 0);
        pv_max(par ^ 1, !first);
        float mx = fmaxf(mxa, __shfl_xor(mxa, 32));
        if (first || __any(mx > 8.f)) {
            const float dl = first ? mx : fmaxf(mx, 0.f), alpha = fast_exp2(-dl); m_run += dl; l_run *= alpha;
#pragma unroll
            for (int mb = 0; mb < NMB; ++mb)
#pragma unroll
                for (int r = 0; r < 16; ++r) o[mb][r] *= alpha;
#pragma unroll
            for (int r = 0; r < 16; ++r) { sc0[r] -= dl; sc1[r] -= dl; negm[r] = -m_run; }
        }
        f32x16 sn0, sn1;
        if (!last) qk(par ^ 1, sn0, sn1);
        float rs = 0.f;
#pragma unroll
        for (int r = 0; r < 16; ++r) { sc0[r] = fast_exp2(sc0[r]); sc1[r] = fast_exp2(sc1[r]); rs += sc0[r] + sc1[r]; }
        l_run += rs;
        pf[0] = pack_bf8(sc0[0], sc0[1], sc0[2], sc0[3], sc0[4], sc0[5], sc0[6], sc0[7]); pf[1] = pack_bf8(sc0[8], sc0[9], sc0[10], sc0[11], sc0[12], sc0[13], sc0[14], sc0[15]);
        pf[2] = pack_bf8(sc1[0], sc1[1], sc1[2], sc1[3], sc1[4], sc1[5], sc1[6], sc1[7]); pf[3] = pack_bf8(sc1[8], sc1[9], sc1[10], sc1[11], sc1[12], sc1[13], sc1[14], sc1[15]);
        if (!last) { sc0 = sn0; sc1 = sn1; }
        __syncthreads();
    };
    iter(0, 0, true, false);
    iter(1, 1, false, false);
    for (int t = 2; t < NT - 2; t += 2) { iter(t, 0, false, false); iter(t + 1, 1, false, false); }
    iter(NT - 2, 0, false, false);
    iter(NT - 1, 1, false, true);
    pv_max(1, true);
    l_run += __shfl_xor(l_run, 32);
    const float inv = 1.f / l_run;
    __syncthreads();
    if (MODE == 0) {
        bf16* orow = A.MIX + (size_t)qrow * 1024 + A.h * 64;
#pragma unroll
        for (int mb = 0; mb < NMB; ++mb)
#pragma unroll
            for (int g = 0; g < 4; ++g) { u32x2 w; w.x = pkbf(o[mb][4 * g] * inv, o[mb][4 * g + 1] * inv); w.y = pkbf(o[mb][4 * g + 2] * inv, o[mb][4 * g + 3] * inv);
                *(u32x2*)(orow + 32 * mb + 8 * g + 4 * hi) = w; }
    } else {
        LAS float* xb = (LAS float*)lds + (size_t)(wid & 3) * 64 * 64;
        if (wid >= 4) {
#pragma unroll
            for (int mb = 0; mb < NMB; ++mb)
#pragma unroll
                for (int r = 0; r < 16; ++r) xb[(mb * 16 + r) * 64 + lane] = o[mb][r] * inv;
        }
        __syncthreads();
        if (wid < 4) {
            float ss = 0.f;
#pragma unroll
            for (int mb = 0; mb < NMB; ++mb)
#pragma unroll
                for (int r = 0; r < 16; ++r) { const float v = o[mb][r] * inv - A.lam * xb[(mb * 16 + r) * 64 + lane]; o[mb][r] = v; ss += v * v; }
            ss += __shfl_xor(ss, 32);
            const float rr = (1.f - LAM_INIT) / sqrtf(ss * (1.f / 128.f) + EPS);
            bf16* orow = A.MIX + (size_t)qrow * 1024 + A.h * 128;
#pragma unroll
            for (int mb = 0; mb < NMB; ++mb)
#pragma unroll
                for (int g = 0; g < 4; ++g) { const int d = 32 * mb + 8 * g + 4 * hi; const f32x4 gg = *(const f32x4*)(A.gout + d);
                    u32x2 w; w.x = pkbf(o[mb][4 * g] * rr * gg[0], o[mb][4 * g + 1] * rr * gg[1]); w.y = pkbf(o[mb][4 * g + 2] * rr * gg[2], o[mb][4 * g + 3] * rr * gg[3]);
                    *(u32x2*)(orow + d) = w; }
        }
        __syncthreads();
    }
}

__device__ __forceinline__ float logsig(float x) { return fminf(x, 0.f) - __logf(1.f + __expf(-fabsf(x))); }
__device__ __forceinline__ void gla_unit(ldsp lds, const Params& P, bool prompt, int b, int h, int dir) {
    constexpr int QSTR = 272, TSTR = 144;
    constexpr int L_QIN = 0, L_KIN = 64 * QSTR, L_KOT = 2 * 64 * QSTR, L_VT = L_KOT + 128 * TSTR, L_AM = L_VT + 128 * TSTR, L_LR = L_AM + 64 * TSTR, L_TOT = L_LR + 4096, L_DEC = L_TOT + 2048,
                  L_VRAW = L_DEC + 512;
    static_assert(L_VRAW + 64 * QSTR <= 131072, "gla lds");
    const int tid = tid_opaque(), lane = tid & 63, wid = tid >> 6, l16 = lane & 15, q4 = lane >> 4;
    const int L = prompt ? 256 : 4096, nch = L >> 6, rowbase = prompt ? b * 256 : MP + b * 4096;
    const bf16* PROJ = (const bf16*)(P.wsp() + B_PROJ);
    bf16* OD = dir == 0 ? (bf16*)(P.wsp() + B_PROJ) + h * 128 : (bf16*)(P.wsp() + A_MIX) + 512 + h * 128;
    const int ostr = dir == 0 ? PJ : 1024;
    LAS float* dec = (LAS float*)(lds + L_DEC);
    const int vcol = 16 * wid + l16;
    f32x4 S[8];
    if (prompt) {
#pragma unroll
        for (int db = 0; db < 8; ++db) S[db] = (f32x4){0.f, 0.f, 0.f, 0.f};
    } else {
        const float* sfp = P.inp(I_SF); const float* sbp = P.inp(I_SB); asm volatile("" : "+s"(sfp), "+s"(sbp));
        const float* s0 = (dir == 0 ? sfp : sbp) + ((size_t)(b * 4 + h) * 128) * 128 + (size_t)(4 * q4) * 128 + vcol; asm volatile("" : "+v"(s0));
#pragma unroll
        for (int db = 0; db < 8; ++db)
#pragma unroll
            for (int r = 0; r < 4; ++r) S[db][r] = s0[(16 * db + r) * 128];
    }
    const int dq = 16 * wid + l16;
    bf16x8 wgf;
    {
        float wv[8];
#pragma unroll
        for (int j = 0; j < 8; ++j) wv[j] = q4 < 2 ? P.inp(I_WGATE)[(size_t)(dir * 16 + 8 * q4 + j) * 512 + h * 128 + dq] : 0.f;
        wgf = pack_bf8(wv[0], wv[1], wv[2], wv[3], wv[4], wv[5], wv[6], wv[7]);
    }
    const float bg = P.inp(I_BGATE)[dir * 512 + h * 128 + dq];
    u32x4 rq[2], rk[2], rv[2], lrf[4];
    auto raw_load = [&](int ci) {
        const int n = dir == 0 ? ci : nch - 1 - ci; const int tok0 = rowbase + n * 64;
#pragma unroll
        for (int i = 0; i < 2; ++i) { const int idx = tid + 512 * i; const bf16* pr = PROJ + (size_t)(tok0 + (idx >> 4)) * PJ + h * 128 + (idx & 15) * 8;
            rq[i] = *(const u32x4*)(pr + C_GQ); rk[i] = *(const u32x4*)(pr + C_GK); rv[i] = *(const u32x4*)(pr + C_GV); }
        const bf16* pl = PROJ + (size_t)(tok0 + l16) * PJ + C_GGATE + dir * 16 + 8 * (q4 & 1); asm volatile("" : "+v"(pl));
#pragma unroll
        for (int mb = 0; mb < 4; ++mb) { const u32x4 t = *(const u32x4*)(pl + (size_t)(16 * mb) * PJ); lrf[mb] = q4 < 2 ? t : (u32x4){0u, 0u, 0u, 0u}; }
    };
    raw_load(0);
    for (int ci = 0; ci < nch; ++ci) {
        const int n = dir == 0 ? ci : nch - 1 - ci; const int tok0 = rowbase + n * 64;
#pragma unroll
        for (int i = 0; i < 2; ++i) { const int idx = tid + 512 * i, off = (idx >> 4) * QSTR + (idx & 15) * 16;
            *(LAS u32x4*)(lds + L_QIN + off) = rq[i]; *(LAS u32x4*)(lds + L_KIN + off) = rk[i]; *(LAS u32x4*)(lds + L_VRAW + off) = rv[i]; }
        float g[4][4];
#pragma unroll
        for (int mb = 0; mb < 4; ++mb) { const f32x4 acc = mfma16(__builtin_bit_cast(bf16x8, lrf[mb]), wgf, (f32x4){0.f, 0.f, 0.f, 0.f});
#pragma unroll
            for (int r = 0; r < 4; ++r) g[mb][r] = logsig(acc[r] + bg) * (1.f / 16.f); }
        if (ci + 1 < nch) raw_load(ci + 1);
        __syncthreads();
        float qv[4][4], kv[4][4]; bf16 vraw[4][4];
#pragma unroll
        for (int mb = 0; mb < 4; ++mb)
#pragma unroll
            for (int r = 0; r < 4; ++r) { const int off = (16 * mb + 4 * q4 + r) * QSTR + dq * 2;
                qv[mb][r] = bf1(*(const LAS bf16*)(lds + L_QIN + off)); kv[mb][r] = bf1(*(const LAS bf16*)(lds + L_KIN + off)); vraw[mb][r] = *(const LAS bf16*)(lds + L_VRAW + off); }
        float pfx[4][4], total = 0.f;
#pragma unroll
        for (int mb = 0; mb < 4; ++mb) {
            pfx[mb][0] = g[mb][0]; pfx[mb][1] = pfx[mb][0] + g[mb][1]; pfx[mb][2] = pfx[mb][1] + g[mb][2]; pfx[mb][3] = pfx[mb][2] + g[mb][3];
            const float R = pfx[mb][3];
            const float e1 = __shfl_up(R, 16), e2 = __shfl_up(R, 32), e3 = __shfl_up(R, 48);
            const float excl = (q4 >= 1 ? e1 : 0.f) + (q4 >= 2 ? e2 : 0.f) + (q4 >= 3 ? e3 : 0.f);
            const float blk = __shfl(excl + R, 48 + l16);
            const float base = excl + total;
#pragma unroll
            for (int r = 0; r < 4; ++r) pfx[mb][r] += base;
            total += blk;
        }
        if (q4 == 0) dec[dq] = __expf(total);
        {
            const float etot = __expf(total);
#pragma unroll
            for (int mb = 0; mb < 4; ++mb) {
                float ko[4];
#pragma unroll
                for (int r = 0; r < 4; ++r) { const float cum = dir == 0 ? pfx[mb][r] : total - pfx[mb][r] + g[mb][r]; const int s = 16 * mb + 4 * q4 + r;
                    const float ec = __expf(cum), en = fast_rcp(ec);
                    *(LAS bf16*)(lds + L_QIN + s * QSTR + dq * 2) = tobf(qv[mb][r] * 0.08838834764831845f * ec);
                    *(LAS bf16*)(lds + L_KIN + s * QSTR + dq * 2) = tobf(kv[mb][r] * en);
                    ko[r] = kv[mb][r] * en * etot; }
                u32x2 w; w.x = pkbf(ko[0], ko[1]); w.y = pkbf(ko[2], ko[3]);
                *(LAS u32x2*)(lds + L_KOT + dq * TSTR + (16 * mb + 4 * q4) * 2) = w;
                u32x2 v; v.x = vraw[mb][0] | ((unsigned)vraw[mb][1] << 16); v.y = vraw[mb][2] | ((unsigned)vraw[mb][3] << 16);
                *(LAS u32x2*)(lds + L_VT + dq * TSTR + (16 * mb + 4 * q4) * 2) = v;
            }
        }
        __syncthreads();
        {
            const int cb1 = wid >> 1, sh = wid & 1;
#pragma unroll
            for (int nb = 0; nb < 2; ++nb) {
                f32x4 acc = (f32x4){0.f, 0.f, 0.f, 0.f};
#pragma unroll
                for (int kb = 0; kb < 4; ++kb) {
                    const bf16x8 a = *(const LAS bf16x8*)(lds + L_QIN + (16 * cb1 + l16) * QSTR + (32 * kb + 8 * q4) * 2);
                    const bf16x8 bb = *(const LAS bf16x8*)(lds + L_KIN + (32 * sh + 16 * nb + l16) * QSTR + (32 * kb + 8 * q4) * 2);
                    acc = mfma16(a, bb, acc);
                }
                const int s = 32 * sh + 16 * nb + l16;
#pragma unroll
                for (int r = 0; r < 4; ++r) { const int c = 16 * cb1 + 4 * q4 + r; const bool keep = dir == 0 ? (s <= c) : (s >= c);
                    *(LAS bf16*)(lds + L_AM + c * TSTR + s * 2) = tobf(keep ? acc[r] : 0.f); }
            }
        }
        f32x4 o[4];
        {
            bf16x8 sb[4];
#pragma unroll
            for (int kb = 0; kb < 4; ++kb) sb[kb] = pack_bf8(S[2 * kb][0], S[2 * kb][1], S[2 * kb][2], S[2 * kb][3], S[2 * kb + 1][0], S[2 * kb + 1][1], S[2 * kb + 1][2], S[2 * kb + 1][3]);
#pragma unroll
            for (int cb = 0; cb < 4; ++cb) { o[cb] = (f32x4){0.f, 0.f, 0.f, 0.f};
#pragma unroll
                for (int kb = 0; kb < 4; ++kb) {
                    const s16x4 lo = *(const LAS s16x4*)(lds + L_QIN + (16 * cb + l16) * QSTR + (32 * kb + 4 * q4) * 2), hh = *(const LAS s16x4*)(lds + L_QIN + (16 * cb + l16) * QSTR + (32 * kb + 16 + 4 * q4) * 2);
                    const bf16x8 a = (bf16x8){lo[0], lo[1], lo[2], lo[3], hh[0], hh[1], hh[2], hh[3]};
                    o[cb] = mfma16(a, sb[kb], o[cb]);
                } }
        }
        __syncthreads();
        {
            bf16x8 vb[2];
#pragma unroll
            for (int kb = 0; kb < 2; ++kb) vb[kb] = *(const LAS bf16x8*)(lds + L_VT + vcol * TSTR + (32 * kb + 8 * q4) * 2);
#pragma unroll
            for (int cb = 0; cb < 4; ++cb)
#pragma unroll
                for (int kb = 0; kb < 2; ++kb) { const bf16x8 a = *(const LAS bf16x8*)(lds + L_AM + (16 * cb + l16) * TSTR + (32 * kb + 8 * q4) * 2); o[cb] = mfma16(a, vb[kb], o[cb]); }
#pragma unroll
            for (int db = 0; db < 8; ++db) { const f32x4 dc = *(const LAS f32x4*)(lds + L_DEC + (16 * db + 4 * q4) * 4); S[db] = S[db] * dc;
#pragma unroll
                for (int kb = 0; kb < 2; ++kb) { const bf16x8 a = *(const LAS bf16x8*)(lds + L_KOT + (16 * db + l16) * TSTR + (32 * kb + 8 * q4) * 2); S[db] = mfma16(a, vb[kb], S[db]); } }
        }
        {
            bf16* pw0 = OD + (size_t)(tok0 + 4 * q4) * ostr + vcol; asm volatile("" : "+v"(pw0));
#pragma unroll
            for (int cb = 0; cb < 4; ++cb)
#pragma unroll
                for (int r = 0; r < 4; ++r) pw0[(size_t)(16 * cb + r) * ostr] = tobf(o[cb][r]);
        }
        __syncthreads();
    }
    if (prompt) { float* so = P.outp() + (dir == 0 ? O_GF : O_GB) + ((size_t)(b * 4 + h) * 128) * 128 + (size_t)(4 * q4) * 128 + vcol; asm volatile("" : "+v"(so));
#pragma unroll
        for (int db = 0; db < 8; ++db)
#pragma unroll
            for (int r = 0; r < 4; ++r) so[(16 * db + r) * 128] = S[db][r]; }
    __syncthreads();
}
__device__ __forceinline__ void phase_gla_fin(const Params& P) {
    const int tid = tid_opaque(), lane = tid & 63, gw = blockIdx.x * 8 + (tid >> 6), NGW = gridDim.x * 8;
    const bf16* PROJ = (const bf16*)(P.wsp() + B_PROJ); bf16* MIX = (bf16*)(P.wsp() + A_MIX);
    const f32x4 g0 = *(const f32x4*)(P.inp(I_GGOUT) + (8 * lane & 127)), g1 = *(const f32x4*)(P.inp(I_GGOUT) + (8 * lane & 127) + 4);
    for (int row = gw; row < MT; row += NGW) {
        const u32x4 a = *(const u32x4*)(PROJ + (size_t)row * PJ + 8 * lane), bq = *(const u32x4*)(MIX + (size_t)row * 1024 + 512 + 8 * lane), gt = *(const u32x4*)(PROJ + (size_t)row * PJ + C_GOUT + 8 * lane);
        float v[8];
        v[0] = bf_lo(a.x) + bf_lo(bq.x); v[1] = bf_hi(a.x) + bf_hi(bq.x); v[2] = bf_lo(a.y) + bf_lo(bq.y); v[3] = bf_hi(a.y) + bf_hi(bq.y);
        v[4] = bf_lo(a.z) + bf_lo(bq.z); v[5] = bf_hi(a.z) + bf_hi(bq.z); v[6] = bf_lo(a.w) + bf_lo(bq.w); v[7] = bf_hi(a.w) + bf_hi(bq.w);
        float ss = 0.f;
#pragma unroll
        for (int i = 0; i < 8; ++i) ss += v[i] * v[i];
        ss += __shfl_xor(ss, 1); ss += __shfl_xor(ss, 2); ss += __shfl_xor(ss, 4); ss += __shfl_xor(ss, 8);
        const float rr = 1.f / sqrtf(ss * (1.f / 128.f) + EPS);
        u32x4 w;
        w.x = pkbf(v[0] * rr * g0[0] * silu_f(bf_lo(gt.x)), v[1] * rr * g0[1] * silu_f(bf_hi(gt.x))); w.y = pkbf(v[2] * rr * g0[2] * silu_f(bf_lo(gt.y)), v[3] * rr * g0[3] * silu_f(bf_hi(gt.y)));
        w.z = pkbf(v[4] * rr * g1[0] * silu_f(bf_lo(gt.z)), v[5] * rr * g1[1] * silu_f(bf_hi(gt.z))); w.w = pkbf(v[6] * rr * g1[2] * silu_f(bf_lo(gt.w)), v[7] * rr * g1[3] * silu_f(bf_hi(gt.w)));
        *(u32x4*)(MIX + (size_t)row * 1024 + 512 + 8 * lane) = w;
    }
}

#define RLX_AGENT __ATOMIC_RELAXED, __HIP_MEMORY_SCOPE_AGENT
#define XB_TMO      128
#define XB_XCNT(j)  (256  + 64 * (j))
#define XB_XSUB(j)  (1280 + 64 * (j))
#define XB_XGEN(j)  (2304 + 64 * (j))
#define XB_TOP      3328
#define XB_TOPGEN   3392
#define XCD_BAR_WORDS 3456
#define XB_SPIN_CAP (1u << 18)

__device__ __forceinline__ unsigned xb_ld(unsigned* p)              { return __hip_atomic_load(p, __ATOMIC_RELAXED, __HIP_MEMORY_SCOPE_AGENT); }
__device__ __forceinline__ unsigned xb_add(unsigned* p, unsigned v) { return __hip_atomic_fetch_add(p, v, __ATOMIC_RELAXED, __HIP_MEMORY_SCOPE_AGENT); }
__device__ __forceinline__ unsigned xb_xcc_id() { return (unsigned)__builtin_amdgcn_s_getreg((3 << 11) | 20) & 0xFu; }
#define XB_SPIN(cond, bar) do { unsigned _sp = 0; while (cond) { __builtin_amdgcn_s_sleep(1); \
    if ((++_sp & 255u) == 0u) { if (xb_ld(&(bar)[XB_TMO])) break; if (_sp > XB_SPIN_CAP) { atomicAdd(&(bar)[XB_TMO], 1u); break; } } } } while (0)

struct XcdBarrier {
    unsigned* bar; unsigned x;
    volatile LAS unsigned* st;
};

__device__ __forceinline__ XcdBarrier xcd_barrier_post(unsigned* bar, volatile LAS unsigned* st) {
    XcdBarrier b; b.bar = bar; b.x = xb_xcc_id(); b.st = st;
    if (threadIdx.x == 0) (void)xb_add(&bar[XB_XCNT(b.x)], 1u);
    return b;
}
__device__ __forceinline__ void xcd_barrier_complete(unsigned* bar, unsigned x, unsigned& nloc, unsigned& nx) {
    const unsigned G = gridDim.x * gridDim.y * gridDim.z;
    unsigned sum, cnt, mine, sp = 0u;
    for (;;) {
        sum = 0u; cnt = 0u; mine = 0u;
#pragma unroll
        for (unsigned j = 0; j < 16; ++j) { const unsigned c = xb_ld(&bar[XB_XCNT(j)]); sum += c; cnt += (c > 0u) ? 1u : 0u; mine = (j == x) ? c : mine; }
        if (sum == G) break;
        __builtin_amdgcn_s_sleep(1);
        if ((++sp & 255u) == 0u) { if (xb_ld(&bar[XB_TMO])) break; if (sp > XB_SPIN_CAP) { atomicAdd(&bar[XB_TMO], 1u); break; } }
    }
    nloc = mine > 0u ? mine : 1u; nx = cnt > 0u ? cnt : 1u;
}

__device__ __forceinline__ void xcd_barrier(const XcdBarrier& b) {
    asm volatile("s_waitcnt vmcnt(0)" ::: "memory");
    __syncthreads();
    if (threadIdx.x == 0) {
        unsigned* bar = b.bar;
        __builtin_amdgcn_s_waitcnt(0);
        unsigned nloc = b.st[0], nx = b.st[1];
        if (nloc == 0u) { xcd_barrier_complete(bar, b.x, nloc, nx); b.st[0] = nloc; b.st[1] = nx; }
        const unsigned old = xb_add(&bar[XB_XSUB(b.x)], 1u);
        const unsigned gen = old / nloc;
        if (old + 1u == (gen + 1u) * nloc) {
            __builtin_amdgcn_fence(__ATOMIC_RELEASE, "agent");
            asm volatile("s_waitcnt vmcnt(0)" ::: "memory");
            const unsigned og = xb_add(&bar[XB_TOP], 1u);
            const unsigned tg = og / nx;
            if (og + 1u == (tg + 1u) * nx) xb_add(&bar[XB_TOPGEN], 1u);
            else XB_SPIN(xb_ld(&bar[XB_TOPGEN]) == tg, bar);
            __builtin_amdgcn_fence(__ATOMIC_ACQUIRE, "agent");
            xb_add(&bar[XB_XGEN(b.x)], 1u);
            asm volatile("s_waitcnt vmcnt(0)" ::: "memory");
        } else {
            XB_SPIN(xb_ld(&bar[XB_XGEN(b.x)]) == gen, bar);
            __builtin_amdgcn_fence(__ATOMIC_ACQUIRE, "agent");
            asm volatile("s_waitcnt vmcnt(0)" ::: "memory");
        }
    }
    __syncthreads();
}


#ifndef NO_GEMM
#define RUN_GEMM(...) pg8::run_gemm(__VA_ARGS__)
#else
#define RUN_GEMM(...) do{}while(0)
#endif
#ifndef NO_ATT0
#define ATT0(...) attn_unit<0>(__VA_ARGS__)
#else
#define ATT0(...) do{}while(0)
#endif
#ifndef NO_ATT1
#define ATT1(...) attn_unit<1>(__VA_ARGS__)
#else
#define ATT1(...) do{}while(0)
#endif
#ifndef NO_GLA
#define GLA(...) gla_unit(__VA_ARGS__)
#else
#define GLA(...) do{}while(0)
#endif
#ifndef NO_EmPlain
#define RG_EmPlain(...) RUN_GEMM(__VA_ARGS__)
#else
#define RG_EmPlain(...) do{}while(0)
#endif
#ifndef NO_EmQ
#define RG_EmQ(...) RUN_GEMM(__VA_ARGS__)
#else
#define RG_EmQ(...) do{}while(0)
#endif
#ifndef NO_EmKV
#define RG_EmKV(...) RUN_GEMM(__VA_ARGS__)
#else
#define RG_EmKV(...) do{}while(0)
#endif
#ifndef NO_EmFFN
#define RG_EmFFN(...) RUN_GEMM(__VA_ARGS__)
#else
#define RG_EmFFN(...) do{}while(0)
#endif
#ifndef NO_EmQKV
#define RG_EmQKV(...) RUN_GEMM(__VA_ARGS__)
#else
#define RG_EmQKV(...) do{}while(0)
#endif
#ifndef PH_LO
#define PH_LO 0
#endif
#ifndef PH_HI
#define PH_HI 20
#endif
constexpr int LDS_BYTES = 147456;
__device__ __forceinline__ int next_item(unsigned* ctr, ldsp lds) {
    LAS int* slot = (LAS int*)(lds + 131072 + 64);
    __syncthreads();
    if (threadIdx.x == 0) *slot = (int)atomicAdd(ctr, 1u);
    __syncthreads();
    return *slot;
}
__global__ void __launch_bounds__(512, 2) fwd_megakernel(ParamsK Pkarg) {
    extern __shared__ __attribute__((aligned(16))) unsigned char lds_raw[];
    ldsp lds = (ldsp)lds_raw;
    cg::grid_group grid = cg::this_grid();
    XcdBarrier xbar;
    {
        volatile LAS unsigned* stw = (volatile LAS unsigned*)(lds + 131072 + 128);
        if (threadIdx.x < 2) stw[threadIdx.x] = 0u;
        __syncthreads();
#if defined(__HIP_DEVICE_COMPILE__)
        unsigned char* ws0 = *(unsigned char* const __attribute__((address_space(4)))*)((const __attribute__((address_space(4))) char*)__builtin_amdgcn_kernarg_segment_ptr() + 8 * 29);
#else
        unsigned char* ws0 = nullptr;
#endif
        xbar = xcd_barrier_post((unsigned*)(ws0 + WS_CTL) + 4096, stw);
    }
#pragma unroll 1
    for (int ph = PH_LO; ph < PH_HI; ++ph) {
        Params P;
#if defined(__HIP_DEVICE_COMPILE__)
        P.kp = (const __attribute__((address_space(4))) char*)__builtin_amdgcn_kernarg_segment_ptr(); asm volatile("" : "+s"(P.kp));
#else
        P.kp = nullptr;
#endif
        unsigned char* ws = P.wsp();
        unsigned* ctl = (unsigned*)(ws + WS_CTL);
        typedef pg8::bf16_t* bp; typedef const pg8::bf16_t* cbp;
        const float* rmc = (const float*)(ws + WS_RM_COS); const float* rms = (const float*)(ws + WS_RM_SIN); const float* rdc = (const float*)(ws + WS_RD_COS); const float* rds = (const float*)(ws + WS_RD_SIN);
#ifdef REPMASK
        const int nrep = 1 + ((REPMASK >> ph) & 1);
#else
        const int nrep = 1;
#endif
#pragma unroll 1
        for (int rep = 0; rep < nrep; ++rep) {
        if (rep) xcd_barrier(xbar);
        int kind = 0;
        cbp gA = nullptr, gB = nullptr; int gM = 0, gN = 0, gK = 0; bp gO = nullptr; int gldc = 0;
        bool rn_first = false, rn_doH = false; int rn_liA = 0, rn_gA = 0, rn_gate = 0, rn_liB = 0, rn_gB = 0, rn_sc = 0, rn_sh = 0;
        switch (ph) {
        case 0: phase0(P, lds); break;
        case 1: phase_norm0(P); break;
        case 2: kind = 1; gA = (cbp)(ws + A_H); gB = (cbp)(ws + W_IN); gM = MT; gN = PJ; gK = 1024; gO = (bp)(ws + B_PROJ); gldc = PJ; break;
        case 3: phase_mla_prep(P); break;
        case 4: RG_EmQ(lds, (cbp)(ws + A_QLN), (cbp)(ws + W_UQ), MT, 768, 384, pg8::EmQ{(bp)(ws + R_Q), rmc, rms});
                RG_EmKV(lds, (cbp)(ws + A_CKV), (cbp)(ws + W_UKV), KR, 1024, 256, pg8::EmKV{(bp)(ws + R_KN), (bp)(ws + R_VTM)}); break;
        case 5: break;
        case 6: {
            const int xcd = (int)(__builtin_amdgcn_s_getreg((3 << 11) | 20) & 7u);
            for (int qq = 0; qq < 8; ++qq) {
                const int x = (xcd + qq) & 7;
                for (;;) {
                    const int it = next_item(ctl + 64 * x + 1024 * rep, lds);
                    if (it >= 168) break;
                    if (it < 8) { const int u = x * 8 + it; GLA(lds, P, false, u >> 3, (u >> 1) & 3, u & 1); }
                    else if (it >= 136 && it < 152) { const int u = x * 16 + (it - 136); GLA(lds, P, true, u >> 3, (u >> 1) & 3, u & 1); }
                    else { AttnArgs<0> A; A.Q = (const bf16*)(ws + R_Q); A.K = (const bf16*)(ws + R_KN); A.K2 = (const bf16*)(ws + R_KROPE); A.MIX = (bf16*)(ws + A_MIX); A.lam = 0.f; A.gout = nullptr;
                        if (it < 136) { const int j = it - 8, pair = (j >> 4) * 8 + x, b = pair >> 3, h = pair & 7, qb = j & 15;
                            A.VTh = (const bf16*)(ws + R_VTM) + (size_t)16 * 512 * 256 + (size_t)b * 512 * 4608 + (size_t)h * 64 * 4608;
                            A.row0 = MP + b * 4096 + qb * 256; A.krow0 = MP + b * 4608; A.Lk = 4608; A.h = h; }
                        else { const int u = x * 16 + (it - 152), b = u >> 3, h = u & 7;
                            A.VTh = (const bf16*)(ws + R_VTM) + (size_t)b * 512 * 256 + (size_t)h * 64 * 256;
                            A.row0 = b * 256; A.krow0 = b * 256; A.Lk = 256; A.h = h; }
                        ATT0(lds, A); }
                }
            }
        } break;
        case 7: phase_gla_fin(P); break;
        case 8: kind = 1; gA = (cbp)(ws + A_MIX); gB = (cbp)(ws + W_ABO); gM = MT; gN = 1024; gK = 1024; gO = (bp)(ws + R_OUT); gldc = 1024; break;
        case 9: kind = 2; rn_first = true; rn_liA = 0; rn_gA = 1; rn_gate = 2; rn_doH = true; rn_liB = 0; rn_gB = 2; rn_sc = 4; rn_sh = 3; break;
        case 10: kind = 3; gA = (cbp)(ws + A_H); gB = (cbp)(ws + W_F1); gM = MT; gN = 5632; gK = 1024; gO = (bp)(ws + B_FFNH); break;
        case 11: kind = 1; gA = (cbp)(ws + B_FFNH); gB = (cbp)(ws + W_F2); gM = MT; gN = 1024; gK = 2816; gO = (bp)(ws + R_OUT); gldc = 1024; break;
        case 12: kind = 2; rn_liA = 0; rn_gA = 3; rn_gate = 5; rn_doH = true; rn_liB = 1; rn_gB = 0; rn_sc = 1; rn_sh = 0; phase_diff_ctx(P); break;
        case 13: RG_EmQKV(lds, (cbp)(ws + A_H), (cbp)(ws + W_QKV), MT, 3072, 1024, pg8::EmQKV{(bp)(ws + B_QD), (bp)(ws + B_KD), (bp)(ws + R_VTD), P.outp() + O_DK, P.outp() + O_DV, rdc, rds}); break;
        case 14: {
            const float lam = *(const float*)(ws + WS_LAM);
            const int xcd = (int)(__builtin_amdgcn_s_getreg((3 << 11) | 20) & 7u);
            for (int qq = 0; qq < 8; ++qq) {
                const int x = (xcd + qq) & 7;
                for (;;) {
                    const int it = next_item(ctl + 512 + 64 * x + 1024 * rep, lds);
                    if (it >= 288) break;
                    AttnArgs<1> A; A.Q = (const bf16*)(ws + B_QD); A.K = (const bf16*)(ws + B_KD); A.K2 = nullptr; A.MIX = (bf16*)(ws + A_MIX); A.lam = lam; A.gout = P.inp(I_DGOUT);
                    if (it < 256) { const int pair = (it >> 5) * 8 + x, b = pair >> 3, h = pair & 7, qb = it & 31;
                        A.VTh = (const bf16*)(ws + R_VTD) + (size_t)16 * 1024 * 256 + (size_t)b * 1024 * 4608 + (size_t)h * 128 * 4608;
                        A.row0 = MP + b * 4096 + qb * 128; A.krow0 = MP + b * 4608; A.Lk = 4608; A.h = h; }
                    else { const int u = x * 32 + (it - 256), b = u >> 4, h = (u >> 1) & 7, qb = u & 1;
                        A.VTh = (const bf16*)(ws + R_VTD) + (size_t)b * 1024 * 256 + (size_t)h * 128 * 256;
                        A.row0 = b * 256 + qb * 128; A.krow0 = b * 256; A.Lk = 256; A.h = h; }
#ifdef UNIT_REP
                    ATT1(lds, A);
#endif
                    ATT1(lds, A);
                }
            }
        } break;
        case 15: kind = 1; gA = (cbp)(ws + A_MIX); gB = (cbp)(ws + W_CO); gM = MT; gN = 1024; gK = 1024; gO = (bp)(ws + R_OUT); gldc = 1024; break;
        case 16: kind = 2; rn_liA = 1; rn_gA = 1; rn_gate = 2; rn_doH = true; rn_liB = 1; rn_gB = 2; rn_sc = 4; rn_sh = 3; break;
        case 17: kind = 3; gA = (cbp)(ws + A_H); gB = (cbp)(ws + W_F1 + 11 * MiB); gM = MT; gN = 5632; gK = 1024; gO = (bp)(ws + B_FFNH); break;
        case 18: kind = 1; gA = (cbp)(ws + B_FFNH); gB = (cbp)(ws + W_F2 + (size_t)2816 * 1024 * 2); gM = MT; gN = 1024; gK = 2816; gO = (bp)(ws + R_OUT); gldc = 1024; break;
        default: kind = 2; rn_liA = 1; rn_gA = 3; rn_gate = 5; rn_doH = false; break;
        }
        if (kind == 1) RG_EmPlain(lds, gA, gB, gM, gN, gK, pg8::EmPlain{gO, gldc});
        else if (kind == 3) RG_EmFFN(lds, gA, gB, gM, gN, gK, pg8::EmFFN{gO});
        else if (kind == 2) phase_resnorm(P, rn_first, rn_liA, rn_gA, rn_gate, rn_doH, rn_liB, rn_gB, rn_sc, rn_sh);
        }
        if (ph + 1 < PH_HI && ph != 4) { if (ph == 0) grid.sync(); else xcd_barrier(xbar); }
#ifdef EXTRA_SYNCS
        if (ph == 1) { for (int es = 0; es < EXTRA_SYNCS; ++es) xcd_barrier(xbar); }
#endif
    }
}

extern "C" void kernel_launch(void* const* d_in, const int* in_sizes, int n_in, void* d_out, int out_size, void* d_ws, size_t ws_size, hipStream_t stream) {
    static int grid = 0;
    if (grid == 0) {
        if (n_in != 28 || ws_size < WS_END) { fprintf(stderr, "kernel_launch: unexpected n_in %d / ws_size %zu (need %zu)\n", n_in, ws_size, (size_t)WS_END); grid = -1; return; }
        int dev = 0, cus = 0, per_cu = 0;
        hipGetDevice(&dev); hipDeviceGetAttribute(&cus, hipDeviceAttributeMultiprocessorCount, dev);
        if (hipFuncSetAttribute((const void*)fwd_megakernel, hipFuncAttributeMaxDynamicSharedMemorySize, LDS_BYTES) != hipSuccess) { fprintf(stderr, "kernel_launch: hipFuncSetAttribute failed\n"); grid = -1; return; }
        if (hipOccupancyMaxActiveBlocksPerMultiprocessor(&per_cu, (const void*)fwd_megakernel, 512, LDS_BYTES) != hipSuccess || per_cu < 1) { fprintf(stderr, "kernel_launch: occupancy query says %d\n", per_cu); per_cu = 1; }
        (void)hipGetLastError();
        grid = cus * 1;
    }
    if (grid < 0) return;
    hipMemsetAsync((char*)d_ws + WS_CTL, 0, 32768, stream);
    ParamsK p{};
    for (int i = 0; i < 28; ++i) p.in[i] = (const float*)d_in[i];
    p.out = (float*)d_out; p.ws = (unsigned char*)d_ws;
    void* args[] = {&p};
    hipError_t e = hipLaunchCooperativeKernel((const void*)fwd_megakernel, dim3(grid), dim3(512), args, LDS_BYTES, stream);
    if (e != hipSuccess) fprintf(stderr, "cooperative launch failed: %s (grid %d)\n", hipGetErrorString(e), grid);
}
```

```cpp
#include <hip/hip_runtime.h>
#include <hip/hip_cooperative_groups.h>
#include <cstdio>
#include <cstdint>
namespace cg = cooperative_groups;
__device__ __forceinline__ int tid_opaque() { int t = threadIdx.x; asm volatile("" : "+v"(t)); return t; }
namespace pg8 {
#define PG8_LAS __attribute__((address_space(3)))
typedef unsigned short bf16_t;
typedef short bf16x8 __attribute__((ext_vector_type(8)));
typedef float f32x4 __attribute__((ext_vector_type(4)));
typedef unsigned u32x4 __attribute__((ext_vector_type(4)));
constexpr int BM = 256, BK = 64, HALF = 128, HTB = HALF * BK * 2  , STAGE_BYTES = 8 * HTB, NXCD = 8, WGM = 8;

__host__ __device__ __forceinline__ int lds_byte(int r, int c) { const int st = (r >> 4) * 2 + (c >> 5), rr = r & 15, cc = c & 31, ob = rr * 64 + cc * 2; return st * 1024 + (ob ^ (((ob >> 9) & 1) << 5)); }
__host__ __device__ __forceinline__ void stage_rc(int b, int& R, int& C) { const int st = b / 1024, sb = b % 1024, swz = sb ^ (((sb >> 9) & 1) << 5); R = (st >> 1) * 16 + swz / 64; C = (st & 1) * 32 + (swz % 64) / 2; }
__host__ __device__ __forceinline__ int perm32(int rho) { const int n = rho >> 4, i = rho & 15; return 8 * (i >> 2) + 4 * n + (i & 3); }

struct Unit { int pm, pn; };
struct Gemm { const bf16_t* A; const bf16_t* Bt; int M, N, K; };

struct StaticOrder {
    int nM, nN, nwg, G, c;
    __host__ __device__ void init(int M, int N, int G_, int c_) { nM = M / BM; nN = N / BM; nwg = nM * nN; G = G_; c = c_; }
    __host__ __device__ bool next(int i, Unit& u) const {
        const long L = (long)i * G + c; if (L >= nwg) return false;
        int wgid = (int)L; { const int q = nwg / NXCD, r = nwg % NXCD, xcd = wgid % NXCD, off = wgid / NXCD; wgid = (xcd < r ? xcd * (q + 1) : r * (q + 1) + (xcd - r) * q) + off; }
        const int nig = WGM * nN, gid = wgid / nig, fm = gid * WGM, gsz = (nM - fm) < WGM ? (nM - fm) : WGM;
        u.pm = fm + ((wgid % nig) % gsz); u.pn = (wgid % nig) / gsz; return true;
    }
    __device__ __forceinline__ void a_ready(const Unit&) const {}
    __device__ __forceinline__ void done(const Unit&) const {}
};

__device__ __forceinline__ unsigned cvt_pk_bf16(float lo, float hi) { unsigned r; asm volatile("v_cvt_pk_bf16_f32 %0, %1, %2" : "=v"(r) : "v"(lo), "v"(hi)); return r; }
typedef float f32x2 __attribute__((ext_vector_type(2)));
template <class Epi, class Sched, bool ALIGN_EPI = false, bool SP2 = false>
__device__ __forceinline__ void gemm_phase(PG8_LAS unsigned char* lds, const Gemm g, const Sched& S, const Epi& E) {
    const int tid = tid_opaque(), wid = __builtin_amdgcn_readfirstlane(tid >> 6), lane = tid & 63, wr = wid >> 2, wc = wid & 3, fr = lane & 15, fq = lane >> 4;
    const int K = g.K, nt = K / BK;
    unsigned voffA[2], voffB[2];
#pragma unroll
    for (int i = 0; i < 2; ++i) { int R, C; stage_rc(tid * 16 + i * 8192, R, C); const int Rb = Epi::PERM ? ((R & ~31) + perm32(R & 31)) : R;
        voffA[i] = (unsigned)(R * K + C) * 2u; voffB[i] = (unsigned)(Rb * K + C) * 2u; }
    const size_t kstep = (size_t)(BK * 2);
    const size_t hstep = (size_t)HALF * K * 2;
    const size_t tstep = 2 * hstep;
    const unsigned ldsw = (unsigned)wid * 1024u;
    const int aoff = lds_byte(wr * 64 + fr, fq * 8), boff = lds_byte(wc * 32 + fr, fq * 8);
#define PG8_SA(b, h) (((b) * 2 + (h)) * HTB)
#define PG8_SB(b, h) ((4 + (b) * 2 + (h)) * HTB)
#define PG8_STAGE(bufoff, gbase, voff) do { _Pragma("unroll") for (int _i = 0; _i < 2; ++_i) \
        __builtin_amdgcn_global_load_lds((const unsigned*)((const char*)(gbase) + (voff)[_i]), (PG8_LAS unsigned*)(lds + (bufoff) + ldsw + _i * 8192), 16, 0, 0); } while (0)
#define PG8_LDA(dst, b, h) do { _Pragma("unroll") for (int m = 0; m < 4; ++m) _Pragma("unroll") for (int k = 0; k < 2; ++k) dst[m][k] = *(const PG8_LAS bf16x8*)(lds + PG8_SA(b, h) + aoff + m * 2048 + k * 1024); } while (0)
#define PG8_LDB(dst, b, h) do { _Pragma("unroll") for (int n = 0; n < 2; ++n) _Pragma("unroll") for (int k = 0; k < 2; ++k) dst[n][k] = *(const PG8_LAS bf16x8*)(lds + PG8_SB(b, h) + boff + n * 2048 + k * 1024); } while (0)
#define PG8_MMA(ai, bj, At, Bt) do { __builtin_amdgcn_s_setprio(1); _Pragma("unroll") for (int m = 0; m < 4; ++m) _Pragma("unroll") for (int n = 0; n < 2; ++n) _Pragma("unroll") for (int k = 0; k < 2; ++k) \
        acc[ai][bj][m][n] = __builtin_amdgcn_mfma_f32_16x16x32_bf16(Bt[n][k], At[m][k], acc[ai][bj][m][n], 0, 0, 0); __builtin_amdgcn_s_setprio(0); } while (0)
#define PG8_WAIT_V(n) asm volatile("s_waitcnt vmcnt(" #n ")" ::: "memory")
#define PG8_WAIT_L(n) asm volatile("s_waitcnt lgkmcnt(" #n ")" ::: "memory")
#define PG8_BAR __builtin_amdgcn_s_barrier()
#define PG8_SCHED __builtin_amdgcn_sched_barrier(0)
    Unit cur, nxt; int ui = 0;
    if (!S.next(0, cur)) return;
    f32x4 acc[2][2][4][2];
#pragma unroll
    for (int a = 0; a < 2; ++a)
#pragma unroll
        for (int b = 0; b < 2; ++b)
#pragma unroll
            for (int m = 0; m < 4; ++m)
#pragma unroll
                for (int n = 0; n < 2; ++n) acc[a][b][m][n] = (f32x4){0.f, 0.f, 0.f, 0.f};
    bf16x8 At[4][2], B0[2][2], B1[2][2];
    const char* cA = (const char*)g.A + (size_t)cur.pm * tstep; const char* cB = (const char*)g.Bt + (size_t)cur.pn * tstep;
    S.a_ready(cur);
    if constexpr (SP2) {
        PG8_STAGE(PG8_SB(0, 0), cB, voffB); PG8_STAGE(PG8_SB(0, 1), cB + hstep, voffB); PG8_STAGE(PG8_SA(0, 0), cA, voffA); PG8_STAGE(PG8_SA(0, 1), cA + hstep, voffA);
        if (wr == 1) PG8_BAR;
        PG8_WAIT_V(2); PG8_BAR;
        PG8_STAGE(PG8_SB(1, 0), cB + kstep, voffB); PG8_STAGE(PG8_SA(1, 0), cA + kstep, voffA); PG8_STAGE(PG8_SB(1, 1), cB + hstep + kstep, voffB);
        PG8_WAIT_V(6); PG8_BAR;
    } else {
        PG8_STAGE(PG8_SB(0, 0), cB, voffB); PG8_STAGE(PG8_SA(0, 0), cA, voffA); PG8_STAGE(PG8_SB(0, 1), cB + hstep, voffB); PG8_STAGE(PG8_SA(0, 1), cA + hstep, voffA);
        if (wr == 1) PG8_BAR;
        PG8_WAIT_V(4); PG8_BAR;
        PG8_STAGE(PG8_SB(1, 0), cB + kstep, voffB); PG8_STAGE(PG8_SA(1, 0), cA + kstep, voffA); PG8_STAGE(PG8_SB(1, 1), cB + hstep + kstep, voffB);
        PG8_WAIT_V(6); PG8_BAR;
    }
    for (;;) {
        const bool has_next = S.next(ui + 1, nxt);
        const char* nA = has_next ? (const char*)g.A + (size_t)nxt.pm * tstep : cA; const char* nB = has_next ? (const char*)g.Bt + (size_t)nxt.pn * tstep : cB;
        for (int t = 0; t < nt; t += 2) {
            const bool last = (t == nt - 2);
            const char* a1 = cA + (size_t)(t + 1) * kstep;
            const char* a2 = last ? nA : cA + (size_t)(t + 2) * kstep; const char* b2 = last ? nB : cB + (size_t)(t + 2) * kstep;
            const char* a3 = a2 + kstep; const char* b3 = b2 + kstep;
            if (last && has_next) S.a_ready(nxt);
            if constexpr (SP2) {
            PG8_LDB(B0, 0, 0); PG8_LDB(B1, 0, 1); PG8_SCHED; PG8_LDA(At, 0, 0); PG8_STAGE(PG8_SA(1, 1), a1 + hstep, voffA);
            PG8_WAIT_V(8); PG8_WAIT_L(0); PG8_BAR; PG8_MMA(0, 0, At, B0); PG8_MMA(0, 1, At, B1); PG8_BAR; PG8_SCHED;
            PG8_LDA(At, 0, 1); PG8_STAGE(PG8_SB(0, 0), b2, voffB); PG8_STAGE(PG8_SB(0, 1), b2 + hstep, voffB); PG8_STAGE(PG8_SA(0, 0), a2, voffA);
            PG8_WAIT_V(8); PG8_WAIT_L(0); PG8_BAR; PG8_MMA(1, 0, At, B0); PG8_MMA(1, 1, At, B1); PG8_BAR; PG8_SCHED;
            PG8_LDB(B0, 1, 0); PG8_LDB(B1, 1, 1); PG8_SCHED; PG8_LDA(At, 1, 0); PG8_STAGE(PG8_SA(0, 1), a2 + hstep, voffA);
            PG8_WAIT_V(8); PG8_WAIT_L(0); PG8_BAR; PG8_MMA(0, 0, At, B0); PG8_MMA(0, 1, At, B1); PG8_BAR; PG8_SCHED;
            PG8_LDA(At, 1, 1); PG8_STAGE(PG8_SB(1, 0), b3, voffB); PG8_STAGE(PG8_SB(1, 1), b3 + hstep, voffB); PG8_STAGE(PG8_SA(1, 0), a3, voffA);
            PG8_WAIT_V(8); PG8_WAIT_L(0); PG8_BAR; PG8_MMA(1, 0, At, B0); PG8_MMA(1, 1, At, B1); PG8_BAR; PG8_SCHED;
            } else {
            PG8_LDB(B0, 0, 0); PG8_SCHED; PG8_LDA(At, 0, 0); PG8_STAGE(PG8_SA(1, 1), a1 + hstep, voffA);
            PG8_WAIT_L(8); PG8_BAR; PG8_WAIT_L(0); PG8_MMA(0, 0, At, B0); PG8_BAR; PG8_SCHED;
            PG8_LDB(B1, 0, 1); PG8_STAGE(PG8_SB(0, 0), b2, voffB);
            PG8_BAR; PG8_WAIT_L(0); PG8_MMA(0, 1, At, B1); PG8_BAR;
            PG8_LDA(At, 0, 1); PG8_STAGE(PG8_SA(0, 0), a2, voffA);
            PG8_BAR; PG8_WAIT_L(0); PG8_MMA(1, 0, At, B0); PG8_BAR; PG8_SCHED;
            PG8_STAGE(PG8_SB(0, 1), b2 + hstep, voffB);
            PG8_WAIT_V(6); PG8_BAR; PG8_MMA(1, 1, At, B1); PG8_BAR;
            PG8_LDB(B0, 1, 0); PG8_SCHED; PG8_LDA(At, 1, 0); PG8_STAGE(PG8_SA(0, 1), a2 + hstep, voffA);
            PG8_WAIT_L(8); PG8_BAR; PG8_WAIT_L(0); PG8_MMA(0, 0, At, B0); PG8_BAR; PG8_SCHED;
            PG8_LDB(B1, 1, 1); PG8_STAGE(PG8_SB(1, 0), b3, voffB);
            PG8_BAR; PG8_WAIT_L(0); PG8_MMA(0, 1, At, B1); PG8_BAR;
            PG8_LDA(At, 1, 1); PG8_STAGE(PG8_SA(1, 0), a3, voffA);
            PG8_BAR; PG8_WAIT_L(0); PG8_MMA(1, 0, At, B0); PG8_BAR; PG8_SCHED;
            PG8_STAGE(PG8_SB(1, 1), b3 + hstep, voffB);
            PG8_WAIT_V(6); PG8_BAR; PG8_MMA(1, 1, At, B1); PG8_BAR;
            }
        }
        if constexpr (ALIGN_EPI) { if (wr == 0) PG8_BAR; }
        if constexpr (!Epi::AFTER_DRAIN) { E(acc, cur, wr, wc, fr, fq); S.done(cur); }
        if (!has_next) break;
#pragma unroll
        for (int a = 0; a < 2; ++a)
#pragma unroll
            for (int b = 0; b < 2; ++b)
#pragma unroll
                for (int m = 0; m < 4; ++m)
#pragma unroll
                    for (int n = 0; n < 2; ++n) acc[a][b][m][n] = (f32x4){0.f, 0.f, 0.f, 0.f};
        cur = nxt; cA = nA; cB = nB; ++ui;
        if constexpr (ALIGN_EPI) { if (wr == 1) PG8_BAR; }
    }
    PG8_WAIT_V(0);
    if constexpr (!ALIGN_EPI) { if (wr == 0) PG8_BAR; }
    PG8_BAR;
    if constexpr (Epi::AFTER_DRAIN) { E.fused(acc, cur, wr, wc, fr, fq, lds, wid, lane); S.done(cur); }
#undef PG8_SA
#undef PG8_SB
#undef PG8_STAGE
#undef PG8_LDA
#undef PG8_LDB
#undef PG8_MMA
#undef PG8_WAIT_V
#undef PG8_WAIT_L
#undef PG8_BAR
#undef PG8_SCHED
}
}

#define LAS __attribute__((address_space(3)))
typedef LAS unsigned char* ldsp;
typedef unsigned short bf16;
typedef float f32x4 __attribute__((ext_vector_type(4)));
typedef float f32x2 __attribute__((ext_vector_type(2)));
typedef float f32x16 __attribute__((ext_vector_type(16)));
typedef short bf16x8 __attribute__((ext_vector_type(8)));
typedef short s16x4 __attribute__((ext_vector_type(4)));
typedef unsigned u32x4 __attribute__((ext_vector_type(4)));
typedef unsigned u32x2 __attribute__((ext_vector_type(2)));

constexpr int DM = 1024, MP = 4096, MS = 32768, MT = MP + MS, KR = 4096 + 8 * 4608;
constexpr int FFH = 2816, PJ = 2816;
constexpr float EPS = 1e-6f;
constexpr float LAM_INIT = 0.35550907f;
constexpr int C_QLAT = 0, C_KVLAT = 384, C_KROPE = 640, C_GQ = 672, C_GK = 1184, C_GV = 1696, C_GGATE = 2208, C_GOUT = 2240;

constexpr size_t MiB = 1u << 20;
constexpr size_t WS_CTL = 0, WS_MOD = 1 * MiB, WS_ROPE = 2 * MiB, WS_W = 4 * MiB;
constexpr size_t WS_RM_COS = WS_ROPE, WS_RM_SIN = WS_ROPE + 256 * 1024, WS_RD_COS = WS_ROPE + 512 * 1024, WS_RD_SIN = WS_ROPE + 1024 * 1024, WS_LAM = WS_ROPE + 1536 * 1024;
constexpr size_t W_IN = WS_W, W_UQ = W_IN + (size_t)2816 * 1024 * 2, W_UKV = W_UQ + (size_t)768 * 384 * 2, W_ABO = W_UKV + (size_t)1024 * 256 * 2,
                 W_QKV = W_ABO + 2 * MiB, W_CO = W_QKV + 6 * MiB, W_F1 = W_CO + 2 * MiB, W_F2 = W_F1 + 22 * MiB, W_END = W_F2 + 11 * MiB;
constexpr size_t WS_A = 54 * MiB, WS_B = 126 * MiB, WS_C = 324 * MiB, WS_END = 476 * MiB;
static_assert(W_END <= WS_A, "weights fit");
constexpr size_t A_H = WS_A, A_MIX = WS_A, A_QLN = WS_A, A_CKV = WS_A + 28 * MiB;
constexpr size_t B_PROJ = WS_B, B_FFNH = WS_B, B_QD = WS_B, B_KD = WS_B + 72 * MiB;
constexpr size_t R_OUT = WS_C, R_Q = WS_C, R_KN = WS_C + 54 * MiB, R_KROPE = WS_C + 94 * MiB, R_VTM = WS_C + 97 * MiB, R_VTD = WS_C + 72 * MiB;

struct ParamsK {
    const float* in[28];
    float* out;
    unsigned char* ws;
};
struct Params {
    const __attribute__((address_space(4))) char* kp;
    __device__ __forceinline__ const float* inp(int i) const {
#if defined(__HIP_DEVICE_COMPILE__)
        return *(const float* const __attribute__((address_space(4)))*)(kp + 8 * i);
#else
        return nullptr;
#endif
    }
    __device__ __forceinline__ float* outp() const {
#if defined(__HIP_DEVICE_COMPILE__)
        return *(float* const __attribute__((address_space(4)))*)(kp + 8 * 28);
#else
        return nullptr;
#endif
    }
    __device__ __forceinline__ unsigned char* wsp() const {
#if defined(__HIP_DEVICE_COMPILE__)
        return *(unsigned char* const __attribute__((address_space(4)))*)(kp + 8 * 29);
#else
        return nullptr;
#endif
    }
};
enum { I_XP = 0, I_XS, I_CKV, I_CKROPE, I_SF, I_SB, I_CDK, I_CDV, I_C, I_CCTX, I_WMOD, I_BMOD, I_GNORM, I_ABWIN, I_GQ, I_GKV, I_WUQ, I_WUKV, I_WGATE, I_BGATE, I_GGOUT, I_ABWOUT,
       I_CWQKV, I_DLAM, I_DGOUT, I_CWOUT, I_WF1, I_WF2 };
constexpr size_t O_Y = 0, O_CKV = (size_t)MT * 1024, O_KROPE = O_CKV + (size_t)4096 * 256, O_GF = O_KROPE + (size_t)4096 * 32, O_GB = O_GF + (size_t)16 * 4 * 128 * 128,
                 O_DK = O_GB + (size_t)16 * 4 * 128 * 128, O_DV = O_DK + (size_t)4096 * 1024;

typedef float f32x2_cv __attribute__((ext_vector_type(2))); typedef __bf16 bf16x2_cv __attribute__((ext_vector_type(2)));
__device__ __forceinline__ unsigned pkbf(float lo, float hi) { f32x2_cv v = {lo, hi}; bf16x2_cv b = __builtin_convertvector(v, bf16x2_cv); return __builtin_bit_cast(unsigned, b); }
__device__ __forceinline__ float bf_lo(unsigned w) { return __uint_as_float(w << 16); }
__device__ __forceinline__ float bf_hi(unsigned w) { return __uint_as_float(w & 0xffff0000u); }
__device__ __forceinline__ float bf1(bf16 v) { return __uint_as_float((unsigned)v << 16); }
__device__ __forceinline__ bf16 tobf(float f) { return (bf16)(pkbf(f, 0.f) & 0xffffu); }
__device__ __forceinline__ float wave_sum(float v) {
#pragma unroll
    for (int o = 1; o < 64; o <<= 1) v += __shfl_xor(v, o);
    return v;
}
__device__ __forceinline__ float fast_exp2(float x) { return __builtin_amdgcn_exp2f(x); }
__device__ __forceinline__ float fast_rcp(float x) { return __builtin_amdgcn_rcpf(x); }
__device__ __forceinline__ float silu_f(float g) { return g * fast_rcp(1.f + fast_exp2(-1.4426950408889634f * g)); }
__device__ __forceinline__ int key_row(int row) { if (row < MP) return row; const int r = row - MP; return MP + (r >> 12) * 4608 + 512 + (r & 4095); }
__device__ __forceinline__ void vt_pos(int krow, int HD, size_t& base, int& pos, int& Lk) {
    if (krow < MP) { const int kb = krow >> 8; pos = krow & 255; Lk = 256; base = (size_t)kb * HD * 256; }
    else { const int r = krow - MP, b = r / 4608; pos = r - b * 4608; Lk = 4608; base = (size_t)16 * HD * 256 + (size_t)b * HD * 4608; }
}
__device__ __forceinline__ const float* xrow_in(const Params& P, int row) { return row < MP ? P.inp(I_XP) + (size_t)row * DM : P.inp(I_XS) + (size_t)(row - MP) * DM; }
__device__ __forceinline__ int cond_of(int row) { return row < MP ? 0 : 1 + ((row - MP) >> 12); }

namespace pg8 {
template <class F> struct Epi8 {
    static constexpr bool PERM = true, AFTER_DRAIN = false; F f;
    __device__ __forceinline__ void operator()(const f32x4 (&acc)[2][2][4][2], const Unit& u, int wr, int wc, int fr, int fq) const {
        const int row0 = u.pm * BM + wr * 64 + fr, col0 = u.pn * BM + wc * 32 + 8 * fq;
#pragma unroll
        for (int ai = 0; ai < 2; ++ai)
#pragma unroll
            for (int m = 0; m < 4; ++m)
#pragma unroll
                for (int bj = 0; bj < 2; ++bj) { f(row0 + ai * HALF + m * 16, col0 + bj * HALF, acc[ai][bj][m][0], acc[ai][bj][m][1]); asm volatile("" ::: "memory"); }
    }
};
__device__ __forceinline__ ::u32x4 pack8(::f32x4 v0, ::f32x4 v1) { ::u32x4 w; w.x = pkbf(v0[0], v0[1]); w.y = pkbf(v0[2], v0[3]); w.z = pkbf(v1[0], v1[1]); w.w = pkbf(v1[2], v1[3]); return w; }
__device__ __forceinline__ void rot8(::f32x4& v0, ::f32x4& v1, const float* cs, const float* sn) {
    const ::f32x4 c = *(const ::f32x4*)cs, s = *(const ::f32x4*)sn;
    ::f32x4 a, b;
    a[0] = v0[0] * c[0] - v0[1] * s[0]; a[1] = v0[0] * s[0] + v0[1] * c[0];
    a[2] = v0[2] * c[1] - v0[3] * s[1]; a[3] = v0[2] * s[1] + v0[3] * c[1];
    b[0] = v1[0] * c[2] - v1[1] * s[2]; b[1] = v1[0] * s[2] + v1[1] * c[2];
    b[2] = v1[2] * c[3] - v1[3] * s[3]; b[3] = v1[2] * s[3] + v1[3] * c[3];
    v0 = a; v1 = b;
}
struct EmPlain { bf16_t* O; int ldc;
    __device__ __forceinline__ void operator()(int row, int col, ::f32x4 v0, ::f32x4 v1) const { *(::u32x4*)(O + (size_t)row * ldc + col) = pack8(v0, v1); } };
struct EmQ { bf16_t* Q; const float* rc; const float* rs;
    __device__ __forceinline__ void operator()(int row, int col, ::f32x4 v0, ::f32x4 v1) const {
        const int o = col % 96;
        if (o >= 64 && row >= MP) { const int t = (row - MP) & 4095, p0 = (o - 64) >> 1; rot8(v0, v1, rc + t * 16 + p0, rs + t * 16 + p0); }
        *(::u32x4*)(Q + (size_t)row * 768 + col) = pack8(v0, v1); } };
struct EmKV { bf16_t* KN; bf16_t* VT;
    __device__ __forceinline__ void operator()(int row, int col, ::f32x4 v0, ::f32x4 v1) const {
        const int h = col >> 7, o = col & 127;
        if (o < 64) { *(::u32x4*)(KN + (size_t)row * 512 + h * 64 + o) = pack8(v0, v1); }
        else { size_t base; int pos, Lk; vt_pos(row, 512, base, pos, Lk); bf16_t* p = VT + base + (size_t)(h * 64 + o - 64) * Lk + pos;
            const ::u32x4 w = pack8(v0, v1);
            p[0] = (bf16_t)(w.x & 0xffff); p[(size_t)Lk] = (bf16_t)(w.x >> 16); p[(size_t)2 * Lk] = (bf16_t)(w.y & 0xffff); p[(size_t)3 * Lk] = (bf16_t)(w.y >> 16);
            p[(size_t)4 * Lk] = (bf16_t)(w.z & 0xffff); p[(size_t)5 * Lk] = (bf16_t)(w.z >> 16); p[(size_t)6 * Lk] = (bf16_t)(w.w & 0xffff); p[(size_t)7 * Lk] = (bf16_t)(w.w >> 16); } } };
struct EmFFN { bf16_t* O;
    __device__ __forceinline__ void operator()(int row, int col, ::f32x4 v0, ::f32x4 v1) const {
        ::u32x2 w; w.x = pkbf(silu_f(v0[0]) * v1[0], silu_f(v0[1]) * v1[1]); w.y = pkbf(silu_f(v0[2]) * v1[2], silu_f(v0[3]) * v1[3]);
        *(::u32x2*)(O + (size_t)row * FFH + (col >> 1)) = w; } };
struct EmQKV { bf16_t* QD; bf16_t* KD; bf16_t* VT; float* odk; float* odv; const float* rc; const float* rs;
    __device__ __forceinline__ void operator()(int row, int col, ::f32x4 v0, ::f32x4 v1) const {
        if (col < 2048) {
            const int cc = col & 1023;
            if (col >= 1024 && row < MP) { float* o = odk + (size_t)row * 1024 + cc; *(::f32x4*)o = v0; *(::f32x4*)(o + 4) = v1; }
            if (row >= MP) { const int t = (row - MP) & 4095, p0 = (cc & 63) >> 1; rot8(v0, v1, rc + t * 32 + p0, rs + t * 32 + p0); }
            if (col < 1024) *(::u32x4*)(QD + (size_t)row * 1024 + cc) = pack8(v0, v1);
            else *(::u32x4*)(KD + (size_t)key_row(row) * 1024 + cc) = pack8(v0, v1);
        } else {
            const int cc = col - 2048;
            if (row < MP) { float* o = odv + (size_t)row * 1024 + cc; *(::f32x4*)o = v0; *(::f32x4*)(o + 4) = v1; }
            size_t base; int pos, Lk; vt_pos(key_row(row), 1024, base, pos, Lk); bf16_t* p = VT + base + (size_t)cc * Lk + pos;
            const ::u32x4 w = pack8(v0, v1);
            p[0] = (bf16_t)(w.x & 0xffff); p[(size_t)Lk] = (bf16_t)(w.x >> 16); p[(size_t)2 * Lk] = (bf16_t)(w.y & 0xffff); p[(size_t)3 * Lk] = (bf16_t)(w.y >> 16);
            p[(size_t)4 * Lk] = (bf16_t)(w.z & 0xffff); p[(size_t)5 * Lk] = (bf16_t)(w.z >> 16); p[(size_t)6 * Lk] = (bf16_t)(w.w & 0xffff); p[(size_t)7 * Lk] = (bf16_t)(w.w >> 16);
        } } };
template <class F> __device__ __forceinline__ void run_gemm(PG8_LAS unsigned char* lds, const bf16_t* A, const bf16_t* Bt, int M, int N, int K, const F& f) {
    asm volatile("" : "+s"(M), "+s"(N), "+s"(K));
    Gemm g{A, Bt, M, N, K}; StaticOrder S; S.init(M, N, (int)gridDim.x, (int)blockIdx.x);
    Epi8<F> E{f};
    gemm_phase<Epi8<F>, StaticOrder, true, true>(lds, g, S, E);
}
}

template <int MAPMODE> __device__ __forceinline__ int wrow_map(int n) {
    if (MAPMODE == 1) { return n < FFH ? 8 * (n >> 2) + (n & 3) : 8 * ((n - FFH) >> 2) + 4 + ((n - FFH) & 3); }
    return n;
}
template <int MAPMODE> __device__ __forceinline__ void transpose_item(const float* W, int K, int N, bf16* WT, LAS float* scr, int item, int lane) {
    const int nblk = N / 32, kb = item / nblk, nb = item % nblk, k0 = 64 * kb, n0 = 32 * nb;
#pragma unroll 8
    for (int i = 0; i < 32; ++i) { const int kk = 2 * i + (lane >> 5); scr[kk * 33 + (lane & 31)] = W[(size_t)(k0 + kk) * N + n0 + (lane & 31)]; }
    asm volatile("s_waitcnt lgkmcnt(0)" ::: "memory");
    const int c = lane & 7;
#pragma unroll
    for (int j = 0; j < 4; ++j) { const int n = (lane >> 3) + 8 * j; const LAS float* s = scr + (8 * c) * 33 + n;
        u32x4 o; o.x = pkbf(s[0 * 33], s[1 * 33]); o.y = pkbf(s[2 * 33], s[3 * 33]); o.z = pkbf(s[4 * 33], s[5 * 33]); o.w = pkbf(s[6 * 33], s[7 * 33]);
        *(u32x4*)(WT + (size_t)wrow_map<MAPMODE>(n0 + n) * K + k0 + 8 * c) = o; }
    asm volatile("s_waitcnt lgkmcnt(0)" ::: "memory");
}

__device__ __forceinline__ void phase0(const Params& P, ldsp lds) {
    const int tid = tid_opaque(), lane = tid & 63, wave = tid >> 6, G = gridDim.x, bid = blockIdx.x;
    unsigned char* ws = P.wsp();
    {
        LAS float* sc = (LAS float*)lds;
        LAS float* red = (LAS float*)(lds + 9 * 1024 * 4);
        for (int e = tid; e < 9 * 1024; e += 512) { const int ci = e >> 10, k = e & 1023; const float v = ci == 0 ? P.inp(I_CCTX)[k] : P.inp(I_C)[(ci - 1) * 1024 + k]; sc[e] = silu_f(v); }
        __syncthreads();
        float* MOD = (float*)(ws + WS_MOD);
        for (int item = bid; item < 192; item += G) {
            const int li = item / 96, j0 = (item % 96) * 64;
            const float* wm = P.inp(I_WMOD) + (size_t)li * 1024 * 6144 + j0 + lane;
            float acc[9];
#pragma unroll
            for (int c = 0; c < 9; ++c) acc[c] = 0.f;
            const int kbeg = wave * 128;
#pragma unroll 4
            for (int k = kbeg; k < kbeg + 128; ++k) { const float wv = wm[(size_t)k * 6144];
#pragma unroll
                for (int c = 0; c < 9; ++c) acc[c] += sc[c * 1024 + k] * wv; }
#pragma unroll
            for (int c = 0; c < 9; ++c) red[(wave * 9 + c) * 64 + lane] = acc[c];
            __syncthreads();
            for (int e = tid; e < 576; e += 512) { const int c = e >> 6, l = e & 63; float s = 0.f;
#pragma unroll
                for (int w = 0; w < 8; ++w) s += red[(w * 9 + c) * 64 + l];
                MOD[((size_t)li * 9 + c) * 6144 + j0 + l] = s + P.inp(I_BMOD)[li * 6144 + j0 + l]; }
            __syncthreads();
        }
    }
    __syncthreads();
    {
        LAS float* scr = (LAS float*)(lds + wave * 16384);
        const int gw = bid * 8 + wave, NGW = G * 8;
        constexpr int I1 = 16 * 86, I2 = 6 * 24, I3 = 4 * 32, I4 = 16 * 32, I5 = 16 * 96, I6 = 16 * 32, I7 = 16 * 176, I8 = 44 * 32;
        constexpr int NIT = I1 + I2 + I3 + I4 + I5 + I6 + 2 * I7 + 2 * I8;
        for (int it = gw; it < NIT; it += NGW) {
            int r = it;
            if (r < I1) { transpose_item<0>(P.inp(I_ABWIN), 1024, 2752, (bf16*)(ws + W_IN), scr, r, lane); continue; } r -= I1;
            if (r < I2) { transpose_item<0>(P.inp(I_WUQ), 384, 768, (bf16*)(ws + W_UQ), scr, r, lane); continue; } r -= I2;
            if (r < I3) { transpose_item<0>(P.inp(I_WUKV), 256, 1024, (bf16*)(ws + W_UKV), scr, r, lane); continue; } r -= I3;
            if (r < I4) { transpose_item<0>(P.inp(I_ABWOUT), 1024, 1024, (bf16*)(ws + W_ABO), scr, r, lane); continue; } r -= I4;
            if (r < I5) { transpose_item<0>(P.inp(I_CWQKV), 1024, 3072, (bf16*)(ws + W_QKV), scr, r, lane); continue; } r -= I5;
            if (r < I6) { transpose_item<0>(P.inp(I_CWOUT), 1024, 1024, (bf16*)(ws + W_CO), scr, r, lane); continue; } r -= I6;
            if (r < 2 * I7) { const int li = r / I7; transpose_item<1>(P.inp(I_WF1) + (size_t)li * 1024 * 5632, 1024, 5632, (bf16*)(ws + W_F1 + (size_t)li * 11 * MiB), scr, r % I7, lane); continue; } r -= 2 * I7;
            { const int li = r / I8; transpose_item<0>(P.inp(I_WF2) + (size_t)li * 2816 * 1024, 2816, 1024, (bf16*)(ws + W_F2 + (size_t)li * 2816 * 1024 * 2), scr, r % I8, lane); }
        }
    }
    const int gt = bid * 512 + tid, NT = G * 512;
    { u32x4* z = (u32x4*)(ws + W_IN + (size_t)2752 * 1024 * 2); for (int e = gt; e < 64 * 1024 * 2 / 16; e += NT) z[e] = (u32x4){0u, 0u, 0u, 0u}; }
    {
        float* rmc = (float*)(ws + WS_RM_COS); float* rms = (float*)(ws + WS_RM_SIN); float* rdc = (float*)(ws + WS_RD_COS); float* rds = (float*)(ws + WS_RD_SIN);
        for (int e = gt; e < 4096 * 16 + 4096 * 32; e += NT) {
            const bool isd = e >= 4096 * 16; const int ee = isd ? e - 4096 * 16 : e; const int np = isd ? 32 : 16, nf = np >> 1;
            const int t = ee / np, p = ee % np; const int fi = p % nf; const float posv = (float)(p < nf ? (t >> 6) : (t & 63));
            const float inv = exp2f(-(float)fi / (float)nf * 13.287712379549449f);
            const float ang = posv * inv; float rev = ang * 0.15915494309189535f; rev -= rintf(rev);
            const float sn = __builtin_amdgcn_sinf(rev), cs = __builtin_amdgcn_cosf(rev);
            if (isd) { rdc[ee] = cs; rds[ee] = sn; } else { rmc[ee] = cs; rms[ee] = sn; }
        }
    }
    if (bid == 0 && wave == 0) {
        const float* lp = P.inp(I_DLAM);
        const float a = wave_sum(lp[lane] * lp[64 + lane]), b = wave_sum(lp[128 + lane] * lp[192 + lane]);
        if (lane == 0) *(float*)(ws + WS_LAM) = __expf(a) - __expf(b) + LAM_INIT;
    }
}

__device__ __forceinline__ void norm_mod_store(const f32x4 (&v)[4], float ss, const float* g, const float* scale, const float* shift, bf16* hrow, int lane) {
    const float r = 1.f / sqrtf(ss * (1.f / 1024.f) + EPS);
#pragma unroll
    for (int j = 0; j < 4; ++j) { const int c = 4 * lane + 256 * j;
        const f32x4 gg = *(const f32x4*)(g + c), sc = *(const f32x4*)(scale + c), sh = *(const f32x4*)(shift + c);
        const f32x4 h = v[j] * r * gg * (sc + 1.f) + sh;
        u32x2 w; w.x = pkbf(h[0], h[1]); w.y = pkbf(h[2], h[3]); *(u32x2*)(hrow + c) = w; }
}
__device__ __forceinline__ void phase_norm0(const Params& P) {
    const int tid = tid_opaque(), lane = tid & 63, gw = blockIdx.x * 8 + (tid >> 6), NGW = gridDim.x * 8;
    const float* MOD = (const float*)(P.wsp() + WS_MOD); bf16* H = (bf16*)(P.wsp() + A_H);
    for (int row = gw; row < MT; row += NGW) {
        const float* x = xrow_in(P, row); const float* md = MOD + (size_t)(0 * 9 + cond_of(row)) * 6144;
        f32x4 v[4]; float ss = 0.f;
#pragma unroll
        for (int j = 0; j < 4; ++j) { v[j] = *(const f32x4*)(x + 4 * lane + 256 * j); ss += v[j][0] * v[j][0] + v[j][1] * v[j][1] + v[j][2] * v[j][2] + v[j][3] * v[j][3]; }
        ss = wave_sum(ss);
        norm_mod_store(v, ss, P.inp(I_GNORM) + 0, md + 1024, md + 0, H + (size_t)row * DM, lane);
    }
}
__device__ __forceinline__ void phase_resnorm(const Params& P, bool first, int liA, int gA, int gateIdx, bool doH, int liB, int gB, int scaleIdx, int shiftIdx) {
    const int tid = tid_opaque(), lane = tid & 63, gw = blockIdx.x * 8 + (tid >> 6), NGW = gridDim.x * 8;
    const float* MOD = (const float*)(P.wsp() + WS_MOD); bf16* H = (bf16*)(P.wsp() + A_H); const bf16* OUT = (const bf16*)(P.wsp() + R_OUT);
    float* X = P.outp() + O_Y;
    const float* ga = P.inp(I_GNORM) + (liA * 4 + gA) * 1024;
    constexpr int NR = 3;
    for (int row0 = gw; row0 < MT; row0 += NR * NGW) {
        int rows[NR];
#pragma unroll
        for (int u = 0; u < NR; ++u) rows[u] = row0 + u * NGW;
        f32x4 o[NR][4], v[NR][4]; float so[NR];
#pragma unroll
        for (int u = 0; u < NR; ++u) so[u] = 0.f;
#pragma unroll
        for (int u = 0; u < NR; ++u) { if (rows[u] >= MT) break; const int row = rows[u];
            const float* xo = first ? xrow_in(P, row) : X + (size_t)row * DM;
#pragma unroll
            for (int j = 0; j < 4; ++j) { const u32x2 w = *(const u32x2*)(OUT + (size_t)row * DM + 4 * lane + 256 * j);
                o[u][j] = (f32x4){bf_lo(w.x), bf_hi(w.x), bf_lo(w.y), bf_hi(w.y)}; v[u][j] = *(const f32x4*)(xo + 4 * lane + 256 * j); } }
#pragma unroll
        for (int u = 0; u < NR; ++u) { if (rows[u] >= MT) break;
#pragma unroll
            for (int j = 0; j < 4; ++j) so[u] += o[u][j][0] * o[u][j][0] + o[u][j][1] * o[u][j][1] + o[u][j][2] * o[u][j][2] + o[u][j][3] * o[u][j][3]; }
#pragma unroll
        for (int off = 1; off < 64; off <<= 1) {
#pragma unroll
            for (int u = 0; u < NR; ++u) so[u] += __shfl_xor(so[u], off); }
        float ss[NR];
#pragma unroll
        for (int u = 0; u < NR; ++u) ss[u] = 0.f;
#pragma unroll
        for (int u = 0; u < NR; ++u) { if (rows[u] >= MT) break; const int row = rows[u];
            const float* gate = MOD + (size_t)(liA * 9 + cond_of(row)) * 6144 + gateIdx * 1024; const float ro = 1.f / sqrtf(so[u] * (1.f / 1024.f) + EPS);
#pragma unroll
            for (int j = 0; j < 4; ++j) { const int c = 4 * lane + 256 * j; const f32x4 gg = *(const f32x4*)(ga + c), gt = *(const f32x4*)(gate + c);
                v[u][j] = v[u][j] + gt * (o[u][j] * ro * gg); ss[u] += v[u][j][0] * v[u][j][0] + v[u][j][1] * v[u][j][1] + v[u][j][2] * v[u][j][2] + v[u][j][3] * v[u][j][3];
                *(f32x4*)(X + (size_t)row * DM + c) = v[u][j]; } }
        if (doH) {
#pragma unroll
            for (int off = 1; off < 64; off <<= 1) {
#pragma unroll
                for (int u = 0; u < NR; ++u) ss[u] += __shfl_xor(ss[u], off); }
#pragma unroll
            for (int u = 0; u < NR; ++u) { if (rows[u] >= MT) break; const int row = rows[u]; const float* mdB = MOD + (size_t)(liB * 9 + cond_of(row)) * 6144;
                norm_mod_store(v[u], ss[u], P.inp(I_GNORM) + (liB * 4 + gB) * 1024, mdB + scaleIdx * 1024, mdB + shiftIdx * 1024, H + (size_t)row * DM, lane); }
        }
    }
}
__device__ __forceinline__ void phase_mla_prep(const Params& P) {
    const int tid = tid_opaque(), lane = tid & 63, gw = blockIdx.x * 8 + (tid >> 6), NGW = gridDim.x * 8;
    unsigned char* ws = P.wsp(); const bf16* PROJ = (const bf16*)(ws + B_PROJ); bf16* QLN = (bf16*)(ws + A_QLN); bf16* CKV = (bf16*)(ws + A_CKV); bf16* KROPE = (bf16*)(ws + R_KROPE);
    const float* rmc = (const float*)(ws + WS_RM_COS); const float* rms = (const float*)(ws + WS_RM_SIN);
    for (int row = gw; row < MT; row += NGW) {
        const bf16* pr = PROJ + (size_t)row * PJ; const int kr = key_row(row);
        float q[6]; float ss = 0.f;
#pragma unroll
        for (int j = 0; j < 3; ++j) { const unsigned w = *(const unsigned*)(pr + C_QLAT + 2 * lane + 128 * j); q[2 * j] = bf_lo(w); q[2 * j + 1] = bf_hi(w); ss += q[2 * j] * q[2 * j] + q[2 * j + 1] * q[2 * j + 1]; }
        ss = wave_sum(ss); const float rq = 1.f / sqrtf(ss * (1.f / 384.f) + EPS);
#pragma unroll
        for (int j = 0; j < 3; ++j) { const int c = 2 * lane + 128 * j; *(unsigned*)(QLN + (size_t)row * 384 + c) = pkbf(q[2 * j] * rq * P.inp(I_GQ)[c], q[2 * j + 1] * rq * P.inp(I_GQ)[c + 1]); }
        const u32x2 w = *(const u32x2*)(pr + C_KVLAT + 4 * lane); f32x4 kv = (f32x4){bf_lo(w.x), bf_hi(w.x), bf_lo(w.y), bf_hi(w.y)};
        float s2 = wave_sum(kv[0] * kv[0] + kv[1] * kv[1] + kv[2] * kv[2] + kv[3] * kv[3]); const float rk = 1.f / sqrtf(s2 * (1.f / 256.f) + EPS);
        kv = kv * rk * *(const f32x4*)(P.inp(I_GKV) + 4 * lane);
        { u32x2 o; o.x = pkbf(kv[0], kv[1]); o.y = pkbf(kv[2], kv[3]); *(u32x2*)(CKV + (size_t)kr * 256 + 4 * lane) = o; }
        if (row < MP) *(f32x4*)(P.outp() + O_CKV + (size_t)row * 256 + 4 * lane) = kv;
        if (lane < 16) { const unsigned wr = *(const unsigned*)(pr + C_KROPE + 2 * lane); float e = bf_lo(wr), od = bf_hi(wr);
            if (row < MP) { *(f32x2*)(P.outp() + O_KROPE + (size_t)row * 32 + 2 * lane) = (f32x2){e, od}; }
            else { const int t = (row - MP) & 4095; const float c = rmc[t * 16 + lane], s = rms[t * 16 + lane]; const float ne = e * c - od * s, no = e * s + od * c; e = ne; od = no; }
            *(unsigned*)(KROPE + (size_t)kr * 32 + 2 * lane) = pkbf(e, od); }
    }
    const int gt = blockIdx.x * 512 + tid, NT = gridDim.x * 512;
    for (int i = gt; i < 4096 * 256 / 4; i += NT) { const int e = i * 4, sr = e >> 8, col = e & 255; const int dr = MP + (sr >> 9) * 4608 + (sr & 511);
        const f32x4 v = *(const f32x4*)(P.inp(I_CKV) + e); u32x2 o; o.x = pkbf(v[0], v[1]); o.y = pkbf(v[2], v[3]); *(u32x2*)(CKV + (size_t)dr * 256 + col) = o; }
    for (int i = gt; i < 4096 * 32 / 4; i += NT) { const int e = i * 4, sr = e >> 5, col = e & 31; const int dr = MP + (sr >> 9) * 4608 + (sr & 511);
        const f32x4 v = *(const f32x4*)(P.inp(I_CKROPE) + e); u32x2 o; o.x = pkbf(v[0], v[1]); o.y = pkbf(v[2], v[3]); *(u32x2*)(KROPE + (size_t)dr * 32 + col) = o; }
}
__device__ __forceinline__ void phase_diff_ctx(const Params& P) {
    const int gt = blockIdx.x * 512 + tid_opaque(), NT = gridDim.x * 512;
    bf16* KD = (bf16*)(P.wsp() + B_KD); bf16* VT = (bf16*)(P.wsp() + R_VTD);
    for (int i = gt; i < 4096 * 1024 / 4; i += NT) { const int e = i * 4, sr = e >> 10, col = e & 1023; const int dr = MP + (sr >> 9) * 4608 + (sr & 511);
        const f32x4 v = *(const f32x4*)(P.inp(I_CDK) + e); u32x2 o; o.x = pkbf(v[0], v[1]); o.y = pkbf(v[2], v[3]); *(u32x2*)(KD + (size_t)dr * 1024 + col) = o; }
    for (int i = gt; i < 8 * 64 * 1024; i += NT) { const int hd = i & 1023, jg = (i >> 10) & 63, b = i >> 16;
        const float* src = P.inp(I_CDV) + ((size_t)(b * 512 + jg * 8)) * 1024 + hd; float f[8];
#pragma unroll
        for (int k = 0; k < 8; ++k) f[k] = src[(size_t)k * 1024];
        u32x4 o; o.x = pkbf(f[0], f[1]); o.y = pkbf(f[2], f[3]); o.z = pkbf(f[4], f[5]); o.w = pkbf(f[6], f[7]);
        *(u32x4*)(VT + (size_t)16 * 1024 * 256 + (size_t)b * 1024 * 4608 + (size_t)hd * 4608 + jg * 8) = o; }
}

__device__ __forceinline__ f32x16 mfma32(bf16x8 a, bf16x8 b, f32x16 c) { return __builtin_amdgcn_mfma_f32_32x32x16_bf16(a, b, c, 0, 0, 0); }
__device__ __forceinline__ f32x4 mfma16(bf16x8 a, bf16x8 b, f32x4 c) { return __builtin_amdgcn_mfma_f32_16x16x32_bf16(a, b, c, 0, 0, 0); }
__device__ __forceinline__ bf16x8 pack_bf8(float a0, float a1, float a2, float a3, float a4, float a5, float a6, float a7) {
    u32x4 w; w.x = pkbf(a0, a1); w.y = pkbf(a2, a3); w.z = pkbf(a4, a5); w.w = pkbf(a6, a7); return __builtin_bit_cast(bf16x8, w);
}
constexpr int VSTR = 144;
template <int MODE> struct AttnArgs {
    const bf16* Q; const bf16* K; const bf16* K2; const bf16* VTh; bf16* MIX; int row0, krow0, Lk, h; float lam; const float* gout;
};
__device__ __forceinline__ float max3f(float a, float b, float c) { float r; asm("v_max3_f32 %0, %1, %2, %3" : "=v"(r) : "v"(a), "v"(b), "v"(c)); return r; }
template <int MODE> __device__ __forceinline__ void attn_unit(ldsp lds, const AttnArgs<MODE>& A) {
    constexpr int ND = MODE == 0 ? 6 : 4, NMB = MODE == 0 ? 2 : 4, KSTR = MODE == 0 ? 208 : 272, DV = MODE == 0 ? 64 : 128;
    constexpr int KBUF = 64 * KSTR, VBUF = DV * VSTR;
    constexpr float CS = (MODE == 0 ? 0.10206207261596577f : 0.125f) * 1.4426950408889634f;
    const int tid = tid_opaque(), lane = tid & 63, r32 = lane & 31, hi = lane >> 5, wid = tid >> 6;
    const int map = MODE == 1 ? (wid >> 2) : 0;
    const int qrow = A.row0 + (MODE == 0 ? wid * 32 : (wid & 3) * 32) + r32;
    constexpr bool QLDS = false;
    constexpr int QST_OFF = 2 * KBUF + 2 * VBUF;
    bf16x8 qf[ND];
#pragma unroll
    for (int d0 = 0; d0 < ND; ++d0) {
        const u32x4 w = MODE == 0 ? *(const u32x4*)(A.Q + (size_t)qrow * 768 + A.h * 96 + 16 * d0 + 8 * hi) : *(const u32x4*)(A.Q + (size_t)qrow * 1024 + A.h * 128 + map * 64 + 16 * d0 + 8 * hi);
        u32x4 s; s.x = pkbf(bf_lo(w.x) * CS, bf_hi(w.x) * CS); s.y = pkbf(bf_lo(w.y) * CS, bf_hi(w.y) * CS); s.z = pkbf(bf_lo(w.z) * CS, bf_hi(w.z) * CS); s.w = pkbf(bf_lo(w.w) * CS, bf_hi(w.w) * CS);
        if (QLDS) *(LAS u32x4*)(lds + QST_OFF + wid * 4608 + r32 * 144 + hi * 16 + d0 * 32) = s; else qf[d0] = __builtin_bit_cast(bf16x8, s);
    }
    const int koff = r32 * KSTR + (MODE == 1 ? map * 128 : 0) + hi * 16;
    const int voff = r32 * VSTR + hi * 16;
    f32x16 o[NMB];
#pragma unroll
    for (int mb = 0; mb < NMB; ++mb) o[mb] = (f32x16){0.f, 0.f, 0.f, 0.f, 0.f, 0.f, 0.f, 0.f, 0.f, 0.f, 0.f, 0.f, 0.f, 0.f, 0.f, 0.f};
    float m_run = 0.f, l_run = 0.f;
    f32x16 negm = (f32x16){0.f, 0.f, 0.f, 0.f, 0.f, 0.f, 0.f, 0.f, 0.f, 0.f, 0.f, 0.f, 0.f, 0.f, 0.f, 0.f};
    const int NT = A.Lk >> 6;
    u32x4 rk0[2], rk1[2], rv0[2], rv1[2];
    const bf16* kg0; const bf16* kg1; const bf16* vg0; const bf16* vg1;
    if (MODE == 0) { kg0 = A.K + (size_t)(A.krow0 + (tid >> 3)) * 512 + A.h * 64 + (tid & 7) * 8; kg1 = A.K2 + (size_t)(A.krow0 + ((tid & 255) >> 2)) * 32 + (tid & 3) * 8;
                     vg0 = A.VTh + (size_t)(tid >> 3) * A.Lk + (tid & 7) * 8; vg1 = vg0; }
    else { kg0 = A.K + (size_t)(A.krow0 + (tid >> 4)) * 1024 + A.h * 128 + (tid & 15) * 8; kg1 = kg0;
           vg0 = A.VTh + (size_t)(tid >> 3) * A.Lk + (tid & 7) * 8; vg1 = vg0; }
    auto gloadK = [&](int t, const int s) {
        if (MODE == 0) { rk0[s] = *(const u32x4*)(kg0 + (size_t)t * 64 * 512); if (tid < 256) rk1[s] = *(const u32x4*)(kg1 + (size_t)t * 64 * 32); }
        else { const bf16* kp = kg0 + (size_t)t * 64 * 1024; rk0[s] = *(const u32x4*)kp; rk1[s] = *(const u32x4*)(kp + (size_t)32 * 1024); }
    };
    auto gloadV = [&](int t, const int s) { const bf16* vp = vg0 + 64 * t; rv0[s] = *(const u32x4*)vp; if (MODE == 1) rv1[s] = *(const u32x4*)(vp + (size_t)64 * A.Lk); };
    auto stK = [&](int buf, const int s) {
        ldsp kb = lds + buf * KBUF;
        if (MODE == 0) { *(LAS u32x4*)(kb + (tid >> 3) * KSTR + (tid & 7) * 16) = rk0[s]; if (tid < 256) *(LAS u32x4*)(kb + (tid >> 2) * KSTR + 128 + (tid & 3) * 16) = rk1[s]; }
        else { *(LAS u32x4*)(kb + (tid >> 4) * KSTR + (tid & 15) * 16) = rk0[s]; *(LAS u32x4*)(kb + (32 + (tid >> 4)) * KSTR + (tid & 15) * 16) = rk1[s]; }
    };
    auto stV = [&](int buf, const int s) {
        ldsp vb = lds + 2 * KBUF + buf * VBUF;
        const int cc = tid & 7, vpo = ((cc >> 1) * 16 + (cc & 1) * 4) * 2;
        LAS u32x2* vp = (LAS u32x2*)(vb + (tid >> 3) * VSTR + vpo); vp[0] = (u32x2){rv0[s].x, rv0[s].y}; vp[2] = (u32x2){rv0[s].z, rv0[s].w};
        if (MODE == 1) { LAS u32x2* vq = (LAS u32x2*)(vb + (64 + (tid >> 3)) * VSTR + vpo); vq[0] = (u32x2){rv1[s].x, rv1[s].y}; vq[2] = (u32x2){rv1[s].z, rv1[s].w}; }
    };
    auto qk = [&](int buf, f32x16& s0, f32x16& s1) {
        ldsp kb = lds + buf * KBUF;
        s0 = negm; s1 = negm;
#pragma unroll
        for (int d0 = 0; d0 < ND; ++d0) {
            const bf16x8 a0 = *(const LAS bf16x8*)(kb + koff + d0 * 32), a1 = *(const LAS bf16x8*)(kb + koff + 32 * KSTR + d0 * 32);
            const bf16x8 qq = QLDS ? *(const LAS bf16x8*)(lds + QST_OFF + wid * 4608 + r32 * 144 + hi * 16 + d0 * 32) : qf[d0];
            s0 = mfma32(a0, qq, s0); s1 = mfma32(a1, qq, s1);
        }
    };
    bf16x8 pf[4];
    f32x16 sc0, sc1;
    float mxa, mxb;
    auto mxstep = [&](int k) {
        if (k == 0) mxa = max3f(sc0[0], sc0[1], sc1[0]);
        else if (k == 1) mxb = max3f(sc0[2], sc0[3], sc1[1]);
        else if (k == 2) mxa = max3f(mxa, sc1[2], sc1[3]);
        else if (k < 15) { const int q = k - 3, r = 4 + 4 * (q >> 2), w = q & 3;
            if (w == 0) mxa = max3f(mxa, sc0[r], sc0[r + 1]); else if (w == 1) mxb = max3f(mxb, sc0[r + 2], sc0[r + 3]);
            else if (w == 2) mxa = max3f(mxa, sc1[r], sc1[r + 1]); else mxb = max3f(mxb, sc1[r + 2], sc1[r + 3]); }
        else mxa = max3f(mxa, mxb, mxb);
    };
    auto pv_max = [&](int buf, const bool dopv) {
        if (!dopv) {
#pragma unroll
            for (int k = 0; k < 16; ++k) mxstep(k);
            return;
        }
        ldsp vb = lds + 2 * KBUF + buf * VBUF;
        constexpr int NS = 2 * NMB;
        bf16x8 vf[2][2];
        auto ldv = [&](int s, bf16x8 (&dst)[2]) {
            const int j = s / (NMB / 2), mp = s % (NMB / 2);
#pragma unroll
            for (int e = 0; e < 2; ++e) { const int mb = 2 * mp + e;
                dst[e] = *(const LAS bf16x8*)(vb + mb * 32 * VSTR + voff + j * 32); }
        };
        ldv(0, vf[0]);
        __builtin_amdgcn_sched_barrier(0);
#pragma unroll
        for (int s = 0; s < NS; ++s) {
            if (s + 1 < NS) { ldv(s + 1, vf[(s + 1) & 1]); __builtin_amdgcn_sched_barrier(0); }
            const int j = s / (NMB / 2), mp = s % (NMB / 2);
#pragma unroll
            for (int e = 0; e < 2; ++e) { const int mb = 2 * mp + e; o[mb] = mfma32(vf[s & 1][e], pf[j], o[mb]);
#pragma unroll
                for (int q = 0; q < 16 / (2 * NS); ++q) mxstep((2 * s + e) * (16 / (2 * NS)) + q); }
            __builtin_amdgcn_sched_barrier(0);
        }
    };
    gloadK(0, 0); gloadK(1, 1); stK(0, 0); stK(1, 1); gloadK(2, 0); gloadV(0, 0);
    __syncthreads();
    qk(0, sc0, sc1);
    __syncthreads();
    auto iter = [&](int t, const int par, const bool first, const bool last) {
        stV(par, 0);
        if (t + 2 < NT) stK(par, 0);
        if (t + 3 < NT) gloadK(t + 3, 0);
        if (!last) gloadV(t + 1, 0);
        pv_max(par ^ 1, !first);
        float mx = fmaxf(mxa, __shfl_xor(mxa, 32));
        if (first || __any(mx > 8.f)) {
            const float dl = first ? mx : fmaxf(mx, 0.f), alpha = fast_exp2(-dl); m_run += dl; l_run *= alpha;
#pragma unroll
            for (int mb = 0; mb < NMB; ++mb)
#pragma unroll
                for (int r = 0; r < 16; ++r) o[mb][r] *= alpha;
#pragma unroll
            for (int r = 0; r < 16; ++r) { sc0[r] -= dl; sc1[r] -= dl; negm[r] = -m_run; }
        }
        f32x16 sn0, sn1;
        if (!last) qk(par ^ 1, sn0, sn1);
        float rs = 0.f;
#pragma unroll
        for (int r = 0; r < 16; ++r) { sc0[r] = fast_exp2(sc0[r]); sc1[r] = fast_exp2(sc1[r]); rs += sc0[r] + sc1[r]; }
        l_run += rs;
        pf[0] = pack_bf8(sc0[0], sc0[1], sc0[2], sc0[3], sc0[4], sc0[5], sc0[6], sc0[7]); pf[1] = pack_bf8(sc0[8], sc0[9], sc0[10], sc0[11], sc0[12], sc0[13], sc0[14], sc0[15]);
        pf[2] = pack_bf8(sc1[0], sc1[1], sc1[2], sc1[3], sc1[4], sc1[5], sc1[6], sc1[7]); pf[3] = pack_bf8(sc1[8], sc1[9], sc1[10], sc1[11], sc1[12], sc1[13], sc1[14], sc1[15]);
        if (!last) { sc0 = sn0; sc1 = sn1; }
        __syncthreads();
    };
    iter(0, 0, true, false);
    iter(1, 1, false, false);
    for (int t = 2; t < NT - 2; t += 2) { iter(t, 0, false, false); iter(t + 1, 1, false, false); }
    iter(NT - 2, 0, false, false);
    iter(NT - 1, 1, false, true);
    pv_max(1, true);
    l_run += __shfl_xor(l_run, 32);
    const float inv = 1.f / l_run;
    __syncthreads();
    if (MODE == 0) {
        bf16* orow = A.MIX + (size_t)qrow * 1024 + A.h * 64;
#pragma unroll
        for (int mb = 0; mb < NMB; ++mb)
#pragma unroll
            for (int g = 0; g < 4; ++g) { u32x2 w; w.x = pkbf(o[mb][4 * g] * inv, o[mb][4 * g + 1] * inv); w.y = pkbf(o[mb][4 * g + 2] * inv, o[mb][4 * g + 3] * inv);
                *(u32x2*)(orow + 32 * mb + 8 * g + 4 * hi) = w; }
    } else {
        LAS float* xb = (LAS float*)lds + (size_t)(wid & 3) * 64 * 64;
        if (wid >= 4) {
#pragma unroll
            for (int mb = 0; mb < NMB; ++mb)
#pragma unroll
                for (int r = 0; r < 16; ++r) xb[(mb * 16 + r) * 64 + lane] = o[mb][r] * inv;
        }
        __syncthreads();
        if (wid < 4) {
            float ss = 0.f;
#pragma unroll
            for (int mb = 0; mb < NMB; ++mb)
#pragma unroll
                for (int r = 0; r < 16; ++r) { const float v = o[mb][r] * inv - A.lam * xb[(mb * 16 + r) * 64 + lane]; o[mb][r] = v; ss += v * v; }
            ss += __shfl_xor(ss, 32);
            const float rr = (1.f - LAM_INIT) / sqrtf(ss * (1.f / 128.f) + EPS);
            bf16* orow = A.MIX + (size_t)qrow * 1024 + A.h * 128;
#pragma unroll
            for (int mb = 0; mb < NMB; ++mb)
#pragma unroll
                for (int g = 0; g < 4; ++g) { const int d = 32 * mb + 8 * g + 4 * hi; const f32x4 gg = *(const f32x4*)(A.gout + d);
                    u32x2 w; w.x = pkbf(o[mb][4 * g] * rr * gg[0], o[mb][4 * g + 1] * rr * gg[1]); w.y = pkbf(o[mb][4 * g + 2] * rr * gg[2], o[mb][4 * g + 3] * rr * gg[3]);
                    *(u32x2*)(orow + d) = w; }
        }
        __syncthreads();
    }
}

__device__ __forceinline__ float logsig(float x) { return fminf(x, 0.f) - __logf(1.f + __expf(-fabsf(x))); }
__device__ __forceinline__ void gla_unit(ldsp lds, const Params& P, bool prompt, int b, int h, int dir) {
    constexpr int QSTR = 272, TSTR = 144;
    constexpr int L_QIN = 0, L_KIN = 64 * QSTR, L_KOT = 2 * 64 * QSTR, L_VT = L_KOT + 128 * TSTR, L_AM = L_VT + 128 * TSTR, L_LR = L_AM + 64 * TSTR, L_TOT = L_LR + 4096, L_DEC = L_TOT + 2048,
                  L_VRAW = L_DEC + 512;
    static_assert(L_VRAW + 64 * QSTR <= 131072, "gla lds");
    const int tid = tid_opaque(), lane = tid & 63, wid = tid >> 6, l16 = lane & 15, q4 = lane >> 4;
    const int L = prompt ? 256 : 4096, nch = L >> 6, rowbase = prompt ? b * 256 : MP + b * 4096;
    const bf16* PROJ = (const bf16*)(P.wsp() + B_PROJ);
    bf16* OD = dir == 0 ? (bf16*)(P.wsp() + B_PROJ) + h * 128 : (bf16*)(P.wsp() + A_MIX) + 512 + h * 128;
    const int ostr = dir == 0 ? PJ : 1024;
    LAS float* dec = (LAS float*)(lds + L_DEC);
    const int vcol = 16 * wid + l16;
    f32x4 S[8];
    if (prompt) {
#pragma unroll
        for (int db = 0; db < 8; ++db) S[db] = (f32x4){0.f, 0.f, 0.f, 0.f};
    } else {
        const float* sfp = P.inp(I_SF); const float* sbp = P.inp(I_SB); asm volatile("" : "+s"(sfp), "+s"(sbp));
        const float* s0 = (dir == 0 ? sfp : sbp) + ((size_t)(b * 4 + h) * 128) * 128 + (size_t)(4 * q4) * 128 + vcol; asm volatile("" : "+v"(s0));
#pragma unroll
        for (int db = 0; db < 8; ++db)
#pragma unroll
            for (int r = 0; r < 4; ++r) S[db][r] = s0[(16 * db + r) * 128];
    }
    const int dq = 16 * wid + l16;
    bf16x8 wgf;
    {
        float wv[8];
#pragma unroll
        for (int j = 0; j < 8; ++j) wv[j] = q4 < 2 ? P.inp(I_WGATE)[(size_t)(dir * 16 + 8 * q4 + j) * 512 + h * 128 + dq] : 0.f;
        wgf = pack_bf8(wv[0], wv[1], wv[2], wv[3], wv[4], wv[5], wv[6], wv[7]);
    }
    const float bg = P.inp(I_BGATE)[dir * 512 + h * 128 + dq];
    u32x4 rq[2], rk[2], rv[2], lrf[4];
    auto raw_load = [&](int ci) {
        const int n = dir == 0 ? ci : nch - 1 - ci; const int tok0 = rowbase + n * 64;
#pragma unroll
        for (int i = 0; i < 2; ++i) { const int idx = tid + 512 * i; const bf16* pr = PROJ + (size_t)(tok0 + (idx >> 4)) * PJ + h * 128 + (idx & 15) * 8;
            rq[i] = *(const u32x4*)(pr + C_GQ); rk[i] = *(const u32x4*)(pr + C_GK); rv[i] = *(const u32x4*)(pr + C_GV); }
        const bf16* pl = PROJ + (size_t)(tok0 + l16) * PJ + C_GGATE + dir * 16 + 8 * (q4 & 1); asm volatile("" : "+v"(pl));
#pragma unroll
        for (int mb = 0; mb < 4; ++mb) { const u32x4 t = *(const u32x4*)(pl + (size_t)(16 * mb) * PJ); lrf[mb] = q4 < 2 ? t : (u32x4){0u, 0u, 0u, 0u}; }
    };
    raw_load(0);
    for (int ci = 0; ci < nch; ++ci) {
        const int n = dir == 0 ? ci : nch - 1 - ci; const int tok0 = rowbase + n * 64;
#pragma unroll
        for (int i = 0; i < 2; ++i) { const int idx = tid + 512 * i, off = (idx >> 4) * QSTR + (idx & 15) * 16;
            *(LAS u32x4*)(lds + L_QIN + off) = rq[i]; *(LAS u32x4*)(lds + L_KIN + off) = rk[i]; *(LAS u32x4*)(lds + L_VRAW + off) = rv[i]; }
        float g[4][4];
#pragma unroll
        for (int mb = 0; mb < 4; ++mb) { const f32x4 acc = mfma16(__builtin_bit_cast(bf16x8, lrf[mb]), wgf, (f32x4){0.f, 0.f, 0.f, 0.f});
#pragma unroll
            for (int r = 0; r < 4; ++r) g[mb][r] = logsig(acc[r] + bg) * (1.f / 16.f); }
        if (ci + 1 < nch) raw_load(ci + 1);
        __syncthreads();
        float qv[4][4], kv[4][4]; bf16 vraw[4][4];
#pragma unroll
        for (int mb = 0; mb < 4; ++mb)
#pragma unroll
            for (int r = 0; r < 4; ++r) { const int off = (16 * mb + 4 * q4 + r) * QSTR + dq * 2;
                qv[mb][r] = bf1(*(const LAS bf16*)(lds + L_QIN + off)); kv[mb][r] = bf1(*(const LAS bf16*)(lds + L_KIN + off)); vraw[mb][r] = *(const LAS bf16*)(lds + L_VRAW + off); }
        float pfx[4][4], total = 0.f;
#pragma unroll
        for (int mb = 0; mb < 4; ++mb) {
            pfx[mb][0] = g[mb][0]; pfx[mb][1] = pfx[mb][0] + g[mb][1]; pfx[mb][2] = pfx[mb][1] + g[mb][2]; pfx[mb][3] = pfx[mb][2] + g[mb][3];
            const float R = pfx[mb][3];
            const float e1 = __shfl_up(R, 16), e2 = __shfl_up(R, 32), e3 = __shfl_up(R, 48);
            const float excl = (q4 >= 1 ? e1 : 0.f) + (q4 >= 2 ? e2 : 0.f) + (q4 >= 3 ? e3 : 0.f);
            const float blk = __shfl(excl + R, 48 + l16);
            const float base = excl + total;
#pragma unroll
            for (int r = 0; r < 4; ++r) pfx[mb][r] += base;
            total += blk;
        }
        if (q4 == 0) dec[dq] = __expf(total);
        {
            const float etot = __expf(total);
#pragma unroll
            for (int mb = 0; mb < 4; ++mb) {
                float ko[4];
#pragma unroll
                for (int r = 0; r < 4; ++r) { const float cum = dir == 0 ? pfx[mb][r] : total - pfx[mb][r] + g[mb][r]; const int s = 16 * mb + 4 * q4 + r;
                    const float ec = __expf(cum), en = fast_rcp(ec);
                    *(LAS bf16*)(lds + L_QIN + s * QSTR + dq * 2) = tobf(qv[mb][r] * 0.08838834764831845f * ec);
                    *(LAS bf16*)(lds + L_KIN + s * QSTR + dq * 2) = tobf(kv[mb][r] * en);
                    ko[r] = kv[mb][r] * en * etot; }
                u32x2 w; w.x = pkbf(ko[0], ko[1]); w.y = pkbf(ko[2], ko[3]);
                *(LAS u32x2*)(lds + L_KOT + dq * TSTR + (16 * mb + 4 * q4) * 2) = w;
                u32x2 v; v.x = vraw[mb][0] | ((unsigned)vraw[mb][1] << 16); v.y = vraw[mb][2] | ((unsigned)vraw[mb][3] << 16);
                *(LAS u32x2*)(lds + L_VT + dq * TSTR + (16 * mb + 4 * q4) * 2) = v;
            }
        }
        __syncthreads();
        {
            const int cb1 = wid >> 1, sh = wid & 1;
#pragma unroll
            for (int nb = 0; nb < 2; ++nb) {
                f32x4 acc = (f32x4){0.f, 0.f, 0.f, 0.f};
#pragma unroll
                for (int kb = 0; kb < 4; ++kb) {
                    const bf16x8 a = *(const LAS bf16x8*)(lds + L_QIN + (16 * cb1 + l16) * QSTR + (32 * kb + 8 * q4) * 2);
                    const bf16x8 bb = *(const LAS bf16x8*)(lds + L_KIN + (32 * sh + 16 * nb + l16) * QSTR + (32 * kb + 8 * q4) * 2);
                    acc = mfma16(a, bb, acc);
                }
                const int s = 32 * sh + 16 * nb + l16;
#pragma unroll
                for (int r = 0; r < 4; ++r) { const int c = 16 * cb1 + 4 * q4 + r; const bool keep = dir == 0 ? (s <= c) : (s >= c);
                    *(LAS bf16*)(lds + L_AM + c * TSTR + s * 2) = tobf(keep ? acc[r] : 0.f); }
            }
        }
        f32x4 o[4];
        {
            bf16x8 sb[4];
#pragma unroll
            for (int kb = 0; kb < 4; ++kb) sb[kb] = pack_bf8(S[2 * kb][0], S[2 * kb][1], S[2 * kb][2], S[2 * kb][3], S[2 * kb + 1][0], S[2 * kb + 1][1], S[2 * kb + 1][2], S[2 * kb + 1][3]);
#pragma unroll
            for (int cb = 0; cb < 4; ++cb) { o[cb] = (f32x4){0.f, 0.f, 0.f, 0.f};
#pragma unroll
                for (int kb = 0; kb < 4; ++kb) {
                    const s16x4 lo = *(const LAS s16x4*)(lds + L_QIN + (16 * cb + l16) * QSTR + (32 * kb + 4 * q4) * 2), hh = *(const LAS s16x4*)(lds + L_QIN + (16 * cb + l16) * QSTR + (32 * kb + 16 + 4 * q4) * 2);
                    const bf16x8 a = (bf16x8){lo[0], lo[1], lo[2], lo[3], hh[0], hh[1], hh[2], hh[3]};
                    o[cb] = mfma16(a, sb[kb], o[cb]);
                } }
        }
        __syncthreads();
        {
            bf16x8 vb[2];
#pragma unroll
            for (int kb = 0; kb < 2; ++kb) vb[kb] = *(const LAS bf16x8*)(lds + L_VT + vcol * TSTR + (32 * kb + 8 * q4) * 2);
#pragma unroll
            for (int cb = 0; cb < 4; ++cb)
#pragma unroll
                for (int kb = 0; kb < 2; ++kb) { const bf16x8 a = *(const LAS bf16x8*)(lds + L_AM + (16 * cb + l16) * TSTR + (32 * kb + 8 * q4) * 2); o[cb] = mfma16(a, vb[kb], o[cb]); }
#pragma unroll
            for (int db = 0; db < 8; ++db) { const f32x4 dc = *(const LAS f32x4*)(lds + L_DEC + (16 * db + 4 * q4) * 4); S[db] = S[db] * dc;
#pragma unroll
                for (int kb = 0; kb < 2; ++kb) { const bf16x8 a = *(const LAS bf16x8*)(lds + L_KOT + (16 * db + l16) * TSTR + (32 * kb + 8 * q4) * 2); S[db] = mfma16(a, vb[kb], S[db]); } }
        }
        {
            bf16* pw0 = OD + (size_t)(tok0 + 4 * q4) * ostr + vcol; asm volatile("" : "+v"(pw0));
#pragma unroll
            for (int cb = 0; cb < 4; ++cb)
#pragma unroll
                for (int r = 0; r < 4; ++r) pw0[(size_t)(16 * cb + r) * ostr] = tobf(o[cb][r]);
        }
        __syncthreads();
    }
    if (prompt) { float* so = P.outp() + (dir == 0 ? O_GF : O_GB) + ((size_t)(b * 4 + h) * 128) * 128 + (size_t)(4 * q4) * 128 + vcol; asm volatile("" : "+v"(so));
#pragma unroll
        for (int db = 0; db < 8; ++db)
#pragma unroll
            for (int r = 0; r < 4; ++r) so[(16 * db + r) * 128] = S[db][r]; }
    __syncthreads();
}
__device__ __forceinline__ void phase_gla_fin(const Params& P) {
    const int tid = tid_opaque(), lane = tid & 63, gw = blockIdx.x * 8 + (tid >> 6), NGW = gridDim.x * 8;
    const bf16* PROJ = (const bf16*)(P.wsp() + B_PROJ); bf16* MIX = (bf16*)(P.wsp() + A_MIX);
    const f32x4 g0 = *(const f32x4*)(P.inp(I_GGOUT) + (8 * lane & 127)), g1 = *(const f32x4*)(P.inp(I_GGOUT) + (8 * lane & 127) + 4);
    for (int row = gw; row < MT; row += NGW) {
        const u32x4 a = *(const u32x4*)(PROJ + (size_t)row * PJ + 8 * lane), bq = *(const u32x4*)(MIX + (size_t)row * 1024 + 512 + 8 * lane), gt = *(const u32x4*)(PROJ + (size_t)row * PJ + C_GOUT + 8 * lane);
        float v[8];
        v[0] = bf_lo(a.x) + bf_lo(bq.x); v[1] = bf_hi(a.x) + bf_hi(bq.x); v[2] = bf_lo(a.y) + bf_lo(bq.y); v[3] = bf_hi(a.y) + bf_hi(bq.y);
        v[4] = bf_lo(a.z) + bf_lo(bq.z); v[5] = bf_hi(a.z) + bf_hi(bq.z); v[6] = bf_lo(a.w) + bf_lo(bq.w); v[7] = bf_hi(a.w) + bf_hi(bq.w);
        float ss = 0.f;
#pragma unroll
        for (int i = 0; i < 8; ++i) ss += v[i] * v[i];
        ss += __shfl_xor(ss, 1); ss += __shfl_xor(ss, 2); ss += __shfl_xor(ss, 4); ss += __shfl_xor(ss, 8);
        const float rr = 1.f / sqrtf(ss * (1.f / 128.f) + EPS);
        u32x4 w;
        w.x = pkbf(v[0] * rr * g0[0] * silu_f(bf_lo(gt.x)), v[1] * rr * g0[1] * silu_f(bf_hi(gt.x))); w.y = pkbf(v[2] * rr * g0[2] * silu_f(bf_lo(gt.y)), v[3] * rr * g0[3] * silu_f(bf_hi(gt.y)));
        w.z = pkbf(v[4] * rr * g1[0] * silu_f(bf_lo(gt.z)), v[5] * rr * g1[1] * silu_f(bf_hi(gt.z))); w.w = pkbf(v[6] * rr * g1[2] * silu_f(bf_lo(gt.w)), v[7] * rr * g1[3] * silu_f(bf_hi(gt.w)));
        *(u32x4*)(MIX + (size_t)row * 1024 + 512 + 8 * lane) = w;
    }
}

#define RLX_AGENT __ATOMIC_RELAXED, __HIP_MEMORY_SCOPE_AGENT
#define XB_TMO      128
#define XB_XCNT(j)  (256  + 64 * (j))
#define XB_XSUB(j)  (1280 + 64 * (j))
#define XB_XGEN(j)  (2304 + 64 * (j))
#define XB_TOP      3328
#define XB_TOPGEN   3392
#define XCD_BAR_WORDS 3456
#define XB_SPIN_CAP (1u << 18)

__device__ __forceinline__ unsigned xb_ld(unsigned* p)              { return __hip_atomic_load(p, __ATOMIC_RELAXED, __HIP_MEMORY_SCOPE_AGENT); }
__device__ __forceinline__ unsigned xb_add(unsigned* p, unsigned v) { return __hip_atomic_fetch_add(p, v, __ATOMIC_RELAXED, __HIP_MEMORY_SCOPE_AGENT); }
__device__ __forceinline__ unsigned xb_xcc_id() { return (unsigned)__builtin_amdgcn_s_getreg((3 << 11) | 20) & 0xFu; }
#define XB_SPIN(cond, bar) do { unsigned _sp = 0; while (cond) { __builtin_amdgcn_s_sleep(1); \
    if ((++_sp & 255u) == 0u) { if (xb_ld(&(bar)[XB_TMO])) break; if (_sp > XB_SPIN_CAP) { atomicAdd(&(bar)[XB_TMO], 1u); break; } } } } while (0)

struct XcdBarrier {
    unsigned* bar; unsigned x;
    volatile LAS unsigned* st;
};

__device__ __forceinline__ XcdBarrier xcd_barrier_post(unsigned* bar, volatile LAS unsigned* st) {
    XcdBarrier b; b.bar = bar; b.x = xb_xcc_id(); b.st = st;
    if (threadIdx.x == 0) (void)xb_add(&bar[XB_XCNT(b.x)], 1u);
    return b;
}
__device__ __forceinline__ void xcd_barrier_complete(unsigned* bar, unsigned x, unsigned& nloc, unsigned& nx) {
    const unsigned G = gridDim.x * gridDim.y * gridDim.z;
    unsigned sum, cnt, mine, sp = 0u;
    for (;;) {
        sum = 0u; cnt = 0u; mine = 0u;
#pragma unroll
        for (unsigned j = 0; j < 16; ++j) { const unsigned c = xb_ld(&bar[XB_XCNT(j)]); sum += c; cnt += (c > 0u) ? 1u : 0u; mine = (j == x) ? c : mine; }
        if (sum == G) break;
        __builtin_amdgcn_s_sleep(1);
        if ((++sp & 255u) == 0u) { if (xb_ld(&bar[XB_TMO])) break; if (sp > XB_SPIN_CAP) { atomicAdd(&bar[XB_TMO], 1u); break; } }
    }
    nloc = mine > 0u ? mine : 1u; nx = cnt > 0u ? cnt : 1u;
}

__device__ __forceinline__ void xcd_barrier(const XcdBarrier& b) {
    asm volatile("s_waitcnt vmcnt(0)" ::: "memory");
    __syncthreads();
    if (threadIdx.x == 0) {
        unsigned* bar = b.bar;
        __builtin_amdgcn_s_waitcnt(0);
        unsigned nloc = b.st[0], nx = b.st[1];
        if (nloc == 0u) { xcd_barrier_complete(bar, b.x, nloc, nx); b.st[0] = nloc; b.st[1] = nx; }
        const unsigned old = xb_add(&bar[XB_XSUB(b.x)], 1u);
        const unsigned gen = old / nloc;
        if (old + 1u == (gen + 1u) * nloc) {
            __builtin_amdgcn_fence(__ATOMIC_RELEASE, "agent");
            asm volatile("s_waitcnt vmcnt(0)" ::: "memory");
            const unsigned og = xb_add(&bar[XB_TOP], 1u);
            const unsigned tg = og / nx;
            if (og + 1u == (tg + 1u) * nx) xb_add(&bar[XB_TOPGEN], 1u);
            else XB_SPIN(xb_ld(&bar[XB_TOPGEN]) == tg, bar);
            __builtin_amdgcn_fence(__ATOMIC_ACQUIRE, "agent");
            xb_add(&bar[XB_XGEN(b.x)], 1u);
            asm volatile("s_waitcnt vmcnt(0)" ::: "memory");
        } else {
            XB_SPIN(xb_ld(&bar[XB_XGEN(b.x)]) == gen, bar);
            __builtin_amdgcn_fence(__ATOMIC_ACQUIRE, "agent");
            asm volatile("s_waitcnt vmcnt(0)" ::: "memory");
        }
    }
    __syncthreads();
}


#ifndef NO_GEMM
#define RUN_GEMM(...) pg8::run_gemm(__VA_ARGS__)
#else
#define RUN_GEMM(...) do{}while(0)
#endif
#ifndef NO_ATT0
#define ATT0(...) attn_unit<0>(__VA_ARGS__)
#else
#define ATT0(...) do{}while(0)
#endif
#ifndef NO_ATT1
#define ATT1(...) attn_unit<1>(__VA_ARGS__)
#else
#define ATT1(...) do{}while(0)
#endif
#ifndef NO_GLA
#define GLA(...) gla_unit(__VA_ARGS__)
#else
#define GLA(...) do{}while(0)
#endif
#ifndef NO_EmPlain
#define RG_EmPlain(...) RUN_GEMM(__VA_ARGS__)
#else
#define RG_EmPlain(...) do{}while(0)
#endif
#ifndef NO_EmQ
#define RG_EmQ(...) RUN_GEMM(__VA_ARGS__)
#else
#define RG_EmQ(...) do{}while(0)
#endif
#ifndef NO_EmKV
#define RG_EmKV(...) RUN_GEMM(__VA_ARGS__)
#else
#define RG_EmKV(...) do{}while(0)
#endif
#ifndef NO_EmFFN
#define RG_EmFFN(...) RUN_GEMM(__VA_ARGS__)
#else
#define RG_EmFFN(...) do{}while(0)
#endif
#ifndef NO_EmQKV
#define RG_EmQKV(...) RUN_GEMM(__VA_ARGS__)
#else
#define RG_EmQKV(...) do{}while(0)
#endif
#ifndef PH_LO
#define PH_LO 0
#endif
#ifndef PH_HI
#define PH_HI 20
#endif
constexpr int LDS_BYTES = 147456;
__device__ __forceinline__ int next_item(unsigned* ctr, ldsp lds) {
    LAS int* slot = (LAS int*)(lds + 131072 + 64);
    __syncthreads();
    if (threadIdx.x == 0) *slot = (int)atomicAdd(ctr, 1u);
    __syncthreads();
    return *slot;
}
__device__ __forceinline__ int bcast_item(int v, ldsp lds) {
    LAS int* slot = (LAS int*)(lds + 131072 + 64);
    __syncthreads();
    if (threadIdx.x == 0) *slot = v;
    __syncthreads();
    return *slot;
}
__global__ void __launch_bounds__(512, 2) fwd_megakernel(ParamsK Pkarg) {
    extern __shared__ __attribute__((aligned(16))) unsigned char lds_raw[];
    ldsp lds = (ldsp)lds_raw;
    cg::grid_group grid = cg::this_grid();
    XcdBarrier xbar;
    {
        volatile LAS unsigned* stw = (volatile LAS unsigned*)(lds + 131072 + 128);
        if (threadIdx.x < 2) stw[threadIdx.x] = 0u;
        __syncthreads();
#if defined(__HIP_DEVICE_COMPILE__)
        unsigned char* ws0 = *(unsigned char* const __attribute__((address_space(4)))*)((const __attribute__((address_space(4))) char*)__builtin_amdgcn_kernarg_segment_ptr() + 8 * 29);
#else
        unsigned char* ws0 = nullptr;
#endif
        xbar = xcd_barrier_post((unsigned*)(ws0 + WS_CTL) + 4096, stw);
    }
#pragma unroll 1
    for (int ph = PH_LO; ph < PH_HI; ++ph) {
        Params P;
#if defined(__HIP_DEVICE_COMPILE__)
        P.kp = (const __attribute__((address_space(4))) char*)__builtin_amdgcn_kernarg_segment_ptr(); asm volatile("" : "+s"(P.kp));
#else
        P.kp = nullptr;
#endif
        unsigned char* ws = P.wsp();
        unsigned* ctl = (unsigned*)(ws + WS_CTL);
        typedef pg8::bf16_t* bp; typedef const pg8::bf16_t* cbp;
        const float* rmc = (const float*)(ws + WS_RM_COS); const float* rms = (const float*)(ws + WS_RM_SIN); const float* rdc = (const float*)(ws + WS_RD_COS); const float* rds = (const float*)(ws + WS_RD_SIN);
#ifdef REPMASK
        const int nrep = 1 + ((REPMASK >> ph) & 1);
#else
        const int nrep = 1;
#endif
#pragma unroll 1
        for (int rep = 0; rep < nrep; ++rep) {
        if (rep) xcd_barrier(xbar);
        int kind = 0;
        cbp gA = nullptr, gB = nullptr; int gM = 0, gN = 0, gK = 0; bp gO = nullptr; int gldc = 0;
        bool rn_first = false, rn_doH = false; int rn_liA = 0, rn_gA = 0, rn_gate = 0, rn_liB = 0, rn_gB = 0, rn_sc = 0, rn_sh = 0;
        switch (ph) {
        case 0: phase0(P, lds); break;
        case 1: phase_norm0(P); break;
        case 2: kind = 1; gA = (cbp)(ws + A_H); gB = (cbp)(ws + W_IN); gM = MT; gN = PJ; gK = 1024; gO = (bp)(ws + B_PROJ); gldc = PJ; break;
        case 3: phase_mla_prep(P); break;
        case 4: RG_EmQ(lds, (cbp)(ws + A_QLN), (cbp)(ws + W_UQ), MT, 768, 384, pg8::EmQ{(bp)(ws + R_Q), rmc, rms});
                RG_EmKV(lds, (cbp)(ws + A_CKV), (cbp)(ws + W_UKV), KR, 1024, 256, pg8::EmKV{(bp)(ws + R_KN), (bp)(ws + R_VTM)}); break;
        case 5: break;
        case 6: {
            const int xcd = (int)(__builtin_amdgcn_s_getreg((3 << 11) | 20) & 7u);
            for (int qq = 0; qq < 8; ++qq) {
                const int x = (xcd + qq) & 7;
                unsigned* qctr = ctl + 64 * x + 1024 * rep;
                for (int it = next_item(qctr, lds), pre = 0; it < 168; it = bcast_item(pre, lds)) {
                    if (threadIdx.x == 0) pre = (int)atomicAdd(qctr, 1u);
                    if (it < 8) { const int u = x * 8 + it; GLA(lds, P, false, u >> 3, (u >> 1) & 3, u & 1); }
                    else if (it >= 136 && it < 152) { const int u = x * 16 + (it - 136); GLA(lds, P, true, u >> 3, (u >> 1) & 3, u & 1); }
                    else { AttnArgs<0> A; A.Q = (const bf16*)(ws + R_Q); A.K = (const bf16*)(ws + R_KN); A.K2 = (const bf16*)(ws + R_KROPE); A.MIX = (bf16*)(ws + A_MIX); A.lam = 0.f; A.gout = nullptr;
                        if (it < 136) { const int j = it - 8, pair = (j >> 4) * 8 + x, b = pair >> 3, h = pair & 7, qb = j & 15;
                            A.VTh = (const bf16*)(ws + R_VTM) + (size_t)16 * 512 * 256 + (size_t)b * 512 * 4608 + (size_t)h * 64 * 4608;
                            A.row0 = MP + b * 4096 + qb * 256; A.krow0 = MP + b * 4608; A.Lk = 4608; A.h = h; }
                        else { const int u = x * 16 + (it - 152), b = u >> 3, h = u & 7;
                            A.VTh = (const bf16*)(ws + R_VTM) + (size_t)b * 512 * 256 + (size_t)h * 64 * 256;
                            A.row0 = b * 256; A.krow0 = b * 256; A.Lk = 256; A.h = h; }
                        ATT0(lds, A); }
                }
            }
        } break;
        case 7: phase_gla_fin(P); break;
        case 8: kind = 1; gA = (cbp)(ws + A_MIX); gB = (cbp)(ws + W_ABO); gM = MT; gN = 1024; gK = 1024; gO = (bp)(ws + R_OUT); gldc = 1024; break;
        case 9: kind = 2; rn_first = true; rn_liA = 0; rn_gA = 1; rn_gate = 2; rn_doH = true; rn_liB = 0; rn_gB = 2; rn_sc = 4; rn_sh = 3; break;
        case 10: kind = 3; gA = (cbp)(ws + A_H); gB = (cbp)(ws + W_F1); gM = MT; gN = 5632; gK = 1024; gO = (bp)(ws + B_FFNH); break;
        case 11: kind = 1; gA = (cbp)(ws + B_FFNH); gB = (cbp)(ws + W_F2); gM = MT; gN = 1024; gK = 2816; gO = (bp)(ws + R_OUT); gldc = 1024; break;
        case 12: kind = 2; rn_liA = 0; rn_gA = 3; rn_gate = 5; rn_doH = true; rn_liB = 1; rn_gB = 0; rn_sc = 1; rn_sh = 0; phase_diff_ctx(P); break;
        case 13: RG_EmQKV(lds, (cbp)(ws + A_H), (cbp)(ws + W_QKV), MT, 3072, 1024, pg8::EmQKV{(bp)(ws + B_QD), (bp)(ws + B_KD), (bp)(ws + R_VTD), P.outp() + O_DK, P.outp() + O_DV, rdc, rds}); break;
        case 14: {
            const float lam = *(const float*)(ws + WS_LAM);
            const int xcd = (int)(__builtin_amdgcn_s_getreg((3 << 11) | 20) & 7u);
            for (int qq = 0; qq < 8; ++qq) {
                const int x = (xcd + qq) & 7;
                unsigned* qctr = ctl + 512 + 64 * x + 1024 * rep;
                for (int it = next_item(qctr, lds), pre = 0; it < 288; it = bcast_item(pre, lds)) {
                    if (threadIdx.x == 0) pre = (int)atomicAdd(qctr, 1u);
                    AttnArgs<1> A; A.Q = (const bf16*)(ws + B_QD); A.K = (const bf16*)(ws + B_KD); A.K2 = nullptr; A.MIX = (bf16*)(ws + A_MIX); A.lam = lam; A.gout = P.inp(I_DGOUT);
                    if (it < 256) { const int pair = (it >> 5) * 8 + x, b = pair >> 3, h = pair & 7, qb = it & 31;
                        A.VTh = (const bf16*)(ws + R_VTD) + (size_t)16 * 1024 * 256 + (size_t)b * 1024 * 4608 + (size_t)h * 128 * 4608;
                        A.row0 = MP + b * 4096 + qb * 128; A.krow0 = MP + b * 4608; A.Lk = 4608; A.h = h; }
                    else { const int u = x * 32 + (it - 256), b = u >> 4, h = (u >> 1) & 7, qb = u & 1;
                        A.VTh = (const bf16*)(ws + R_VTD) + (size_t)b * 1024 * 256 + (size_t)h * 128 * 256;
                        A.row0 = b * 256 + qb * 128; A.krow0 = b * 256; A.Lk = 256; A.h = h; }
#ifdef UNIT_REP
                    ATT1(lds, A);
#endif
                    ATT1(lds, A);
                }
            }
        } break;
        case 15: kind = 1; gA = (cbp)(ws + A_MIX); gB = (cbp)(ws + W_CO); gM = MT; gN = 1024; gK = 1024; gO = (bp)(ws + R_OUT); gldc = 1024; break;
        case 16: kind = 2; rn_liA = 1; rn_gA = 1; rn_gate = 2; rn_doH = true; rn_liB = 1; rn_gB = 2; rn_sc = 4; rn_sh = 3; break;
        case 17: kind = 3; gA = (cbp)(ws + A_H); gB = (cbp)(ws + W_F1 + 11 * MiB); gM = MT; gN = 5632; gK = 1024; gO = (bp)(ws + B_FFNH); break;
        case 18: kind = 1; gA = (cbp)(ws + B_FFNH); gB = (cbp)(ws + W_F2 + (size_t)2816 * 1024 * 2); gM = MT; gN = 1024; gK = 2816; gO = (bp)(ws + R_OUT); gldc = 1024; break;
        default: kind = 2; rn_liA = 1; rn_gA = 3; rn_gate = 5; rn_doH = false; break;
        }
        if (kind == 1) RG_EmPlain(lds, gA, gB, gM, gN, gK, pg8::EmPlain{gO, gldc});
        else if (kind == 3) RG_EmFFN(lds, gA, gB, gM, gN, gK, pg8::EmFFN{gO});
        else if (kind == 2) phase_resnorm(P, rn_first, rn_liA, rn_gA, rn_gate, rn_doH, rn_liB, rn_gB, rn_sc, rn_sh);
        }
        if (ph + 1 < PH_HI && ph != 4) { if (ph == 0) grid.sync(); else xcd_barrier(xbar); }
#ifdef EXTRA_SYNCS
        if (ph == 1) { for (int es = 0; es < EXTRA_SYNCS; ++es) xcd_barrier(xbar); }
#endif
    }
}

extern "C" void kernel_launch(void* const* d_in, const int* in_sizes, int n_in, void* d_out, int out_size, void* d_ws, size_t ws_size, hipStream_t stream) {
    static int grid = 0;
    if (grid == 0) {
        if (n_in != 28 || ws_size < WS_END) { fprintf(stderr, "kernel_launch: unexpected n_in %d / ws_size %zu (need %zu)\n", n_in, ws_size, (size_t)WS_END); grid = -1; return; }
        int dev = 0, cus = 0, per_cu = 0;
        hipGetDevice(&dev); hipDeviceGetAttribute(&cus, hipDeviceAttributeMultiprocessorCount, dev);
        if (hipFuncSetAttribute((const void*)fwd_megakernel, hipFuncAttributeMaxDynamicSharedMemorySize, LDS_BYTES) != hipSuccess) { fprintf(stderr, "kernel_launch: hipFuncSetAttribute failed\n"); grid = -1; return; }
        if (hipOccupancyMaxActiveBlocksPerMultiprocessor(&per_cu, (const void*)fwd_megakernel, 512, LDS_BYTES) != hipSuccess || per_cu < 1) { fprintf(stderr, "kernel_launch: occupancy query says %d\n", per_cu); per_cu = 1; }
        (void)hipGetLastError();
        grid = cus * 1;
    }
    if (grid < 0) return;
    hipMemsetAsync((char*)d_ws + WS_CTL, 0, 32768, stream);
    ParamsK p{};
    for (int i = 0; i < 28; ++i) p.in[i] = (const float*)d_in[i];
    p.out = (float*)d_out; p.ws = (unsigned char*)d_ws;
    void* args[] = {&p};
    hipError_t e = hipLaunchCooperativeKernel((const void*)fwd_megakernel, dim3(grid), dim3(512), args, LDS_BYTES, stream);
    if (e != hipSuccess) fprintf(stderr, "cooperative launch failed: %s (grid %d)\n", hipGetErrorString(e), grid);
}
```

```cpp
#include <hip/hip_runtime.h>
#include <hip/hip_cooperative_groups.h>
#include <cstdio>
#include <cstdint>
namespace cg = cooperative_groups;
__device__ __forceinline__ int tid_opaque() { int t = threadIdx.x; asm volatile("" : "+v"(t)); return t; }
namespace pg8 {
#define PG8_LAS __attribute__((address_space(3)))
typedef unsigned short bf16_t;
typedef short bf16x8 __attribute__((ext_vector_type(8)));
typedef float f32x4 __attribute__((ext_vector_type(4)));
typedef unsigned u32x4 __attribute__((ext_vector_type(4)));
constexpr int BM = 256, BK = 64, HALF = 128, HTB = HALF * BK * 2  , STAGE_BYTES = 8 * HTB, NXCD = 8, WGM = 8;

__host__ __device__ __forceinline__ int lds_byte(int r, int c) { const int st = (r >> 4) * 2 + (c >> 5), rr = r & 15, cc = c & 31, ob = rr * 64 + cc * 2; return st * 1024 + (ob ^ (((ob >> 9) & 1) << 5)); }
__host__ __device__ __forceinline__ void stage_rc(int b, int& R, int& C) { const int st = b / 1024, sb = b % 1024, swz = sb ^ (((sb >> 9) & 1) << 5); R = (st >> 1) * 16 + swz / 64; C = (st & 1) * 32 + (swz % 64) / 2; }
__host__ __device__ __forceinline__ int perm32(int rho) { const int n = rho >> 4, i = rho & 15; return 8 * (i >> 2) + 4 * n + (i & 3); }

struct Unit { int pm, pn; };
struct Gemm { const bf16_t* A; const bf16_t* Bt; int M, N, K; };

struct StaticOrder {
    int nM, nN, nwg, G, c;
    __host__ __device__ void init(int M, int N, int G_, int c_) { nM = M / BM; nN = N / BM; nwg = nM * nN; G = G_; c = c_; }
    __host__ __device__ bool next(int i, Unit& u) const {
        const long L = (long)i * G + c; if (L >= nwg) return false;
        int wgid = (int)L; { const int q = nwg / NXCD, r = nwg % NXCD, xcd = wgid % NXCD, off = wgid / NXCD; wgid = (xcd < r ? xcd * (q + 1) : r * (q + 1) + (xcd - r) * q) + off; }
        const int nig = WGM * nN, gid = wgid / nig, fm = gid * WGM, gsz = (nM - fm) < WGM ? (nM - fm) : WGM;
        u.pm = fm + ((wgid % nig) % gsz); u.pn = (wgid % nig) / gsz; return true;
    }
    __device__ __forceinline__ void a_ready(const Unit&) const {}
    __device__ __forceinline__ void done(const Unit&) const {}
};

__device__ __forceinline__ unsigned cvt_pk_bf16(float lo, float hi) { unsigned r; asm volatile("v_cvt_pk_bf16_f32 %0, %1, %2" : "=v"(r) : "v"(lo), "v"(hi)); return r; }
typedef float f32x2 __attribute__((ext_vector_type(2)));
template <class Epi, class Sched, bool ALIGN_EPI = false, bool SP2 = false>
__device__ __forceinline__ void gemm_phase(PG8_LAS unsigned char* lds, const Gemm g, const Sched& S, const Epi& E) {
    const int tid = tid_opaque(), wid = __builtin_amdgcn_readfirstlane(tid >> 6), lane = tid & 63, wr = wid >> 2, wc = wid & 3, fr = lane & 15, fq = lane >> 4;
    const int K = g.K, nt = K / BK;
    unsigned voffA[2], voffB[2];
#pragma unroll
    for (int i = 0; i < 2; ++i) { int R, C; stage_rc(tid * 16 + i * 8192, R, C); const int Rb = Epi::PERM ? ((R & ~31) + perm32(R & 31)) : R;
        voffA[i] = (unsigned)(R * K + C) * 2u; voffB[i] = (unsigned)(Rb * K + C) * 2u; }
    const size_t kstep = (size_t)(BK * 2);
    const size_t hstep = (size_t)HALF * K * 2;
    const size_t tstep = 2 * hstep;
    const unsigned ldsw = (unsigned)wid * 1024u;
    const int aoff = lds_byte(wr * 64 + fr, fq * 8), boff = lds_byte(wc * 32 + fr, fq * 8);
#define PG8_SA(b, h) (((b) * 2 + (h)) * HTB)
#define PG8_SB(b, h) ((4 + (b) * 2 + (h)) * HTB)
#define PG8_STAGE(bufoff, gbase, voff) do { _Pragma("unroll") for (int _i = 0; _i < 2; ++_i) \
        __builtin_amdgcn_global_load_lds((const unsigned*)((const char*)(gbase) + (voff)[_i]), (PG8_LAS unsigned*)(lds + (bufoff) + ldsw + _i * 8192), 16, 0, 0); } while (0)
#define PG8_LDA(dst, b, h) do { _Pragma("unroll") for (int m = 0; m < 4; ++m) _Pragma("unroll") for (int k = 0; k < 2; ++k) dst[m][k] = *(const PG8_LAS bf16x8*)(lds + PG8_SA(b, h) + aoff + m * 2048 + k * 1024); } while (0)
#define PG8_LDB(dst, b, h) do { _Pragma("unroll") for (int n = 0; n < 2; ++n) _Pragma("unroll") for (int k = 0; k < 2; ++k) dst[n][k] = *(const PG8_LAS bf16x8*)(lds + PG8_SB(b, h) + boff + n * 2048 + k * 1024); } while (0)
#define PG8_MMA(ai, bj, At, Bt) do { __builtin_amdgcn_s_setprio(1); _Pragma("unroll") for (int m = 0; m < 4; ++m) _Pragma("unroll") for (int n = 0; n < 2; ++n) _Pragma("unroll") for (int k = 0; k < 2; ++k) \
        acc[ai][bj][m][n] = __builtin_amdgcn_mfma_f32_16x16x32_bf16(Bt[n][k], At[m][k], acc[ai][bj][m][n], 0, 0, 0); __builtin_amdgcn_s_setprio(0); } while (0)
#define PG8_WAIT_V(n) asm volatile("s_waitcnt vmcnt(" #n ")" ::: "memory")
#define PG8_WAIT_L(n) asm volatile("s_waitcnt lgkmcnt(" #n ")" ::: "memory")
#define PG8_BAR __builtin_amdgcn_s_barrier()
#define PG8_SCHED __builtin_amdgcn_sched_barrier(0)
    Unit cur, nxt; int ui = 0;
    if (!S.next(0, cur)) return;
    f32x4 acc[2][2][4][2];
#pragma unroll
    for (int a = 0; a < 2; ++a)
#pragma unroll
        for (int b = 0; b < 2; ++b)
#pragma unroll
            for (int m = 0; m < 4; ++m)
#pragma unroll
                for (int n = 0; n < 2; ++n) acc[a][b][m][n] = (f32x4){0.f, 0.f, 0.f, 0.f};
    bf16x8 At[4][2], B0[2][2], B1[2][2];
    const char* cA = (const char*)g.A + (size_t)cur.pm * tstep; const char* cB = (const char*)g.Bt + (size_t)cur.pn * tstep;
    S.a_ready(cur);
    if constexpr (SP2) {
        PG8_STAGE(PG8_SB(0, 0), cB, voffB); PG8_STAGE(PG8_SB(0, 1), cB + hstep, voffB); PG8_STAGE(PG8_SA(0, 0), cA, voffA); PG8_STAGE(PG8_SA(0, 1), cA + hstep, voffA);
        if (wr == 1) PG8_BAR;
        PG8_WAIT_V(2); PG8_BAR;
        PG8_STAGE(PG8_SB(1, 0), cB + kstep, voffB); PG8_STAGE(PG8_SA(1, 0), cA + kstep, voffA); PG8_STAGE(PG8_SB(1, 1), cB + hstep + kstep, voffB);
        PG8_WAIT_V(6); PG8_BAR;
    } else {
        PG8_STAGE(PG8_SB(0, 0), cB, voffB); PG8_STAGE(PG8_SA(0, 0), cA, voffA); PG8_STAGE(PG8_SB(0, 1), cB + hstep, voffB); PG8_STAGE(PG8_SA(0, 1), cA + hstep, voffA);
        if (wr == 1) PG8_BAR;
        PG8_WAIT_V(4); PG8_BAR;
        PG8_STAGE(PG8_SB(1, 0), cB + kstep, voffB); PG8_STAGE(PG8_SA(1, 0), cA + kstep, voffA); PG8_STAGE(PG8_SB(1, 1), cB + hstep + kstep, voffB);
        PG8_WAIT_V(6); PG8_BAR;
    }
    for (;;) {
        const bool has_next = S.next(ui + 1, nxt);
        const char* nA = has_next ? (const char*)g.A + (size_t)nxt.pm * tstep : cA; const char* nB = has_next ? (const char*)g.Bt + (size_t)nxt.pn * tstep : cB;
        for (int t = 0; t < nt; t += 2) {
            const bool last = (t == nt - 2);
            const char* a1 = cA + (size_t)(t + 1) * kstep;
            const char* a2 = last ? nA : cA + (size_t)(t + 2) * kstep; const char* b2 = last ? nB : cB + (size_t)(t + 2) * kstep;
            const char* a3 = a2 + kstep; const char* b3 = b2 + kstep;
            if (last && has_next) S.a_ready(nxt);
            if constexpr (SP2) {
            PG8_LDB(B0, 0, 0); PG8_LDB(B1, 0, 1); PG8_SCHED; PG8_LDA(At, 0, 0); PG8_STAGE(PG8_SA(1, 1), a1 + hstep, voffA);
            PG8_WAIT_V(8); PG8_WAIT_L(0); PG8_BAR; PG8_MMA(0, 0, At, B0); PG8_MMA(0, 1, At, B1); PG8_BAR; PG8_SCHED;
            PG8_LDA(At, 0, 1); PG8_STAGE(PG8_SB(0, 0), b2, voffB); PG8_STAGE(PG8_SB(0, 1), b2 + hstep, voffB); PG8_STAGE(PG8_SA(0, 0), a2, voffA);
            PG8_WAIT_V(8); PG8_WAIT_L(0); PG8_BAR; PG8_MMA(1, 0, At, B0); PG8_MMA(1, 1, At, B1); PG8_BAR; PG8_SCHED;
            PG8_LDB(B0, 1, 0); PG8_LDB(B1, 1, 1); PG8_SCHED; PG8_LDA(At, 1, 0); PG8_STAGE(PG8_SA(0, 1), a2 + hstep, voffA);
            PG8_WAIT_V(8); PG8_WAIT_L(0); PG8_BAR; PG8_MMA(0, 0, At, B0); PG8_MMA(0, 1, At, B1); PG8_BAR; PG8_SCHED;
            PG8_LDA(At, 1, 1); PG8_STAGE(PG8_SB(1, 0), b3, voffB); PG8_STAGE(PG8_SB(1, 1), b3 + hstep, voffB); PG8_STAGE(PG8_SA(1, 0), a3, voffA);
            PG8_WAIT_V(8); PG8_WAIT_L(0); PG8_BAR; PG8_MMA(1, 0, At, B0); PG8_MMA(1, 1, At, B1); PG8_BAR; PG8_SCHED;
            } else {
            PG8_LDB(B0, 0, 0); PG8_SCHED; PG8_LDA(At, 0, 0); PG8_STAGE(PG8_SA(1, 1), a1 + hstep, voffA);
            PG8_WAIT_L(8); PG8_BAR; PG8_WAIT_L(0); PG8_MMA(0, 0, At, B0); PG8_BAR; PG8_SCHED;
            PG8_LDB(B1, 0, 1); PG8_STAGE(PG8_SB(0, 0), b2, voffB);
            PG8_BAR; PG8_WAIT_L(0); PG8_MMA(0, 1, At, B1); PG8_BAR;
            PG8_LDA(At, 0, 1); PG8_STAGE(PG8_SA(0, 0), a2, voffA);
            PG8_BAR; PG8_WAIT_L(0); PG8_MMA(1, 0, At, B0); PG8_BAR; PG8_SCHED;
            PG8_STAGE(PG8_SB(0, 1), b2 + hstep, voffB);
            PG8_WAIT_V(6); PG8_BAR; PG8_MMA(1, 1, At, B1); PG8_BAR;
            PG8_LDB(B0, 1, 0); PG8_SCHED; PG8_LDA(At, 1, 0); PG8_STAGE(PG8_SA(0, 1), a2 + hstep, voffA);
            PG8_WAIT_L(8); PG8_BAR; PG8_WAIT_L(0); PG8_MMA(0, 0, At, B0); PG8_BAR; PG8_SCHED;
            PG8_LDB(B1, 1, 1); PG8_STAGE(PG8_SB(1, 0), b3, voffB);
            PG8_BAR; PG8_WAIT_L(0); PG8_MMA(0, 1, At, B1); PG8_BAR;
            PG8_LDA(At, 1, 1); PG8_STAGE(PG8_SA(1, 0), a3, voffA);
            PG8_BAR; PG8_WAIT_L(0); PG8_MMA(1, 0, At, B0); PG8_BAR; PG8_SCHED;
            PG8_STAGE(PG8_SB(1, 1), b3 + hstep, voffB);
            PG8_WAIT_V(6); PG8_BAR; PG8_MMA(1, 1, At, B1); PG8_BAR;
            }
        }
        if constexpr (ALIGN_EPI) { if (wr == 0) PG8_BAR; }
        if constexpr (!Epi::AFTER_DRAIN) { E(acc, cur, wr, wc, fr, fq); S.done(cur); }
        if (!has_next) break;
#pragma unroll
        for (int a = 0; a < 2; ++a)
#pragma unroll
            for (int b = 0; b < 2; ++b)
#pragma unroll
                for (int m = 0; m < 4; ++m)
#pragma unroll
                    for (int n = 0; n < 2; ++n) acc[a][b][m][n] = (f32x4){0.f, 0.f, 0.f, 0.f};
        cur = nxt; cA = nA; cB = nB; ++ui;
        if constexpr (ALIGN_EPI) { if (wr == 1) PG8_BAR; }
    }
    PG8_WAIT_V(0);
    if constexpr (!ALIGN_EPI) { if (wr == 0) PG8_BAR; }
    PG8_BAR;
    if constexpr (Epi::AFTER_DRAIN) { E.fused(acc, cur, wr, wc, fr, fq, lds, wid, lane); S.done(cur); }
#undef PG8_SA
#undef PG8_SB
#undef PG8_STAGE
#undef PG8_LDA
#undef PG8_LDB
#undef PG8_MMA
#undef PG8_WAIT_V
#undef PG8_WAIT_L
#undef PG8_BAR
#undef PG8_SCHED
}
}

#define LAS __attribute__((address_space(3)))
typedef LAS unsigned char* ldsp;
typedef unsigned short bf16;
typedef float f32x4 __attribute__((ext_vector_type(4)));
typedef float f32x2 __attribute__((ext_vector_type(2)));
typedef float f32x16 __attribute__((ext_vector_type(16)));
typedef short bf16x8 __attribute__((ext_vector_type(8)));
typedef short s16x4 __attribute__((ext_vector_type(4)));
typedef unsigned u32x4 __attribute__((ext_vector_type(4)));
typedef unsigned u32x2 __attribute__((ext_vector_type(2)));

constexpr int DM = 1024, MP = 4096, MS = 32768, MT = MP + MS, KR = 4096 + 8 * 4608;
constexpr int FFH = 2816, PJ = 2816;
constexpr float EPS = 1e-6f;
constexpr float LAM_INIT = 0.35550907f;
constexpr int C_QLAT = 0, C_KVLAT = 384, C_KROPE = 640, C_GQ = 672, C_GK = 1184, C_GV = 1696, C_GGATE = 2208, C_GOUT = 2240;

constexpr size_t MiB = 1u << 20;
constexpr size_t WS_CTL = 0, WS_MOD = 1 * MiB, WS_ROPE = 2 * MiB, WS_W = 4 * MiB;
constexpr size_t WS_RM_COS = WS_ROPE, WS_RM_SIN = WS_ROPE + 256 * 1024, WS_RD_COS = WS_ROPE + 512 * 1024, WS_RD_SIN = WS_ROPE + 1024 * 1024, WS_LAM = WS_ROPE + 1536 * 1024;
constexpr size_t W_IN = WS_W, W_UQ = W_IN + (size_t)2816 * 1024 * 2, W_UKV = W_UQ + (size_t)768 * 384 * 2, W_ABO = W_UKV + (size_t)1024 * 256 * 2,
                 W_QKV = W_ABO + 2 * MiB, W_CO = W_QKV + 6 * MiB, W_F1 = W_CO + 2 * MiB, W_F2 = W_F1 + 22 * MiB, W_END = W_F2 + 11 * MiB;
constexpr size_t WS_A = 54 * MiB, WS_B = 126 * MiB, WS_C = 324 * MiB, WS_END = 476 * MiB;
static_assert(W_END <= WS_A, "weights fit");
constexpr size_t A_H = WS_A, A_MIX = WS_A, A_QLN = WS_A, A_CKV = WS_A + 28 * MiB;
constexpr size_t B_PROJ = WS_B, B_FFNH = WS_B, B_QD = WS_B, B_KD = WS_B + 72 * MiB;
constexpr size_t R_OUT = WS_C, R_Q = WS_C, R_KN = WS_C + 54 * MiB, R_KROPE = WS_C + 94 * MiB, R_VTM = WS_C + 97 * MiB, R_VTD = WS_C + 72 * MiB;

struct ParamsK {
    const float* in[28];
    float* out;
    unsigned char* ws;
};
struct Params {
    const __attribute__((address_space(4))) char* kp;
    __device__ __forceinline__ const float* inp(int i) const {
#if defined(__HIP_DEVICE_COMPILE__)
        return *(const float* const __attribute__((address_space(4)))*)(kp + 8 * i);
#else
        return nullptr;
#endif
    }
    __device__ __forceinline__ float* outp() const {
#if defined(__HIP_DEVICE_COMPILE__)
        return *(float* const __attribute__((address_space(4)))*)(kp + 8 * 28);
#else
        return nullptr;
#endif
    }
    __device__ __forceinline__ unsigned char* wsp() const {
#if defined(__HIP_DEVICE_COMPILE__)
        return *(unsigned char* const __attribute__((address_space(4)))*)(kp + 8 * 29);
#else
        return nullptr;
#endif
    }
};
enum { I_XP = 0, I_XS, I_CKV, I_CKROPE, I_SF, I_SB, I_CDK, I_CDV, I_C, I_CCTX, I_WMOD, I_BMOD, I_GNORM, I_ABWIN, I_GQ, I_GKV, I_WUQ, I_WUKV, I_WGATE, I_BGATE, I_GGOUT, I_ABWOUT,
       I_CWQKV, I_DLAM, I_DGOUT, I_CWOUT, I_WF1, I_WF2 };
constexpr size_t O_Y = 0, O_CKV = (size_t)MT * 1024, O_KROPE = O_CKV + (size_t)4096 * 256, O_GF = O_KROPE + (size_t)4096 * 32, O_GB = O_GF + (size_t)16 * 4 * 128 * 128,
                 O_DK = O_GB + (size_t)16 * 4 * 128 * 128, O_DV = O_DK + (size_t)4096 * 1024;

typedef float f32x2_cv __attribute__((ext_vector_type(2))); typedef __bf16 bf16x2_cv __attribute__((ext_vector_type(2)));
__device__ __forceinline__ unsigned pkbf(float lo, float hi) { f32x2_cv v = {lo, hi}; bf16x2_cv b = __builtin_convertvector(v, bf16x2_cv); return __builtin_bit_cast(unsigned, b); }
__device__ __forceinline__ float bf_lo(unsigned w) { return __uint_as_float(w << 16); }
__device__ __forceinline__ float bf_hi(unsigned w) { return __uint_as_float(w & 0xffff0000u); }
__device__ __forceinline__ float bf1(bf16 v) { return __uint_as_float((unsigned)v << 16); }
__device__ __forceinline__ bf16 tobf(float f) { return (bf16)(pkbf(f, 0.f) & 0xffffu); }
__device__ __forceinline__ float wave_sum(float v) {
#pragma unroll
    for (int o = 1; o < 64; o <<= 1) v += __shfl_xor(v, o);
    return v;
}
__device__ __forceinline__ float fast_exp2(float x) { return __builtin_amdgcn_exp2f(x); }
__device__ __forceinline__ float fast_rcp(float x) { return __builtin_amdgcn_rcpf(x); }
__device__ __forceinline__ float silu_f(float g) { return g * fast_rcp(1.f + fast_exp2(-1.4426950408889634f * g)); }
__device__ __forceinline__ int key_row(int row) { if (row < MP) return row; const int r = row - MP; return MP + (r >> 12) * 4608 + 512 + (r & 4095); }
__device__ __forceinline__ void vt_pos(int krow, int HD, size_t& base, int& pos, int& Lk) {
    if (krow < MP) { const int kb = krow >> 8; pos = krow & 255; Lk = 256; base = (size_t)kb * HD * 256; }
    else { const int r = krow - MP, b = r / 4608; pos = r - b * 4608; Lk = 4608; base = (size_t)16 * HD * 256 + (size_t)b * HD * 4608; }
}
__device__ __forceinline__ const float* xrow_in(const Params& P, int row) { return row < MP ? P.inp(I_XP) + (size_t)row * DM : P.inp(I_XS) + (size_t)(row - MP) * DM; }
__device__ __forceinline__ int cond_of(int row) { return row < MP ? 0 : 1 + ((row - MP) >> 12); }

namespace pg8 {
template <class F> struct Epi8 {
    static constexpr bool PERM = true, AFTER_DRAIN = false; F f;
    __device__ __forceinline__ void operator()(const f32x4 (&acc)[2][2][4][2], const Unit& u, int wr, int wc, int fr, int fq) const {
        const int row0 = u.pm * BM + wr * 64 + fr, col0 = u.pn * BM + wc * 32 + 8 * fq;
#pragma unroll
        for (int ai = 0; ai < 2; ++ai)
#pragma unroll
            for (int m = 0; m < 4; ++m)
#pragma unroll
                for (int bj = 0; bj < 2; ++bj) { f(row0 + ai * HALF + m * 16, col0 + bj * HALF, acc[ai][bj][m][0], acc[ai][bj][m][1]); asm volatile("" ::: "memory"); }
    }
};
__device__ __forceinline__ ::u32x4 pack8(::f32x4 v0, ::f32x4 v1) { ::u32x4 w; w.x = pkbf(v0[0], v0[1]); w.y = pkbf(v0[2], v0[3]); w.z = pkbf(v1[0], v1[1]); w.w = pkbf(v1[2], v1[3]); return w; }
__device__ __forceinline__ void rot8(::f32x4& v0, ::f32x4& v1, const float* cs, const float* sn) {
    const ::f32x4 c = *(const ::f32x4*)cs, s = *(const ::f32x4*)sn;
    ::f32x4 a, b;
    a[0] = v0[0] * c[0] - v0[1] * s[0]; a[1] = v0[0] * s[0] + v0[1] * c[0];
    a[2] = v0[2] * c[1] - v0[3] * s[1]; a[3] = v0[2] * s[1] + v0[3] * c[1];
    b[0] = v1[0] * c[2] - v1[1] * s[2]; b[1] = v1[0] * s[2] + v1[1] * c[2];
    b[2] = v1[2] * c[3] - v1[3] * s[3]; b[3] = v1[2] * s[3] + v1[3] * c[3];
    v0 = a; v1 = b;
}
struct EmPlain { bf16_t* O; int ldc;
    __device__ __forceinline__ void operator()(int row, int col, ::f32x4 v0, ::f32x4 v1) const { *(::u32x4*)(O + (size_t)row * ldc + col) = pack8(v0, v1); } };
struct EmQ { bf16_t* Q; const float* rc; const float* rs;
    __device__ __forceinline__ void operator()(int row, int col, ::f32x4 v0, ::f32x4 v1) const {
        const int o = col % 96;
        if (o >= 64 && row >= MP) { const int t = (row - MP) & 4095, p0 = (o - 64) >> 1; rot8(v0, v1, rc + t * 16 + p0, rs + t * 16 + p0); }
        *(::u32x4*)(Q + (size_t)row * 768 + col) = pack8(v0, v1); } };
struct EmKV { bf16_t* KN; bf16_t* VT;
    __device__ __forceinline__ void operator()(int row, int col, ::f32x4 v0, ::f32x4 v1) const {
        const int h = col >> 7, o = col & 127;
        if (o < 64) { *(::u32x4*)(KN + (size_t)row * 512 + h * 64 + o) = pack8(v0, v1); }
        else { size_t base; int pos, Lk; vt_pos(row, 512, base, pos, Lk); bf16_t* p = VT + base + (size_t)(h * 64 + o - 64) * Lk + pos;
            const ::u32x4 w = pack8(v0, v1);
            p[0] = (bf16_t)(w.x & 0xffff); p[(size_t)Lk] = (bf16_t)(w.x >> 16); p[(size_t)2 * Lk] = (bf16_t)(w.y & 0xffff); p[(size_t)3 * Lk] = (bf16_t)(w.y >> 16);
            p[(size_t)4 * Lk] = (bf16_t)(w.z & 0xffff); p[(size_t)5 * Lk] = (bf16_t)(w.z >> 16); p[(size_t)6 * Lk] = (bf16_t)(w.w & 0xffff); p[(size_t)7 * Lk] = (bf16_t)(w.w >> 16); } } };
struct EmFFN { bf16_t* O;
    __device__ __forceinline__ void operator()(int row, int col, ::f32x4 v0, ::f32x4 v1) const {
        ::u32x2 w; w.x = pkbf(silu_f(v0[0]) * v1[0], silu_f(v0[1]) * v1[1]); w.y = pkbf(silu_f(v0[2]) * v1[2], silu_f(v0[3]) * v1[3]);
        *(::u32x2*)(O + (size_t)row * FFH + (col >> 1)) = w; } };
struct EmQKV { bf16_t* QD; bf16_t* KD; bf16_t* VT; float* odk; float* odv; const float* rc; const float* rs;
    __device__ __forceinline__ void operator()(int row, int col, ::f32x4 v0, ::f32x4 v1) const {
        if (col < 2048) {
            const int cc = col & 1023;
            if (col >= 1024 && row < MP) { float* o = odk + (size_t)row * 1024 + cc; *(::f32x4*)o = v0; *(::f32x4*)(o + 4) = v1; }
            if (row >= MP) { const int t = (row - MP) & 4095, p0 = (cc & 63) >> 1; rot8(v0, v1, rc + t * 32 + p0, rs + t * 32 + p0); }
            if (col < 1024) *(::u32x4*)(QD + (size_t)row * 1024 + cc) = pack8(v0, v1);
            else *(::u32x4*)(KD + (size_t)key_row(row) * 1024 + cc) = pack8(v0, v1);
        } else {
            const int cc = col - 2048;
            if (row < MP) { float* o = odv + (size_t)row * 1024 + cc; *(::f32x4*)o = v0; *(::f32x4*)(o + 4) = v1; }
            size_t base; int pos, Lk; vt_pos(key_row(row), 1024, base, pos, Lk); bf16_t* p = VT + base + (size_t)cc * Lk + pos;
            const ::u32x4 w = pack8(v0, v1);
            p[0] = (bf16_t)(w.x & 0xffff); p[(size_t)Lk] = (bf16_t)(w.x >> 16); p[(size_t)2 * Lk] = (bf16_t)(w.y & 0xffff); p[(size_t)3 * Lk] = (bf16_t)(w.y >> 16);
            p[(size_t)4 * Lk] = (bf16_t)(w.z & 0xffff); p[(size_t)5 * Lk] = (bf16_t)(w.z >> 16); p[(size_t)6 * Lk] = (bf16_t)(w.w & 0xffff); p[(size_t)7 * Lk] = (bf16_t)(w.w >> 16);
        } } };
template <class F> __device__ __forceinline__ void run_gemm(PG8_LAS unsigned char* lds, const bf16_t* A, const bf16_t* Bt, int M, int N, int K, const F& f) {
    asm volatile("" : "+s"(M), "+s"(N), "+s"(K));
    Gemm g{A, Bt, M, N, K}; StaticOrder S; S.init(M, N, (int)gridDim.x, (int)blockIdx.x);
    Epi8<F> E{f};
    gemm_phase<Epi8<F>, StaticOrder, true, true>(lds, g, S, E);
}
}

template <int MAPMODE> __device__ __forceinline__ int wrow_map(int n) {
    if (MAPMODE == 1) { return n < FFH ? 8 * (n >> 2) + (n & 3) : 8 * ((n - FFH) >> 2) + 4 + ((n - FFH) & 3); }
    return n;
}
template <int MAPMODE> __device__ __forceinline__ void transpose_item(const float* W, int K, int N, bf16* WT, LAS float* scr, int item, int lane) {
    const int nblk = N / 32, kb = item / nblk, nb = item % nblk, k0 = 64 * kb, n0 = 32 * nb;
#pragma unroll 8
    for (int i = 0; i < 32; ++i) { const int kk = 2 * i + (lane >> 5); scr[kk * 33 + (lane & 31)] = W[(size_t)(k0 + kk) * N + n0 + (lane & 31)]; }
    asm volatile("s_waitcnt lgkmcnt(0)" ::: "memory");
    const int c = lane & 7;
#pragma unroll
    for (int j = 0; j < 4; ++j) { const int n = (lane >> 3) + 8 * j; const LAS float* s = scr + (8 * c) * 33 + n;
        u32x4 o; o.x = pkbf(s[0 * 33], s[1 * 33]); o.y = pkbf(s[2 * 33], s[3 * 33]); o.z = pkbf(s[4 * 33], s[5 * 33]); o.w = pkbf(s[6 * 33], s[7 * 33]);
        *(u32x4*)(WT + (size_t)wrow_map<MAPMODE>(n0 + n) * K + k0 + 8 * c) = o; }
    asm volatile("s_waitcnt lgkmcnt(0)" ::: "memory");
}

__device__ __forceinline__ void phase0(const Params& P, ldsp lds) {
    const int tid = tid_opaque(), lane = tid & 63, wave = tid >> 6, G = gridDim.x, bid = blockIdx.x;
    unsigned char* ws = P.wsp();
    {
        LAS float* sc = (LAS float*)lds;
        LAS float* red = (LAS float*)(lds + 9 * 1024 * 4);
        for (int e = tid; e < 9 * 1024; e += 512) { const int ci = e >> 10, k = e & 1023; const float v = ci == 0 ? P.inp(I_CCTX)[k] : P.inp(I_C)[(ci - 1) * 1024 + k]; sc[e] = silu_f(v); }
        __syncthreads();
        float* MOD = (float*)(ws + WS_MOD);
        for (int item = bid; item < 192; item += G) {
            const int li = item / 96, j0 = (item % 96) * 64;
            const float* wm = P.inp(I_WMOD) + (size_t)li * 1024 * 6144 + j0 + lane;
            float acc[9];
#pragma unroll
            for (int c = 0; c < 9; ++c) acc[c] = 0.f;
            const int kbeg = wave * 128;
#pragma unroll 4
            for (int k = kbeg; k < kbeg + 128; ++k) { const float wv = wm[(size_t)k * 6144];
#pragma unroll
                for (int c = 0; c < 9; ++c) acc[c] += sc[c * 1024 + k] * wv; }
#pragma unroll
            for (int c = 0; c < 9; ++c) red[(wave * 9 + c) * 64 + lane] = acc[c];
            __syncthreads();
            for (int e = tid; e < 576; e += 512) { const int c = e >> 6, l = e & 63; float s = 0.f;
#pragma unroll
                for (int w = 0; w < 8; ++w) s += red[(w * 9 + c) * 64 + l];
                MOD[((size_t)li * 9 + c) * 6144 + j0 + l] = s + P.inp(I_BMOD)[li * 6144 + j0 + l]; }
            __syncthreads();
        }
    }
    __syncthreads();
    {
        LAS float* scr = (LAS float*)(lds + wave * 16384);
        const int gw = bid * 8 + wave, NGW = G * 8;
        constexpr int I1 = 16 * 86, I2 = 6 * 24, I3 = 4 * 32, I4 = 16 * 32, I5 = 16 * 96, I6 = 16 * 32, I7 = 16 * 176, I8 = 44 * 32;
        constexpr int NIT = I1 + I2 + I3 + I4 + I5 + I6 + 2 * I7 + 2 * I8;
        for (int it = gw; it < NIT; it += NGW) {
            int r = it;
            if (r < I1) { transpose_item<0>(P.inp(I_ABWIN), 1024, 2752, (bf16*)(ws + W_IN), scr, r, lane); continue; } r -= I1;
            if (r < I2) { transpose_item<0>(P.inp(I_WUQ), 384, 768, (bf16*)(ws + W_UQ), scr, r, lane); continue; } r -= I2;
            if (r < I3) { transpose_item<0>(P.inp(I_WUKV), 256, 1024, (bf16*)(ws + W_UKV), scr, r, lane); continue; } r -= I3;
            if (r < I4) { transpose_item<0>(P.inp(I_ABWOUT), 1024, 1024, (bf16*)(ws + W_ABO), scr, r, lane); continue; } r -= I4;
            if (r < I5) { transpose_item<0>(P.inp(I_CWQKV), 1024, 3072, (bf16*)(ws + W_QKV), scr, r, lane); continue; } r -= I5;
            if (r < I6) { transpose_item<0>(P.inp(I_CWOUT), 1024, 1024, (bf16*)(ws + W_CO), scr, r, lane); continue; } r -= I6;
            if (r < 2 * I7) { const int li = r / I7; transpose_item<1>(P.inp(I_WF1) + (size_t)li * 1024 * 5632, 1024, 5632, (bf16*)(ws + W_F1 + (size_t)li * 11 * MiB), scr, r % I7, lane); continue; } r -= 2 * I7;
            { const int li = r / I8; transpose_item<0>(P.inp(I_WF2) + (size_t)li * 2816 * 1024, 2816, 1024, (bf16*)(ws + W_F2 + (size_t)li * 2816 * 1024 * 2), scr, r % I8, lane); }
        }
    }
    const int gt = bid * 512 + tid, NT = G * 512;
    { u32x4* z = (u32x4*)(ws + W_IN + (size_t)2752 * 1024 * 2); for (int e = gt; e < 64 * 1024 * 2 / 16; e += NT) z[e] = (u32x4){0u, 0u, 0u, 0u}; }
    {
        float* rmc = (float*)(ws + WS_RM_COS); float* rms = (float*)(ws + WS_RM_SIN); float* rdc = (float*)(ws + WS_RD_COS); float* rds = (float*)(ws + WS_RD_SIN);
        for (int e = gt; e < 4096 * 16 + 4096 * 32; e += NT) {
            const bool isd = e >= 4096 * 16; const int ee = isd ? e - 4096 * 16 : e; const int np = isd ? 32 : 16, nf = np >> 1;
            const int t = ee / np, p = ee % np; const int fi = p % nf; const float posv = (float)(p < nf ? (t >> 6) : (t & 63));
            const float inv = exp2f(-(float)fi / (float)nf * 13.287712379549449f);
            const float ang = posv * inv; float rev = ang * 0.15915494309189535f; rev -= rintf(rev);
            const float sn = __builtin_amdgcn_sinf(rev), cs = __builtin_amdgcn_cosf(rev);
            if (isd) { rdc[ee] = cs; rds[ee] = sn; } else { rmc[ee] = cs; rms[ee] = sn; }
        }
    }
    if (bid == 0 && wave == 0) {
        const float* lp = P.inp(I_DLAM);
        const float a = wave_sum(lp[lane] * lp[64 + lane]), b = wave_sum(lp[128 + lane] * lp[192 + lane]);
        if (lane == 0) *(float*)(ws + WS_LAM) = __expf(a) - __expf(b) + LAM_INIT;
    }
}

__device__ __forceinline__ void norm_mod_store(const f32x4 (&v)[4], float ss, const float* g, const float* scale, const float* shift, bf16* hrow, int lane) {
    const float r = 1.f / sqrtf(ss * (1.f / 1024.f) + EPS);
#pragma unroll
    for (int j = 0; j < 4; ++j) { const int c = 4 * lane + 256 * j;
        const f32x4 gg = *(const f32x4*)(g + c), sc = *(const f32x4*)(scale + c), sh = *(const f32x4*)(shift + c);
        const f32x4 h = v[j] * r * gg * (sc + 1.f) + sh;
        u32x2 w; w.x = pkbf(h[0], h[1]); w.y = pkbf(h[2], h[3]); *(u32x2*)(hrow + c) = w; }
}
__device__ __forceinline__ void phase_norm0(const Params& P) {
    const int tid = tid_opaque(), lane = tid & 63, gw = blockIdx.x * 8 + (tid >> 6), NGW = gridDim.x * 8;
    const float* MOD = (const float*)(P.wsp() + WS_MOD); bf16* H = (bf16*)(P.wsp() + A_H);
    constexpr int NR = 3;
    for (int row0 = gw; row0 < MT; row0 += NR * NGW) {
        f32x4 v[NR][4]; float ss[NR];
#pragma unroll
        for (int u = 0; u < NR; ++u) { ss[u] = 0.f; const int row = row0 + u * NGW; if (row >= MT) break; const float* x = xrow_in(P, row);
#pragma unroll
            for (int j = 0; j < 4; ++j) v[u][j] = *(const f32x4*)(x + 4 * lane + 256 * j); }
#pragma unroll
        for (int u = 0; u < NR; ++u) { if (row0 + u * NGW >= MT) break;
#pragma unroll
            for (int j = 0; j < 4; ++j) ss[u] += v[u][j][0] * v[u][j][0] + v[u][j][1] * v[u][j][1] + v[u][j][2] * v[u][j][2] + v[u][j][3] * v[u][j][3]; }
#pragma unroll
        for (int off = 1; off < 64; off <<= 1) {
#pragma unroll
            for (int u = 0; u < NR; ++u) ss[u] += __shfl_xor(ss[u], off); }
#pragma unroll
        for (int u = 0; u < NR; ++u) { const int row = row0 + u * NGW; if (row >= MT) break; const float* md = MOD + (size_t)(0 * 9 + cond_of(row)) * 6144;
            norm_mod_store(v[u], ss[u], P.inp(I_GNORM) + 0, md + 1024, md + 0, H + (size_t)row * DM, lane); }
    }
}
__device__ __forceinline__ void phase_resnorm(const Params& P, bool first, int liA, int gA, int gateIdx, bool doH, int liB, int gB, int scaleIdx, int shiftIdx) {
    const int tid = tid_opaque(), lane = tid & 63, gw = blockIdx.x * 8 + (tid >> 6), NGW = gridDim.x * 8;
    const float* MOD = (const float*)(P.wsp() + WS_MOD); bf16* H = (bf16*)(P.wsp() + A_H); const bf16* OUT = (const bf16*)(P.wsp() + R_OUT);
    float* X = P.outp() + O_Y;
    const float* ga = P.inp(I_GNORM) + (liA * 4 + gA) * 1024;
    constexpr int NR = 3;
    for (int row0 = gw; row0 < MT; row0 += NR * NGW) {
        int rows[NR];
#pragma unroll
        for (int u = 0; u < NR; ++u) rows[u] = row0 + u * NGW;
        f32x4 o[NR][4], v[NR][4]; float so[NR];
#pragma unroll
        for (int u = 0; u < NR; ++u) so[u] = 0.f;
#pragma unroll
        for (int u = 0; u < NR; ++u) { if (rows[u] >= MT) break; const int row = rows[u];
            const float* xo = first ? xrow_in(P, row) : X + (size_t)row * DM;
#pragma unroll
            for (int j = 0; j < 4; ++j) { const u32x2 w = *(const u32x2*)(OUT + (size_t)row * DM + 4 * lane + 256 * j);
                o[u][j] = (f32x4){bf_lo(w.x), bf_hi(w.x), bf_lo(w.y), bf_hi(w.y)}; v[u][j] = *(const f32x4*)(xo + 4 * lane + 256 * j); } }
#pragma unroll
        for (int u = 0; u < NR; ++u) { if (rows[u] >= MT) break;
#pragma unroll
            for (int j = 0; j < 4; ++j) so[u] += o[u][j][0] * o[u][j][0] + o[u][j][1] * o[u][j][1] + o[u][j][2] * o[u][j][2] + o[u][j][3] * o[u][j][3]; }
#pragma unroll
        for (int off = 1; off < 64; off <<= 1) {
#pragma unroll
            for (int u = 0; u < NR; ++u) so[u] += __shfl_xor(so[u], off); }
        float ss[NR];
#pragma unroll
        for (int u = 0; u < NR; ++u) ss[u] = 0.f;
#pragma unroll
        for (int u = 0; u < NR; ++u) { if (rows[u] >= MT) break; const int row = rows[u];
            const float* gate = MOD + (size_t)(liA * 9 + cond_of(row)) * 6144 + gateIdx * 1024; const float ro = 1.f / sqrtf(so[u] * (1.f / 1024.f) + EPS);
#pragma unroll
            for (int j = 0; j < 4; ++j) { const int c = 4 * lane + 256 * j; const f32x4 gg = *(const f32x4*)(ga + c), gt = *(const f32x4*)(gate + c);
                v[u][j] = v[u][j] + gt * (o[u][j] * ro * gg); ss[u] += v[u][j][0] * v[u][j][0] + v[u][j][1] * v[u][j][1] + v[u][j][2] * v[u][j][2] + v[u][j][3] * v[u][j][3];
                *(f32x4*)(X + (size_t)row * DM + c) = v[u][j]; } }
        if (doH) {
#pragma unroll
            for (int off = 1; off < 64; off <<= 1) {
#pragma unroll
                for (int u = 0; u < NR; ++u) ss[u] += __shfl_xor(ss[u], off); }
#pragma unroll
            for (int u = 0; u < NR; ++u) { if (rows[u] >= MT) break; const int row = rows[u]; const float* mdB = MOD + (size_t)(liB * 9 + cond_of(row)) * 6144;
                norm_mod_store(v[u], ss[u], P.inp(I_GNORM) + (liB * 4 + gB) * 1024, mdB + scaleIdx * 1024, mdB + shiftIdx * 1024, H + (size_t)row * DM, lane); }
        }
    }
}
__device__ __forceinline__ void phase_mla_prep(const Params& P) {
    const int tid = tid_opaque(), lane = tid & 63, gw = blockIdx.x * 8 + (tid >> 6), NGW = gridDim.x * 8;
    unsigned char* ws = P.wsp(); const bf16* PROJ = (const bf16*)(ws + B_PROJ); bf16* QLN = (bf16*)(ws + A_QLN); bf16* CKV = (bf16*)(ws + A_CKV); bf16* KROPE = (bf16*)(ws + R_KROPE);
    const float* rmc = (const float*)(ws + WS_RM_COS); const float* rms = (const float*)(ws + WS_RM_SIN);
    for (int row = gw; row < MT; row += NGW) {
        const bf16* pr = PROJ + (size_t)row * PJ; const int kr = key_row(row);
        float q[6]; float ss = 0.f;
#pragma unroll
        for (int j = 0; j < 3; ++j) { const unsigned w = *(const unsigned*)(pr + C_QLAT + 2 * lane + 128 * j); q[2 * j] = bf_lo(w); q[2 * j + 1] = bf_hi(w); ss += q[2 * j] * q[2 * j] + q[2 * j + 1] * q[2 * j + 1]; }
        ss = wave_sum(ss); const float rq = 1.f / sqrtf(ss * (1.f / 384.f) + EPS);
#pragma unroll
        for (int j = 0; j < 3; ++j) { const int c = 2 * lane + 128 * j; *(unsigned*)(QLN + (size_t)row * 384 + c) = pkbf(q[2 * j] * rq * P.inp(I_GQ)[c], q[2 * j + 1] * rq * P.inp(I_GQ)[c + 1]); }
        const u32x2 w = *(const u32x2*)(pr + C_KVLAT + 4 * lane); f32x4 kv = (f32x4){bf_lo(w.x), bf_hi(w.x), bf_lo(w.y), bf_hi(w.y)};
        float s2 = wave_sum(kv[0] * kv[0] + kv[1] * kv[1] + kv[2] * kv[2] + kv[3] * kv[3]); const float rk = 1.f / sqrtf(s2 * (1.f / 256.f) + EPS);
        kv = kv * rk * *(const f32x4*)(P.inp(I_GKV) + 4 * lane);
        { u32x2 o; o.x = pkbf(kv[0], kv[1]); o.y = pkbf(kv[2], kv[3]); *(u32x2*)(CKV + (size_t)kr * 256 + 4 * lane) = o; }
        if (row < MP) *(f32x4*)(P.outp() + O_CKV + (size_t)row * 256 + 4 * lane) = kv;
        if (lane < 16) { const unsigned wr = *(const unsigned*)(pr + C_KROPE + 2 * lane); float e = bf_lo(wr), od = bf_hi(wr);
            if (row < MP) { *(f32x2*)(P.outp() + O_KROPE + (size_t)row * 32 + 2 * lane) = (f32x2){e, od}; }
            else { const int t = (row - MP) & 4095; const float c = rmc[t * 16 + lane], s = rms[t * 16 + lane]; const float ne = e * c - od * s, no = e * s + od * c; e = ne; od = no; }
            *(unsigned*)(KROPE + (size_t)kr * 32 + 2 * lane) = pkbf(e, od); }
    }
    const int gt = blockIdx.x * 512 + tid, NT = gridDim.x * 512;
    for (int i = gt; i < 4096 * 256 / 4; i += NT) { const int e = i * 4, sr = e >> 8, col = e & 255; const int dr = MP + (sr >> 9) * 4608 + (sr & 511);
        const f32x4 v = *(const f32x4*)(P.inp(I_CKV) + e); u32x2 o; o.x = pkbf(v[0], v[1]); o.y = pkbf(v[2], v[3]); *(u32x2*)(CKV + (size_t)dr * 256 + col) = o; }
    for (int i = gt; i < 4096 * 32 / 4; i += NT) { const int e = i * 4, sr = e >> 5, col = e & 31; const int dr = MP + (sr >> 9) * 4608 + (sr & 511);
        const f32x4 v = *(const f32x4*)(P.inp(I_CKROPE) + e); u32x2 o; o.x = pkbf(v[0], v[1]); o.y = pkbf(v[2], v[3]); *(u32x2*)(KROPE + (size_t)dr * 32 + col) = o; }
}
__device__ __forceinline__ void phase_diff_ctx(const Params& P) {
    const int gt = blockIdx.x * 512 + tid_opaque(), NT = gridDim.x * 512;
    bf16* KD = (bf16*)(P.wsp() + B_KD); bf16* VT = (bf16*)(P.wsp() + R_VTD);
    for (int i = gt; i < 4096 * 1024 / 4; i += NT) { const int e = i * 4, sr = e >> 10, col = e & 1023; const int dr = MP + (sr >> 9) * 4608 + (sr & 511);
        const f32x4 v = *(const f32x4*)(P.inp(I_CDK) + e); u32x2 o; o.x = pkbf(v[0], v[1]); o.y = pkbf(v[2], v[3]); *(u32x2*)(KD + (size_t)dr * 1024 + col) = o; }
    for (int i = gt; i < 8 * 64 * 1024; i += NT) { const int hd = i & 1023, jg = (i >> 10) & 63, b = i >> 16;
        const float* src = P.inp(I_CDV) + ((size_t)(b * 512 + jg * 8)) * 1024 + hd; float f[8];
#pragma unroll
        for (int k = 0; k < 8; ++k) f[k] = src[(size_t)k * 1024];
        u32x4 o; o.x = pkbf(f[0], f[1]); o.y = pkbf(f[2], f[3]); o.z = pkbf(f[4], f[5]); o.w = pkbf(f[6], f[7]);
        *(u32x4*)(VT + (size_t)16 * 1024 * 256 + (size_t)b * 1024 * 4608 + (size_t)hd * 4608 + jg * 8) = o; }
}

__device__ __forceinline__ f32x16 mfma32(bf16x8 a, bf16x8 b, f32x16 c) { return __builtin_amdgcn_mfma_f32_32x32x16_bf16(a, b, c, 0, 0, 0); }
__device__ __forceinline__ f32x4 mfma16(bf16x8 a, bf16x8 b, f32x4 c) { return __builtin_amdgcn_mfma_f32_16x16x32_bf16(a, b, c, 0, 0, 0); }
__device__ __forceinline__ bf16x8 pack_bf8(float a0, float a1, float a2, float a3, float a4, float a5, float a6, float a7) {
    u32x4 w; w.x = pkbf(a0, a1); w.y = pkbf(a2, a3); w.z = pkbf(a4, a5); w.w = pkbf(a6, a7); return __builtin_bit_cast(bf16x8, w);
}
constexpr int VSTR = 144;
template <int MODE> struct AttnArgs {
    const bf16* Q; const bf16* K; const bf16* K2; const bf16* VTh; bf16* MIX; int row0, krow0, Lk, h; float lam; const float* gout;
};
__device__ __forceinline__ float max3f(float a, float b, float c) { float r; asm("v_max3_f32 %0, %1, %2, %3" : "=v"(r) : "v"(a), "v"(b), "v"(c)); return r; }
template <int MODE> __device__ __forceinline__ void attn_unit(ldsp lds, const AttnArgs<MODE>& A) {
    constexpr int ND = MODE == 0 ? 6 : 4, NMB = MODE == 0 ? 2 : 4, KSTR = MODE == 0 ? 208 : 272, DV = MODE == 0 ? 64 : 128;
    constexpr int KBUF = 64 * KSTR, VBUF = DV * VSTR;
    constexpr float CS = (MODE == 0 ? 0.10206207261596577f : 0.125f) * 1.4426950408889634f;
    const int tid = tid_opaque(), lane = tid & 63, r32 = lane & 31, hi = lane >> 5, wid = tid >> 6;
    const int map = MODE == 1 ? (wid >> 2) : 0;
    const int qrow = A.row0 + (MODE == 0 ? wid * 32 : (wid & 3) * 32) + r32;
    constexpr bool QLDS = false;
    constexpr int QST_OFF = 2 * KBUF + 2 * VBUF;
    bf16x8 qf[ND];
#pragma unroll
    for (int d0 = 0; d0 < ND; ++d0) {
        const u32x4 w = MODE == 0 ? *(const u32x4*)(A.Q + (size_t)qrow * 768 + A.h * 96 + 16 * d0 + 8 * hi) : *(const u32x4*)(A.Q + (size_t)qrow * 1024 + A.h * 128 + map * 64 + 16 * d0 + 8 * hi);
        u32x4 s; s.x = pkbf(bf_lo(w.x) * CS, bf_hi(w.x) * CS); s.y = pkbf(bf_lo(w.y) * CS, bf_hi(w.y) * CS); s.z = pkbf(bf_lo(w.z) * CS, bf_hi(w.z) * CS); s.w = pkbf(bf_lo(w.w) * CS, bf_hi(w.w) * CS);
        if (QLDS) *(LAS u32x4*)(lds + QST_OFF + wid * 4608 + r32 * 144 + hi * 16 + d0 * 32) = s; else qf[d0] = __builtin_bit_cast(bf16x8, s);
    }
    const int koff = r32 * KSTR + (MODE == 1 ? map * 128 : 0) + hi * 16;
    const int voff = r32 * VSTR + hi * 16;
    f32x16 o[NMB];
#pragma unroll
    for (int mb = 0; mb < NMB; ++mb) o[mb] = (f32x16){0.f, 0.f, 0.f, 0.f, 0.f, 0.f, 0.f, 0.f, 0.f, 0.f, 0.f, 0.f, 0.f, 0.f, 0.f, 0.f};
    float m_run = 0.f, l_run = 0.f;
    f32x16 negm = (f32x16){0.f, 0.f, 0.f, 0.f, 0.f, 0.f, 0.f, 0.f, 0.f, 0.f, 0.f, 0.f, 0.f, 0.f, 0.f, 0.f};
    const int NT = A.Lk >> 6;
    u32x4 rk0[2], rk1[2], rv0[2], rv1[2];
    const bf16* kg0; const bf16* kg1; const bf16* vg0; const bf16* vg1;
    if (MODE == 0) { kg0 = A.K + (size_t)(A.krow0 + (tid >> 3)) * 512 + A.h * 64 + (tid & 7) * 8; kg1 = A.K2 + (size_t)(A.krow0 + ((tid & 255) >> 2)) * 32 + (tid & 3) * 8;
                     vg0 = A.VTh + (size_t)(tid >> 3) * A.Lk + (tid & 7) * 8; vg1 = vg0; }
    else { kg0 = A.K + (size_t)(A.krow0 + (tid >> 4)) * 1024 + A.h * 128 + (tid & 15) * 8; kg1 = kg0;
           vg0 = A.VTh + (size_t)(tid >> 3) * A.Lk + (tid & 7) * 8; vg1 = vg0; }
    auto gloadK = [&](int t, const int s) {
        if (MODE == 0) { rk0[s] = *(const u32x4*)(kg0 + (size_t)t * 64 * 512); if (tid < 256) rk1[s] = *(const u32x4*)(kg1 + (size_t)t * 64 * 32); }
        else { const bf16* kp = kg0 + (size_t)t * 64 * 1024; rk0[s] = *(const u32x4*)kp; rk1[s] = *(const u32x4*)(kp + (size_t)32 * 1024); }
    };
    auto gloadV = [&](int t, const int s) { const bf16* vp = vg0 + 64 * t; rv0[s] = *(const u32x4*)vp; if (MODE == 1) rv1[s] = *(const u32x4*)(vp + (size_t)64 * A.Lk); };
    auto stK = [&](int buf, const int s) {
        ldsp kb = lds + buf * KBUF;
        if (MODE == 0) { *(LAS u32x4*)(kb + (tid >> 3) * KSTR + (tid & 7) * 16) = rk0[s]; if (tid < 256) *(LAS u32x4*)(kb + (tid >> 2) * KSTR + 128 + (tid & 3) * 16) = rk1[s]; }
        else { *(LAS u32x4*)(kb + (tid >> 4) * KSTR + (tid & 15) * 16) = rk0[s]; *(LAS u32x4*)(kb + (32 + (tid >> 4)) * KSTR + (tid & 15) * 16) = rk1[s]; }
    };
    auto stV = [&](int buf, const int s) {
        ldsp vb = lds + 2 * KBUF + buf * VBUF;
        const int cc = tid & 7, vpo = ((cc >> 1) * 16 + (cc & 1) * 4) * 2;
        LAS u32x2* vp = (LAS u32x2*)(vb + (tid >> 3) * VSTR + vpo); vp[0] = (u32x2){rv0[s].x, rv0[s].y}; vp[2] = (u32x2){rv0[s].z, rv0[s].w};
        if (MODE == 1) { LAS u32x2* vq = (LAS u32x2*)(vb + (64 + (tid >> 3)) * VSTR + vpo); vq[0] = (u32x2){rv1[s].x, rv1[s].y}; vq[2] = (u32x2){rv1[s].z, rv1[s].w}; }
    };
    auto qk = [&](int buf, f32x16& s0, f32x16& s1) {
        ldsp kb = lds + buf * KBUF;
        s0 = negm; s1 = negm;
#pragma unroll
        for (int d0 = 0; d0 < ND; ++d0) {
            const bf16x8 a0 = *(const LAS bf16x8*)(kb + koff + d0 * 32), a1 = *(const LAS bf16x8*)(kb + koff + 32 * KSTR + d0 * 32);
            const bf16x8 qq = QLDS ? *(const LAS bf16x8*)(lds + QST_OFF + wid * 4608 + r32 * 144 + hi * 16 + d0 * 32) : qf[d0];
            s0 = mfma32(a0, qq, s0); s1 = mfma32(a1, qq, s1);
        }
    };
    bf16x8 pf[4];
    f32x16 sc0, sc1;
    float mxa, mxb;
    auto mxstep = [&](int k) {
        if (k == 0) mxa = max3f(sc0[0], sc0[1], sc1[0]);
        else if (k == 1) mxb = max3f(sc0[2], sc0[3], sc1[1]);
        else if (k == 2) mxa = max3f(mxa, sc1[2], sc1[3]);
        else if (k < 15) { const int q = k - 3, r = 4 + 4 * (q >> 2), w = q & 3;
            if (w == 0) mxa = max3f(mxa, sc0[r], sc0[r + 1]); else if (w == 1) mxb = max3f(mxb, sc0[r + 2], sc0[r + 3]);
            else if (w == 2) mxa = max3f(mxa, sc1[r], sc1[r + 1]); else mxb = max3f(mxb, sc1[r + 2], sc1[r + 3]); }
        else mxa = max3f(mxa, mxb, mxb);
    };
    auto pv_max = [&](int buf, const bool dopv) {
        if (!dopv) {
#pragma unroll
            for (int k = 0; k < 16; ++k) mxstep(k);
            return;
        }
        ldsp vb = lds + 2 * KBUF + buf * VBUF;
        constexpr int NS = 2 * NMB;
        bf16x8 vf[2][2];
        auto ldv = [&](int s, bf16x8 (&dst)[2]) {
            const int j = s / (NMB / 2), mp = s % (NMB / 2);
#pragma unroll
            for (int e = 0; e < 2; ++e) { const int mb = 2 * mp + e;
                dst[e] = *(const LAS bf16x8*)(vb + mb * 32 * VSTR + voff + j * 32); }
        };
        ldv(0, vf[0]);
        __builtin_amdgcn_sched_barrier(0);
#pragma unroll
        for (int s = 0; s < NS; ++s) {
            if (s + 1 < NS) { ldv(s + 1, vf[(s + 1) & 1]); __builtin_amdgcn_sched_barrier(0); }
            const int j = s / (NMB / 2), mp = s % (NMB / 2);
#pragma unroll
            for (int e = 0; e < 2; ++e) { const int mb = 2 * mp + e; o[mb] = mfma32(vf[s & 1][e], pf[j], o[mb]);
#pragma unroll
                for (int q = 0; q < 16 / (2 * NS); ++q) mxstep((2 * s + e) * (16 / (2 * NS)) + q); }
            __builtin_amdgcn_sched_barrier(0);
        }
    };
    gloadK(0, 0); gloadK(1, 1); stK(0, 0); stK(1, 1); gloadK(2, 0); gloadV(0, 0);
    __syncthreads();
    qk(0, sc0, sc1);
    __syncthreads();
    auto iter = [&](int t, const int par, const bool first, const bool last) {
        stV(par, 0);
        if (t + 2 < NT) stK(par, 0);
        if (t + 3 < NT) gloadK(t + 3, 0);
        if (!last) gloadV(t + 1, 0);
        pv_max(par ^ 1, !first);
        float mx = fmaxf(mxa, __shfl_xor(mxa, 32));
        if (first || __any(mx > 8.f)) {
            const float dl = first ? mx : fmaxf(mx, 0.f), alpha = fast_exp2(-dl); m_run += dl; l_run *= alpha;
#pragma unroll
            for (int mb = 0; mb < NMB; ++mb)
#pragma unroll
                for (int r = 0; r < 16; ++r) o[mb][r] *= alpha;
#pragma unroll
            for (int r = 0; r < 16; ++r) { sc0[r] -= dl; sc1[r] -= dl; negm[r] = -m_run; }
        }
        f32x16 sn0, sn1;
        if (!last) qk(par ^ 1, sn0, sn1);
        float rs = 0.f;
#pragma unroll
        for (int r = 0; r < 16; ++r) { sc0[r] = fast_exp2(sc0[r]); sc1[r] = fast_exp2(sc1[r]); rs += sc0[r] + sc1[r]; }
        l_run += rs;
        pf[0] = pack_bf8(sc0[0], sc0[1], sc0[2], sc0[3], sc0[4], sc0[5], sc0[6], sc0[7]); pf[1] = pack_bf8(sc0[8], sc0[9], sc0[10], sc0[11], sc0[12], sc0[13], sc0[14], sc0[15]);
        pf[2] = pack_bf8(sc1[0], sc1[1], sc1[2], sc1[3], sc1[4], sc1[5], sc1[6], sc1[7]); pf[3] = pack_bf8(sc1[8], sc1[9], sc1[10], sc1[11], sc1[12], sc1[13], sc1[14], sc1[15]);
        if (!last) { sc0 = sn0; sc1 = sn1; }
        __syncthreads();
    };
    iter(0, 0, true, false);
    iter(1, 1, false, false);
    for (int t = 2; t < NT - 2; t += 2) { iter(t, 0, false, false); iter(t + 1, 1, false, false); }
    iter(NT - 2, 0, false, false);
    iter(NT - 1, 1, false, true);
    pv_max(1, true);
    l_run += __shfl_xor(l_run, 32);
    const float inv = 1.f / l_run;
    __syncthreads();
    if (MODE == 0) {
        bf16* orow = A.MIX + (size_t)qrow * 1024 + A.h * 64;
#pragma unroll
        for (int mb = 0; mb < NMB; ++mb)
#pragma unroll
            for (int g = 0; g < 4; ++g) { u32x2 w; w.x = pkbf(o[mb][4 * g] * inv, o[mb][4 * g + 1] * inv); w.y = pkbf(o[mb][4 * g + 2] * inv, o[mb][4 * g + 3] * inv);
                *(u32x2*)(orow + 32 * mb + 8 * g + 4 * hi) = w; }
    } else {
        LAS float* xb = (LAS float*)lds + (size_t)(wid & 3) * 64 * 64;
        if (wid >= 4) {
#pragma unroll
            for (int mb = 0; mb < NMB; ++mb)
#pragma unroll
                for (int r = 0; r < 16; ++r) xb[(mb * 16 + r) * 64 + lane] = o[mb][r] * inv;
        }
        __syncthreads();
        if (wid < 4) {
            float ss = 0.f;
#pragma unroll
            for (int mb = 0; mb < NMB; ++mb)
#pragma unroll
                for (int r = 0; r < 16; ++r) { const float v = o[mb][r] * inv - A.lam * xb[(mb * 16 + r) * 64 + lane]; o[mb][r] = v; ss += v * v; }
            ss += __shfl_xor(ss, 32);
            const float rr = (1.f - LAM_INIT) / sqrtf(ss * (1.f / 128.f) + EPS);
            bf16* orow = A.MIX + (size_t)qrow * 1024 + A.h * 128;
#pragma unroll
            for (int mb = 0; mb < NMB; ++mb)
#pragma unroll
                for (int g = 0; g < 4; ++g) { const int d = 32 * mb + 8 * g + 4 * hi; const f32x4 gg = *(const f32x4*)(A.gout + d);
                    u32x2 w; w.x = pkbf(o[mb][4 * g] * rr * gg[0], o[mb][4 * g + 1] * rr * gg[1]); w.y = pkbf(o[mb][4 * g + 2] * rr * gg[2], o[mb][4 * g + 3] * rr * gg[3]);
                    *(u32x2*)(orow + d) = w; }
        }
        __syncthreads();
    }
}

__device__ __forceinline__ float logsig(float x) { return fminf(x, 0.f) - __logf(1.f + __expf(-fabsf(x))); }
__device__ __forceinline__ void gla_unit(ldsp lds, const Params& P, bool prompt, int b, int h, int dir) {
    constexpr int QSTR = 272, TSTR = 144;
    constexpr int L_QIN = 0, L_KIN = 64 * QSTR, L_KOT = 2 * 64 * QSTR, L_VT = L_KOT + 128 * TSTR, L_AM = L_VT + 128 * TSTR, L_LR = L_AM + 64 * TSTR, L_TOT = L_LR + 4096, L_DEC = L_TOT + 2048,
                  L_VRAW = L_DEC + 512;
    static_assert(L_VRAW + 64 * QSTR <= 131072, "gla lds");
    const int tid = tid_opaque(), lane = tid & 63, wid = tid >> 6, l16 = lane & 15, q4 = lane >> 4;
    const int L = prompt ? 256 : 4096, nch = L >> 6, rowbase = prompt ? b * 256 : MP + b * 4096;
    const bf16* PROJ = (const bf16*)(P.wsp() + B_PROJ);
    bf16* OD = dir == 0 ? (bf16*)(P.wsp() + B_PROJ) + h * 128 : (bf16*)(P.wsp() + A_MIX) + 512 + h * 128;
    const int ostr = dir == 0 ? PJ : 1024;
    LAS float* dec = (LAS float*)(lds + L_DEC);
    const int vcol = 16 * wid + l16;
    f32x4 S[8];
    if (prompt) {
#pragma unroll
        for (int db = 0; db < 8; ++db) S[db] = (f32x4){0.f, 0.f, 0.f, 0.f};
    } else {
        const float* sfp = P.inp(I_SF); const float* sbp = P.inp(I_SB); asm volatile("" : "+s"(sfp), "+s"(sbp));
        const float* s0 = (dir == 0 ? sfp : sbp) + ((size_t)(b * 4 + h) * 128) * 128 + (size_t)(4 * q4) * 128 + vcol; asm volatile("" : "+v"(s0));
#pragma unroll
        for (int db = 0; db < 8; ++db)
#pragma unroll
            for (int r = 0; r < 4; ++r) S[db][r] = s0[(16 * db + r) * 128];
    }
    const int dq = 16 * wid + l16;
    bf16x8 wgf;
    {
        float wv[8];
#pragma unroll
        for (int j = 0; j < 8; ++j) wv[j] = q4 < 2 ? P.inp(I_WGATE)[(size_t)(dir * 16 + 8 * q4 + j) * 512 + h * 128 + dq] : 0.f;
        wgf = pack_bf8(wv[0], wv[1], wv[2], wv[3], wv[4], wv[5], wv[6], wv[7]);
    }
    const float bg = P.inp(I_BGATE)[dir * 512 + h * 128 + dq];
    u32x4 rq[2], rk[2], rv[2], lrf[4];
    auto raw_load = [&](int ci) {
        const int n = dir == 0 ? ci : nch - 1 - ci; const int tok0 = rowbase + n * 64;
#pragma unroll
        for (int i = 0; i < 2; ++i) { const int idx = tid + 512 * i; const bf16* pr = PROJ + (size_t)(tok0 + (idx >> 4)) * PJ + h * 128 + (idx & 15) * 8;
            rq[i] = *(const u32x4*)(pr + C_GQ); rk[i] = *(const u32x4*)(pr + C_GK); rv[i] = *(const u32x4*)(pr + C_GV); }
        const bf16* pl = PROJ + (size_t)(tok0 + l16) * PJ + C_GGATE + dir * 16 + 8 * (q4 & 1); asm volatile("" : "+v"(pl));
#pragma unroll
        for (int mb = 0; mb < 4; ++mb) { const u32x4 t = *(const u32x4*)(pl + (size_t)(16 * mb) * PJ); lrf[mb] = q4 < 2 ? t : (u32x4){0u, 0u, 0u, 0u}; }
    };
    raw_load(0);
    for (int ci = 0; ci < nch; ++ci) {
        const int n = dir == 0 ? ci : nch - 1 - ci; const int tok0 = rowbase + n * 64;
#pragma unroll
        for (int i = 0; i < 2; ++i) { const int idx = tid + 512 * i, off = (idx >> 4) * QSTR + (idx & 15) * 16;
            *(LAS u32x4*)(lds + L_QIN + off) = rq[i]; *(LAS u32x4*)(lds + L_KIN + off) = rk[i]; *(LAS u32x4*)(lds + L_VRAW + off) = rv[i]; }
        float g[4][4];
#pragma unroll
        for (int mb = 0; mb < 4; ++mb) { const f32x4 acc = mfma16(__builtin_bit_cast(bf16x8, lrf[mb]), wgf, (f32x4){0.f, 0.f, 0.f, 0.f});
#pragma unroll
            for (int r = 0; r < 4; ++r) g[mb][r] = logsig(acc[r] + bg) * (1.f / 16.f); }
        if (ci + 1 < nch) raw_load(ci + 1);
        __syncthreads();
        float qv[4][4], kv[4][4]; bf16 vraw[4][4];
#pragma unroll
        for (int mb = 0; mb < 4; ++mb)
#pragma unroll
            for (int r = 0; r < 4; ++r) { const int off = (16 * mb + 4 * q4 + r) * QSTR + dq * 2;
                qv[mb][r] = bf1(*(const LAS bf16*)(lds + L_QIN + off)); kv[mb][r] = bf1(*(const LAS bf16*)(lds + L_KIN + off)); vraw[mb][r] = *(const LAS bf16*)(lds + L_VRAW + off); }
        float pfx[4][4], total = 0.f;
#pragma unroll
        for (int mb = 0; mb < 4; ++mb) {
            pfx[mb][0] = g[mb][0]; pfx[mb][1] = pfx[mb][0] + g[mb][1]; pfx[mb][2] = pfx[mb][1] + g[mb][2]; pfx[mb][3] = pfx[mb][2] + g[mb][3];
            const float R = pfx[mb][3];
            const float e1 = __shfl_up(R, 16), e2 = __shfl_up(R, 32), e3 = __shfl_up(R, 48);
            const float excl = (q4 >= 1 ? e1 : 0.f) + (q4 >= 2 ? e2 : 0.f) + (q4 >= 3 ? e3 : 0.f);
            const float blk = __shfl(excl + R, 48 + l16);
            const float base = excl + total;
#pragma unroll
            for (int r = 0; r < 4; ++r) pfx[mb][r] += base;
            total += blk;
        }
        if (q4 == 0) dec[dq] = __expf(total);
        {
            const float etot = __expf(total);
#pragma unroll
            for (int mb = 0; mb < 4; ++mb) {
                float ko[4];
#pragma unroll
                for (int r = 0; r < 4; ++r) { const float cum = dir == 0 ? pfx[mb][r] : total - pfx[mb][r] + g[mb][r]; const int s = 16 * mb + 4 * q4 + r;
                    const float ec = __expf(cum), en = fast_rcp(ec);
                    *(LAS bf16*)(lds + L_QIN + s * QSTR + dq * 2) = tobf(qv[mb][r] * 0.08838834764831845f * ec);
                    *(LAS bf16*)(lds + L_KIN + s * QSTR + dq * 2) = tobf(kv[mb][r] * en);
                    ko[r] = kv[mb][r] * en * etot; }
                u32x2 w; w.x = pkbf(ko[0], ko[1]); w.y = pkbf(ko[2], ko[3]);
                *(LAS u32x2*)(lds + L_KOT + dq * TSTR + (16 * mb + 4 * q4) * 2) = w;
                u32x2 v; v.x = vraw[mb][0] | ((unsigned)vraw[mb][1] << 16); v.y = vraw[mb][2] | ((unsigned)vraw[mb][3] << 16);
                *(LAS u32x2*)(lds + L_VT + dq * TSTR + (16 * mb + 4 * q4) * 2) = v;
            }
        }
        __syncthreads();
        {
            const int cb1 = wid >> 1, sh = wid & 1;
#pragma unroll
            for (int nb = 0; nb < 2; ++nb) {
                f32x4 acc = (f32x4){0.f, 0.f, 0.f, 0.f};
#pragma unroll
                for (int kb = 0; kb < 4; ++kb) {
                    const bf16x8 a = *(const LAS bf16x8*)(lds + L_QIN + (16 * cb1 + l16) * QSTR + (32 * kb + 8 * q4) * 2);
                    const bf16x8 bb = *(const LAS bf16x8*)(lds + L_KIN + (32 * sh + 16 * nb + l16) * QSTR + (32 * kb + 8 * q4) * 2);
                    acc = mfma16(a, bb, acc);
                }
                const int s = 32 * sh + 16 * nb + l16;
#pragma unroll
                for (int r = 0; r < 4; ++r) { const int c = 16 * cb1 + 4 * q4 + r; const bool keep = dir == 0 ? (s <= c) : (s >= c);
                    *(LAS bf16*)(lds + L_AM + c * TSTR + s * 2) = tobf(keep ? acc[r] : 0.f); }
            }
        }
        f32x4 o[4];
        {
            bf16x8 sb[4];
#pragma unroll
            for (int kb = 0; kb < 4; ++kb) sb[kb] = pack_bf8(S[2 * kb][0], S[2 * kb][1], S[2 * kb][2], S[2 * kb][3], S[2 * kb + 1][0], S[2 * kb + 1][1], S[2 * kb + 1][2], S[2 * kb + 1][3]);
#pragma unroll
            for (int cb = 0; cb < 4; ++cb) { o[cb] = (f32x4){0.f, 0.f, 0.f, 0.f};
#pragma unroll
                for (int kb = 0; kb < 4; ++kb) {
                    const s16x4 lo = *(const LAS s16x4*)(lds + L_QIN + (16 * cb + l16) * QSTR + (32 * kb + 4 * q4) * 2), hh = *(const LAS s16x4*)(lds + L_QIN + (16 * cb + l16) * QSTR + (32 * kb + 16 + 4 * q4) * 2);
                    const bf16x8 a = (bf16x8){lo[0], lo[1], lo[2], lo[3], hh[0], hh[1], hh[2], hh[3]};
                    o[cb] = mfma16(a, sb[kb], o[cb]);
                } }
        }
        __syncthreads();
        {
            bf16x8 vb[2];
#pragma unroll
            for (int kb = 0; kb < 2; ++kb) vb[kb] = *(const LAS bf16x8*)(lds + L_VT + vcol * TSTR + (32 * kb + 8 * q4) * 2);
#pragma unroll
            for (int cb = 0; cb < 4; ++cb)
#pragma unroll
                for (int kb = 0; kb < 2; ++kb) { const bf16x8 a = *(const LAS bf16x8*)(lds + L_AM + (16 * cb + l16) * TSTR + (32 * kb + 8 * q4) * 2); o[cb] = mfma16(a, vb[kb], o[cb]); }
#pragma unroll
            for (int db = 0; db < 8; ++db) { const f32x4 dc = *(const LAS f32x4*)(lds + L_DEC + (16 * db + 4 * q4) * 4); S[db] = S[db] * dc;
#pragma unroll
                for (int kb = 0; kb < 2; ++kb) { const bf16x8 a = *(const LAS bf16x8*)(lds + L_KOT + (16 * db + l16) * TSTR + (32 * kb + 8 * q4) * 2); S[db] = mfma16(a, vb[kb], S[db]); } }
        }
        {
            bf16* pw0 = OD + (size_t)(tok0 + 4 * q4) * ostr + vcol; asm volatile("" : "+v"(pw0));
#pragma unroll
            for (int cb = 0; cb < 4; ++cb)
#pragma unroll
                for (int r = 0; r < 4; ++r) pw0[(size_t)(16 * cb + r) * ostr] = tobf(o[cb][r]);
        }
        __syncthreads();
    }
    if (prompt) { float* so = P.outp() + (dir == 0 ? O_GF : O_GB) + ((size_t)(b * 4 + h) * 128) * 128 + (size_t)(4 * q4) * 128 + vcol; asm volatile("" : "+v"(so));
#pragma unroll
        for (int db = 0; db < 8; ++db)
#pragma unroll
            for (int r = 0; r < 4; ++r) so[(16 * db + r) * 128] = S[db][r]; }
    __syncthreads();
}
__device__ __forceinline__ void phase_gla_fin(const Params& P) {
    const int tid = tid_opaque(), lane = tid & 63, gw = blockIdx.x * 8 + (tid >> 6), NGW = gridDim.x * 8;
    const bf16* PROJ = (const bf16*)(P.wsp() + B_PROJ); bf16* MIX = (bf16*)(P.wsp() + A_MIX);
    const f32x4 g0 = *(const f32x4*)(P.inp(I_GGOUT) + (8 * lane & 127)), g1 = *(const f32x4*)(P.inp(I_GGOUT) + (8 * lane & 127) + 4);
    constexpr int NR = 3;
    for (int row0 = gw; row0 < MT; row0 += NR * NGW) {
        u32x4 a[NR], bq[NR], gt[NR];
#pragma unroll
        for (int u = 0; u < NR; ++u) { const int row = row0 + u * NGW; if (row >= MT) break;
            a[u] = *(const u32x4*)(PROJ + (size_t)row * PJ + 8 * lane); bq[u] = *(const u32x4*)(MIX + (size_t)row * 1024 + 512 + 8 * lane); gt[u] = *(const u32x4*)(PROJ + (size_t)row * PJ + C_GOUT + 8 * lane); }
#pragma unroll
        for (int u = 0; u < NR; ++u) { const int row = row0 + u * NGW; if (row >= MT) break;
            float v[8];
            v[0] = bf_lo(a[u].x) + bf_lo(bq[u].x); v[1] = bf_hi(a[u].x) + bf_hi(bq[u].x); v[2] = bf_lo(a[u].y) + bf_lo(bq[u].y); v[3] = bf_hi(a[u].y) + bf_hi(bq[u].y);
            v[4] = bf_lo(a[u].z) + bf_lo(bq[u].z); v[5] = bf_hi(a[u].z) + bf_hi(bq[u].z); v[6] = bf_lo(a[u].w) + bf_lo(bq[u].w); v[7] = bf_hi(a[u].w) + bf_hi(bq[u].w);
            float ss = 0.f;
#pragma unroll
            for (int i = 0; i < 8; ++i) ss += v[i] * v[i];
            ss += __shfl_xor(ss, 1); ss += __shfl_xor(ss, 2); ss += __shfl_xor(ss, 4); ss += __shfl_xor(ss, 8);
            const float rr = 1.f / sqrtf(ss * (1.f / 128.f) + EPS);
            u32x4 w;
            w.x = pkbf(v[0] * rr * g0[0] * silu_f(bf_lo(gt[u].x)), v[1] * rr * g0[1] * silu_f(bf_hi(gt[u].x))); w.y = pkbf(v[2] * rr * g0[2] * silu_f(bf_lo(gt[u].y)), v[3] * rr * g0[3] * silu_f(bf_hi(gt[u].y)));
            w.z = pkbf(v[4] * rr * g1[0] * silu_f(bf_lo(gt[u].z)), v[5] * rr * g1[1] * silu_f(bf_hi(gt[u].z))); w.w = pkbf(v[6] * rr * g1[2] * silu_f(bf_lo(gt[u].w)), v[7] * rr * g1[3] * silu_f(bf_hi(gt[u].w)));
            *(u32x4*)(MIX + (size_t)row * 1024 + 512 + 8 * lane) = w; }
    }
}

#define RLX_AGENT __ATOMIC_RELAXED, __HIP_MEMORY_SCOPE_AGENT
#define XB_TMO      128
#define XB_XCNT(j)  (256  + 64 * (j))
#define XB_XSUB(j)  (1280 + 64 * (j))
#define XB_XGEN(j)  (2304 + 64 * (j))
#define XB_TOP      3328
#define XB_TOPGEN   3392
#define XCD_BAR_WORDS 3456
#define XB_SPIN_CAP (1u << 18)

__device__ __forceinline__ unsigned xb_ld(unsigned* p)              { return __hip_atomic_load(p, __ATOMIC_RELAXED, __HIP_MEMORY_SCOPE_AGENT); }
__device__ __forceinline__ unsigned xb_add(unsigned* p, unsigned v) { return __hip_atomic_fetch_add(p, v, __ATOMIC_RELAXED, __HIP_MEMORY_SCOPE_AGENT); }
__device__ __forceinline__ unsigned xb_xcc_id() { return (unsigned)__builtin_amdgcn_s_getreg((3 << 11) | 20) & 0xFu; }
#define XB_SPIN(cond, bar) do { unsigned _sp = 0; while (cond) { __builtin_amdgcn_s_sleep(1); \
    if ((++_sp & 255u) == 0u) { if (xb_ld(&(bar)[XB_TMO])) break; if (_sp > XB_SPIN_CAP) { atomicAdd(&(bar)[XB_TMO], 1u); break; } } } } while (0)

struct XcdBarrier {
    unsigned* bar; unsigned x;
    volatile LAS unsigned* st;
};

__device__ __forceinline__ XcdBarrier xcd_barrier_post(unsigned* bar, volatile LAS unsigned* st) {
    XcdBarrier b; b.bar = bar; b.x = xb_xcc_id(); b.st = st;
    if (threadIdx.x == 0) (void)xb_add(&bar[XB_XCNT(b.x)], 1u);
    return b;
}
__device__ __forceinline__ void xcd_barrier_complete(unsigned* bar, unsigned x, unsigned& nloc, unsigned& nx) {
    const unsigned G = gridDim.x * gridDim.y * gridDim.z;
    unsigned sum, cnt, mine, sp = 0u;
    for (;;) {
        sum = 0u; cnt = 0u; mine = 0u;
#pragma unroll
        for (unsigned j = 0; j < 16; ++j) { const unsigned c = xb_ld(&bar[XB_XCNT(j)]); sum += c; cnt += (c > 0u) ? 1u : 0u; mine = (j == x) ? c : mine; }
        if (sum == G) break;
        __builtin_amdgcn_s_sleep(1);
        if ((++sp & 255u) == 0u) { if (xb_ld(&bar[XB_TMO])) break; if (sp > XB_SPIN_CAP) { atomicAdd(&bar[XB_TMO], 1u); break; } }
    }
    nloc = mine > 0u ? mine : 1u; nx = cnt > 0u ? cnt : 1u;
}

__device__ __forceinline__ void xcd_barrier(const XcdBarrier& b) {
    asm volatile("s_waitcnt vmcnt(0)" ::: "memory");
    __syncthreads();
    if (threadIdx.x == 0) {
        unsigned* bar = b.bar;
        __builtin_amdgcn_s_waitcnt(0);
        unsigned nloc = b.st[0], nx = b.st[1];
        if (nloc == 0u) { xcd_barrier_complete(bar, b.x, nloc, nx); b.st[0] = nloc; b.st[1] = nx; }
        const unsigned old = xb_add(&bar[XB_XSUB(b.x)], 1u);
        const unsigned gen = old / nloc;
        if (old + 1u == (gen + 1u) * nloc) {
            __builtin_amdgcn_fence(__ATOMIC_RELEASE, "agent");
            asm volatile("s_waitcnt vmcnt(0)" ::: "memory");
            const unsigned og = xb_add(&bar[XB_TOP], 1u);
            const unsigned tg = og / nx;
            if (og + 1u == (tg + 1u) * nx) xb_add(&bar[XB_TOPGEN], 1u);
            else XB_SPIN(xb_ld(&bar[XB_TOPGEN]) == tg, bar);
            __builtin_amdgcn_fence(__ATOMIC_ACQUIRE, "agent");
            xb_add(&bar[XB_XGEN(b.x)], 1u);
            asm volatile("s_waitcnt vmcnt(0)" ::: "memory");
        } else {
            XB_SPIN(xb_ld(&bar[XB_XGEN(b.x)]) == gen, bar);
            __builtin_amdgcn_fence(__ATOMIC_ACQUIRE, "agent");
            asm volatile("s_waitcnt vmcnt(0)" ::: "memory");
        }
    }
    __syncthreads();
}


#ifndef NO_GEMM
#define RUN_GEMM(...) pg8::run_gemm(__VA_ARGS__)
#else
#define RUN_GEMM(...) do{}while(0)
#endif
#ifndef NO_ATT0
#define ATT0(...) attn_unit<0>(__VA_ARGS__)
#else
#define ATT0(...) do{}while(0)
#endif
#ifndef NO_ATT1
#define ATT1(...) attn_unit<1>(__VA_ARGS__)
#else
#define ATT1(...) do{}while(0)
#endif
#ifndef NO_GLA
#define GLA(...) gla_unit(__VA_ARGS__)
#else
#define GLA(...) do{}while(0)
#endif
#ifndef NO_EmPlain
#define RG_EmPlain(...) RUN_GEMM(__VA_ARGS__)
#else
#define RG_EmPlain(...) do{}while(0)
#endif
#ifndef NO_EmQ
#define RG_EmQ(...) RUN_GEMM(__VA_ARGS__)
#else
#define RG_EmQ(...) do{}while(0)
#endif
#ifndef NO_EmKV
#define RG_EmKV(...) RUN_GEMM(__VA_ARGS__)
#else
#define RG_EmKV(...) do{}while(0)
#endif
#ifndef NO_EmFFN
#define RG_EmFFN(...) RUN_GEMM(__VA_ARGS__)
#else
#define RG_EmFFN(...) do{}while(0)
#endif
#ifndef NO_EmQKV
#define RG_EmQKV(...) RUN_GEMM(__VA_ARGS__)
#else
#define RG_EmQKV(...) do{}while(0)
#endif
#ifndef PH_LO
#define PH_LO 0
#endif
#ifndef PH_HI
#define PH_HI 20
#endif
constexpr int LDS_BYTES = 147456;
__device__ __forceinline__ int next_item(unsigned* ctr, ldsp lds) {
    LAS int* slot = (LAS int*)(lds + 131072 + 64);
    __syncthreads();
    if (threadIdx.x == 0) *slot = (int)atomicAdd(ctr, 1u);
    __syncthreads();
    return *slot;
}
__global__ void __launch_bounds__(512, 2) fwd_megakernel(ParamsK Pkarg) {
    extern __shared__ __attribute__((aligned(16))) unsigned char lds_raw[];
    ldsp lds = (ldsp)lds_raw;
    cg::grid_group grid = cg::this_grid();
    XcdBarrier xbar;
    {
        volatile LAS unsigned* stw = (volatile LAS unsigned*)(lds + 131072 + 128);
        if (threadIdx.x < 2) stw[threadIdx.x] = 0u;
        __syncthreads();
#if defined(__HIP_DEVICE_COMPILE__)
        unsigned char* ws0 = *(unsigned char* const __attribute__((address_space(4)))*)((const __attribute__((address_space(4))) char*)__builtin_amdgcn_kernarg_segment_ptr() + 8 * 29);
#else
        unsigned char* ws0 = nullptr;
#endif
        xbar = xcd_barrier_post((unsigned*)(ws0 + WS_CTL) + 4096, stw);
    }
#pragma unroll 1
    for (int ph = PH_LO; ph < PH_HI; ++ph) {
        Params P;
#if defined(__HIP_DEVICE_COMPILE__)
        P.kp = (const __attribute__((address_space(4))) char*)__builtin_amdgcn_kernarg_segment_ptr(); asm volatile("" : "+s"(P.kp));
#else
        P.kp = nullptr;
#endif
        unsigned char* ws = P.wsp();
        unsigned* ctl = (unsigned*)(ws + WS_CTL);
        typedef pg8::bf16_t* bp; typedef const pg8::bf16_t* cbp;
        const float* rmc = (const float*)(ws + WS_RM_COS); const float* rms = (const float*)(ws + WS_RM_SIN); const float* rdc = (const float*)(ws + WS_RD_COS); const float* rds = (const float*)(ws + WS_RD_SIN);
#ifdef REPMASK
        const int nrep = 1 + ((REPMASK >> ph) & 1);
#else
        const int nrep = 1;
#endif
#pragma unroll 1
        for (int rep = 0; rep < nrep; ++rep) {
        if (rep) xcd_barrier(xbar);
        int kind = 0;
        cbp gA = nullptr, gB = nullptr; int gM = 0, gN = 0, gK = 0; bp gO = nullptr; int gldc = 0;
        bool rn_first = false, rn_doH = false; int rn_liA = 0, rn_gA = 0, rn_gate = 0, rn_liB = 0, rn_gB = 0, rn_sc = 0, rn_sh = 0;
        switch (ph) {
        case 0: phase0(P, lds); break;
        case 1: phase_norm0(P); break;
        case 2: kind = 1; gA = (cbp)(ws + A_H); gB = (cbp)(ws + W_IN); gM = MT; gN = PJ; gK = 1024; gO = (bp)(ws + B_PROJ); gldc = PJ; break;
        case 3: phase_mla_prep(P); break;
        case 4: RG_EmQ(lds, (cbp)(ws + A_QLN), (cbp)(ws + W_UQ), MT, 768, 384, pg8::EmQ{(bp)(ws + R_Q), rmc, rms});
                RG_EmKV(lds, (cbp)(ws + A_CKV), (cbp)(ws + W_UKV), KR, 1024, 256, pg8::EmKV{(bp)(ws + R_KN), (bp)(ws + R_VTM)}); break;
        case 5: break;
        case 6: {
            const int xcd = (int)(__builtin_amdgcn_s_getreg((3 << 11) | 20) & 7u);
            for (int qq = 0; qq < 8; ++qq) {
                const int x = (xcd + qq) & 7;
                for (;;) {
                    const int it = next_item(ctl + 64 * x + 1024 * rep, lds);
                    if (it >= 168) break;
                    if (it < 8) { const int u = x * 8 + it; GLA(lds, P, false, u >> 3, (u >> 1) & 3, u & 1); }
                    else if (it >= 136 && it < 152) { const int u = x * 16 + (it - 136); GLA(lds, P, true, u >> 3, (u >> 1) & 3, u & 1); }
                    else { AttnArgs<0> A; A.Q = (const bf16*)(ws + R_Q); A.K = (const bf16*)(ws + R_KN); A.K2 = (const bf16*)(ws + R_KROPE); A.MIX = (bf16*)(ws + A_MIX); A.lam = 0.f; A.gout = nullptr;
                        if (it < 136) { const int j = it - 8, pair = (j >> 4) * 8 + x, b = pair >> 3, h = pair & 7, qb = j & 15;
                            A.VTh = (const bf16*)(ws + R_VTM) + (size_t)16 * 512 * 256 + (size_t)b * 512 * 4608 + (size_t)h * 64 * 4608;
                            A.row0 = MP + b * 4096 + qb * 256; A.krow0 = MP + b * 4608; A.Lk = 4608; A.h = h; }
                        else { const int u = x * 16 + (it - 152), b = u >> 3, h = u & 7;
                            A.VTh = (const bf16*)(ws + R_VTM) + (size_t)b * 512 * 256 + (size_t)h * 64 * 256;
                            A.row0 = b * 256; A.krow0 = b * 256; A.Lk = 256; A.h = h; }
                        ATT0(lds, A); }
                }
            }
        } break;
        case 7: phase_gla_fin(P); break;
        case 8: kind = 1; gA = (cbp)(ws + A_MIX); gB = (cbp)(ws + W_ABO); gM = MT; gN = 1024; gK = 1024; gO = (bp)(ws + R_OUT); gldc = 1024; break;
        case 9: kind = 2; rn_first = true; rn_liA = 0; rn_gA = 1; rn_gate = 2; rn_doH = true; rn_liB = 0; rn_gB = 2; rn_sc = 4; rn_sh = 3; break;
        case 10: kind = 3; gA = (cbp)(ws + A_H); gB = (cbp)(ws + W_F1); gM = MT; gN = 5632; gK = 1024; gO = (bp)(ws + B_FFNH); break;
        case 11: kind = 1; gA = (cbp)(ws + B_FFNH); gB = (cbp)(ws + W_F2); gM = MT; gN = 1024; gK = 2816; gO = (bp)(ws + R_OUT); gldc = 1024; break;
        case 12: kind = 2; rn_liA = 0; rn_gA = 3; rn_gate = 5; rn_doH = true; rn_liB = 1; rn_gB = 0; rn_sc = 1; rn_sh = 0; phase_diff_ctx(P); break;
        case 13: RG_EmQKV(lds, (cbp)(ws + A_H), (cbp)(ws + W_QKV), MT, 3072, 1024, pg8::EmQKV{(bp)(ws + B_QD), (bp)(ws + B_KD), (bp)(ws + R_VTD), P.outp() + O_DK, P.outp() + O_DV, rdc, rds}); break;
        case 14: {
            const float lam = *(const float*)(ws + WS_LAM);
            const int xcd = (int)(__builtin_amdgcn_s_getreg((3 << 11) | 20) & 7u);
            for (int qq = 0; qq < 8; ++qq) {
                const int x = (xcd + qq) & 7;
                for (;;) {
                    const int it = next_item(ctl + 512 + 64 * x + 1024 * rep, lds);
                    if (it >= 288) break;
                    AttnArgs<1> A; A.Q = (const bf16*)(ws + B_QD); A.K = (const bf16*)(ws + B_KD); A.K2 = nullptr; A.MIX = (bf16*)(ws + A_MIX); A.lam = lam; A.gout = P.inp(I_DGOUT);
                    if (it < 256) { const int pair = (it >> 5) * 8 + x, b = pair >> 3, h = pair & 7, qb = it & 31;
                        A.VTh = (const bf16*)(ws + R_VTD) + (size_t)16 * 1024 * 256 + (size_t)b * 1024 * 4608 + (size_t)h * 128 * 4608;
                        A.row0 = MP + b * 4096 + qb * 128; A.krow0 = MP + b * 4608; A.Lk = 4608; A.h = h; }
                    else { const int u = x * 32 + (it - 256), b = u >> 4, h = (u >> 1) & 7, qb = u & 1;
                        A.VTh = (const bf16*)(ws + R_VTD) + (size_t)b * 1024 * 256 + (size_t)h * 128 * 256;
                        A.row0 = b * 256 + qb * 128; A.krow0 = b * 256; A.Lk = 256; A.h = h; }
#ifdef UNIT_REP
                    ATT1(lds, A);
#endif
                    ATT1(lds, A);
                }
            }
        } break;
        case 15: kind = 1; gA = (cbp)(ws + A_MIX); gB = (cbp)(ws + W_CO); gM = MT; gN = 1024; gK = 1024; gO = (bp)(ws + R_OUT); gldc = 1024; break;
        case 16: kind = 2; rn_liA = 1; rn_gA = 1; rn_gate = 2; rn_doH = true; rn_liB = 1; rn_gB = 2; rn_sc = 4; rn_sh = 3; break;
        case 17: kind = 3; gA = (cbp)(ws + A_H); gB = (cbp)(ws + W_F1 + 11 * MiB); gM = MT; gN = 5632; gK = 1024; gO = (bp)(ws + B_FFNH); break;
        case 18: kind = 1; gA = (cbp)(ws + B_FFNH); gB = (cbp)(ws + W_F2 + (size_t)2816 * 1024 * 2); gM = MT; gN = 1024; gK = 2816; gO = (bp)(ws + R_OUT); gldc = 1024; break;
        default: kind = 2; rn_liA = 1; rn_gA = 3; rn_gate = 5; rn_doH = false; break;
        }
        if (kind == 1) RG_EmPlain(lds, gA, gB, gM, gN, gK, pg8::EmPlain{gO, gldc});
        else if (kind == 3) RG_EmFFN(lds, gA, gB, gM, gN, gK, pg8::EmFFN{gO});
        else if (kind == 2) phase_resnorm(P, rn_first, rn_liA, rn_gA, rn_gate, rn_doH, rn_liB, rn_gB, rn_sc, rn_sh);
        }
        if (ph + 1 < PH_HI && ph != 4) { if (ph == 0) grid.sync(); else xcd_barrier(xbar); }
#ifdef EXTRA_SYNCS
        if (ph == 1) { for (int es = 0; es < EXTRA_SYNCS; ++es) xcd_barrier(xbar); }
#endif
    }
}

extern "C" void kernel_launch(void* const* d_in, const int* in_sizes, int n_in, void* d_out, int out_size, void* d_ws, size_t ws_size, hipStream_t stream) {
    static int grid = 0;
    if (grid == 0) {
        if (n_in != 28 || ws_size < WS_END) { fprintf(stderr, "kernel_launch: unexpected n_in %d / ws_size %zu (need %zu)\n", n_in, ws_size, (size_t)WS_END); grid = -1; return; }
        int dev = 0, cus = 0, per_cu = 0;
        hipGetDevice(&dev); hipDeviceGetAttribute(&cus, hipDeviceAttributeMultiprocessorCount, dev);
        if (hipFuncSetAttribute((const void*)fwd_megakernel, hipFuncAttributeMaxDynamicSharedMemorySize, LDS_BYTES) != hipSuccess) { fprintf(stderr, "kernel_launch: hipFuncSetAttribute failed\n"); grid = -1; return; }
        if (hipOccupancyMaxActiveBlocksPerMultiprocessor(&per_cu, (const void*)fwd_megakernel, 512, LDS_BYTES) != hipSuccess || per_cu < 1) { fprintf(stderr, "kernel_launch: occupancy query says %d\n", per_cu); per_cu = 1; }
        (void)hipGetLastError();
        grid = cus * 1;
    }
    if (grid < 0) return;
    hipMemsetAsync((char*)d_ws + WS_CTL, 0, 32768, stream);
    ParamsK p{};
    for (int i = 0; i < 28; ++i) p.in[i] = (const float*)d_in[i];
    p.out = (float*)d_out; p.ws = (unsigned char*)d_ws;
    void* args[] = {&p};
    hipError_t e = hipLaunchCooperativeKernel((const void*)fwd_megakernel, dim3(grid), dim3(512), args, LDS_BYTES, stream);
    if (e != hipSuccess) fprintf(stderr, "cooperative launch failed: %s (grid %d)\n", hipGetErrorString(e), grid);
}
```
